# Optimizing an MI355X kernel written in HIP

```python
import math
import jax
import jax.numpy as jnp
from jax import lax
import numpy as np

D_MODEL = 2048
BATCH = 4
SEQ = 4096
DEPTH = 2

CHUNK = 64
NORM_EPS = 1e-6
MIX_WIDTH = D_MODEL
GROUP_WIDTH = MIX_WIDTH // 4

HG_HEAD_DIM = 128
HG_HEADS = GROUP_WIDTH // HG_HEAD_DIM

SSM_HEAD_DIM = 64
SSM_HEADS = GROUP_WIDTH // SSM_HEAD_DIM
SSM_STATE = 128
SSM_GROUPS = 2
SSM_CONV = 4
SSM_BC = SSM_GROUPS * SSM_STATE
SSM_CONV_DIM = GROUP_WIDTH + 2 * SSM_BC

RG_BLOCKS = 8
RG_BLOCK = GROUP_WIDTH // RG_BLOCKS
RG_CONV = 4
RG_C = 8.0

RW_HEAD_DIM = 64
RW_HEADS = GROUP_WIDTH // RW_HEAD_DIM
RW_DECAY_RANK = 96
RW_A_RANK = 96
RW_GATE_RANK = 256
RW_GN_EPS = 64e-5

HG_COLS = 4 * GROUP_WIDTH
SSM_COLS = GROUP_WIDTH + SSM_CONV_DIM + SSM_HEADS
RG_COLS = 2 * GROUP_WIDTH
RW_COLS = 3 * GROUP_WIDTH + RW_DECAY_RANK + RW_A_RANK + RW_GATE_RANK
IN_COLS = HG_COLS + SSM_COLS + RG_COLS + RW_COLS

N_GROUPS = 4
EXPERTS_PER_GROUP = 8
N_EXPERTS = N_GROUPS * EXPERTS_PER_GROUP
TOP_K = 2
D_EXPERT = D_MODEL // 2
MOE_BLOCK = 128

kernel_name = 'hybrid_stream_hgrn2_ssd_rglru_rwkv7_hmoe'


def rms_norm(x, w, eps=NORM_EPS):
    xf = x.astype(jnp.float32)
    y = xf * lax.rsqrt(jnp.mean(xf * xf, axis=-1, keepdims=True) + eps)
    return (y * w.astype(jnp.float32)).astype(x.dtype)


def group_rms_norm(y, w, groups, eps=NORM_EPS):
    shp = y.shape
    yg = y.reshape(shp[:-1] + (groups, shp[-1] // groups))
    yg = yg * lax.rsqrt(jnp.mean(yg * yg, axis=-1, keepdims=True) + eps)
    return yg.reshape(shp) * w


def causal_dwconv(x, w, b):
    k = w.shape[0]
    y = lax.conv_general_dilated(x, w[:, None, :].astype(x.dtype), window_strides=(1,), padding=[(k - 1, 0)], dimension_numbers=('NWC', 'WIO', 'NWC'), feature_group_count=x.shape[-1])
    return y + b


def to_chunk_heads(t, heads):
    bsz, seq, width = t.shape
    return t.reshape(bsz, seq // CHUNK, CHUNK, heads, width // heads).transpose(1, 0, 3, 2, 4)


def hgrn2_mixer(p, lower_bound, norm_w):
    bsz, seq, _ = p.shape
    q, f_raw, i, g = jnp.split(p, 4, axis=-1)
    q = jax.nn.silu(q)
    f = lower_bound + (1.0 - lower_bound) * jax.nn.sigmoid(f_raw)
    k = 1.0 - f
    qc = to_chunk_heads(q, HG_HEADS)
    kc = to_chunk_heads(k, HG_HEADS)
    vc = to_chunk_heads(i, HG_HEADS)
    bc = jnp.cumsum(to_chunk_heads(jnp.log(f), HG_HEADS), axis=-2)
    causal = jnp.tril(jnp.ones((CHUNK, CHUNK), dtype=bool))[:, :, None]

    def chunk_step(state, inp):
        qt, kt, vt, bt = inp
        rel = jnp.where(causal, bt[:, :, :, None, :] - bt[:, :, None, :, :], -jnp.inf)
        scores = jnp.einsum('bhtk,bhsk,bhtsk->bhts', qt, kt, jnp.exp(rel))
        out = jnp.einsum('bhts,bhsv->bhtv', scores, vt) + jnp.einsum('bhtk,bhkv->bhtv', qt * jnp.exp(bt), state)
        b_end = bt[:, :, -1:, :]
        state = state * jnp.exp(b_end[:, :, 0, :, None]) + jnp.einsum('bhsk,bhsv->bhkv', kt * jnp.exp(b_end - bt), vt)
        return state, out

    s0 = jnp.zeros((bsz, HG_HEADS, HG_HEAD_DIM, HG_HEAD_DIM), jnp.float32)
    _, o = lax.scan(chunk_step, s0, (qc, kc, vc, bc))
    o = o.transpose(1, 0, 3, 2, 4).reshape(bsz, seq, GROUP_WIDTH)
    return group_rms_norm(o, norm_w, HG_HEADS) * jax.nn.silu(g)


def mamba2_mixer(p, conv_w, conv_b, dt_bias, a_log, d_skip, norm_w):
    bsz, seq, _ = p.shape
    n = seq // CHUNK
    z, xbc, dt = jnp.split(p, [GROUP_WIDTH, GROUP_WIDTH + SSM_CONV_DIM], axis=-1)
    xbc = jax.nn.silu(causal_dwconv(xbc, conv_w, conv_b))
    xs, bm, cm = jnp.split(xbc, [GROUP_WIDTH, GROUP_WIDTH + SSM_BC], axis=-1)
    rep = SSM_HEADS // SSM_GROUPS
    xs = xs.reshape(bsz, n, CHUNK, SSM_HEADS, SSM_HEAD_DIM)
    bm = jnp.repeat(bm.reshape(bsz, n, CHUNK, SSM_GROUPS, SSM_STATE), rep, axis=3)
    cm = jnp.repeat(cm.reshape(bsz, n, CHUNK, SSM_GROUPS, SSM_STATE), rep, axis=3)
    dt = jax.nn.softplus(dt + dt_bias).reshape(bsz, n, CHUNK, SSM_HEADS)
    a_cum = jnp.cumsum((dt * -jnp.exp(a_log)).transpose(0, 3, 1, 2), axis=-1)
    xdt = xs * dt[..., None]
    causal = jnp.tril(jnp.ones((CHUNK, CHUNK), dtype=bool))
    decay_in = jnp.exp(jnp.where(causal, a_cum[..., :, None] - a_cum[..., None, :], -jnp.inf))
    scores = jnp.einsum('bclhn,bcshn->bhcls', cm, bm) * decay_in
    y_diag = jnp.einsum('bhcls,bcshp->bclhp', scores, xdt)
    states = jnp.einsum('bclhn,bhcl,bclhp->bchpn', bm, jnp.exp(a_cum[..., -1:] - a_cum), xdt)

    def chunk_step(h, inp):
        s, dec = inp
        return h * jnp.exp(dec)[..., None, None] + s, h

    h0 = jnp.zeros((bsz, SSM_HEADS, SSM_HEAD_DIM, SSM_STATE), jnp.float32)
    _, prev = lax.scan(chunk_step, h0, (states.transpose(1, 0, 2, 3, 4), a_cum[..., -1].transpose(2, 0, 1)))
    y_off = jnp.einsum('bclhn,bchpn,bhcl->bclhp', cm, prev.transpose(1, 0, 2, 3, 4), jnp.exp(a_cum))
    y = (y_diag + y_off + xs * d_skip[:, None]).reshape(bsz, seq, GROUP_WIDTH)
    return group_rms_norm(y * jax.nn.silu(z), norm_w, SSM_GROUPS)


def rglru_mixer(p, conv_w, conv_b, w_a, b_a, w_x, b_x, lam):
    bsz, seq, _ = p.shape
    gate_in, xb = jnp.split(p, 2, axis=-1)
    xb = causal_dwconv(xb, conv_w, conv_b)
    xh = xb.reshape(bsz, seq, RG_BLOCKS, RG_BLOCK)
    r = jax.nn.sigmoid(jnp.einsum('blhi,hij->blhj', xh, w_a).reshape(bsz, seq, GROUP_WIDTH) + b_a)
    i = jax.nn.sigmoid(jnp.einsum('blhi,hij->blhj', xh, w_x).reshape(bsz, seq, GROUP_WIDTH) + b_x)
    log_a = -RG_C * r * jax.nn.softplus(-lam)
    a = jnp.exp(log_a)
    u = jnp.sqrt(-jnp.expm1(2.0 * log_a)) * (i * xb)

    def combine(c1, c2):
        return c1[0] * c2[0], c2[0] * c1[1] + c2[1]

    _, h = lax.associative_scan(combine, (a, u), axis=1)
    return h * jax.nn.gelu(gate_in, approximate=True)


def rwkv7_mixer(p, mu, w0, w2, a0, a2, g2, k_k, k_a, r_k, ln_w, ln_b):
    bsz, seq, _ = p.shape
    gw = GROUP_WIDTH
    prev = jnp.pad(p, ((0, 0), (1, 0), (0, 0)))[:, :-1]
    p = p + (prev - p) * mu
    r, k, v, wd, ad, gd = jnp.split(p, [gw, 2 * gw, 3 * gw, 3 * gw + RW_DECAY_RANK, 3 * gw + RW_DECAY_RANK + RW_A_RANK], axis=-1)
    w_log = -jax.nn.softplus(-(w0 + jnp.tanh(wd) @ w2)) - 0.5
    decay = jnp.exp(-jnp.exp(w_log))
    a = jax.nn.sigmoid(a0 + ad @ a2)
    g = jax.nn.sigmoid(gd) @ g2

    def heads(t):
        return t.reshape(bsz, seq, RW_HEADS, RW_HEAD_DIM)

    kk = heads(k * k_k)
    kk = kk / jnp.maximum(jnp.sqrt(jnp.sum(kk * kk, axis=-1, keepdims=True)), 1e-12)
    k = k * (1.0 + (a - 1.0) * k_a)
    rh, kh, vh, wh, ah = heads(r), heads(k), heads(v), heads(decay), heads(a)

    def time_step(state, inp):
        r_t, w_t, k_t, v_t, kk_t, a_t = inp
        sa = jnp.einsum('bhvk,bhk->bhv', state, -kk_t)
        state = state * w_t[:, :, None, :] + sa[..., None] * (kk_t * a_t)[:, :, None, :] + v_t[..., None] * k_t[:, :, None, :]
        return state, jnp.einsum('bhvk,bhk->bhv', state, r_t)

    def seq_first(t):
        return t.transpose(1, 0, 2, 3)

    s0 = jnp.zeros((bsz, RW_HEADS, RW_HEAD_DIM, RW_HEAD_DIM), jnp.float32)
    _, y = lax.scan(time_step, s0, (seq_first(rh), seq_first(wh), seq_first(kh), seq_first(vh), seq_first(kk), seq_first(ah)))
    y = y.transpose(1, 0, 2, 3)
    mean = jnp.mean(y, axis=-1, keepdims=True)
    var = jnp.mean(jnp.square(y - mean), axis=-1, keepdims=True)
    y = ((y - mean) * lax.rsqrt(var + RW_GN_EPS)).reshape(bsz, seq, gw) * ln_w + ln_b
    bonus = jnp.sum(rh * kh * r_k.reshape(RW_HEADS, RW_HEAD_DIM), axis=-1, keepdims=True) * vh
    return (y + bonus.reshape(bsz, seq, gw)) * g


def hier_moe(x, wg, bg, we, be, w_gate, w_up, w_down):
    bsz, seq, d = x.shape
    n_tok = bsz * seq
    n_assign = n_tok * TOP_K
    xt = x.reshape(n_tok, d)
    xf = xt.astype(jnp.float32)
    g_prob = jax.nn.softmax(xf @ wg.astype(jnp.float32) + bg.astype(jnp.float32), axis=-1)
    g_top, g_idx = lax.top_k(g_prob, 1)
    e_logits = (xf @ we.astype(jnp.float32) + be.astype(jnp.float32)).reshape(n_tok, N_GROUPS, EXPERTS_PER_GROUP)
    e_logits = jnp.take_along_axis(e_logits, g_idx[:, :, None], axis=1)[:, 0]
    e_top, e_idx = lax.top_k(jax.nn.softmax(e_logits, axis=-1), TOP_K)
    gates = g_top * e_top / jnp.sum(e_top, axis=-1, keepdims=True)
    expert_id = (g_idx * EXPERTS_PER_GROUP + e_idx).reshape(-1)
    token_id = jnp.repeat(jnp.arange(n_tok, dtype=jnp.int32), TOP_K)
    gate_flat = gates.reshape(-1)
    order = jnp.argsort(expert_id)
    sorted_e = expert_id[order]
    counts = jnp.bincount(expert_id, length=N_EXPERTS)
    padded = (counts + MOE_BLOCK - 1) // MOE_BLOCK * MOE_BLOCK
    pad_end = jnp.cumsum(padded)
    pad_start = pad_end - padded
    start = jnp.cumsum(counts) - counts
    dest = pad_start[sorted_e] + jnp.arange(n_assign, dtype=jnp.int32) - start[sorted_e]
    n_blocks = (n_assign + N_EXPERTS * (MOE_BLOCK - 1) + MOE_BLOCK - 1) // MOE_BLOCK
    n_slots = n_blocks * MOE_BLOCK
    slot_tok = jnp.full((n_slots,), n_tok, jnp.int32).at[dest].set(token_id[order])
    slot_gate = jnp.zeros((n_slots,), jnp.float32).at[dest].set(gate_flat[order])
    block_expert = jnp.minimum(jnp.searchsorted(pad_end, jnp.arange(n_blocks, dtype=jnp.int32) * MOE_BLOCK, side='right'), N_EXPERTS - 1)
    x_pad = jnp.concatenate([xt, jnp.zeros((1, d), xt.dtype)], axis=0)
    xb = x_pad[slot_tok].reshape(n_blocks, MOE_BLOCK, d)

    def expert_block(args):
        xblk, e = args
        hid = jax.nn.silu(xblk @ w_gate[e]) * (xblk @ w_up[e])
        return hid @ w_down[e]

    yb = lax.map(expert_block, (xb, block_expert)).reshape(n_slots, d)
    y = jnp.zeros((n_tok + 1, d), jnp.float32).at[slot_tok].add(yb.astype(jnp.float32) * slot_gate[:, None])
    return y[:n_tok].reshape(bsz, seq, d).astype(x.dtype)


def setup_inputs(seed: int = 0) -> dict:
    key = jax.random.key(seed)
    ks = iter(jax.random.split(key, 48))
    f32 = jnp.float32

    def nrm(shape, scale):
        return jax.random.normal(next(ks), shape, f32) * scale

    def unif(shape, lo, hi):
        return jax.random.uniform(next(ks), shape, f32, lo, hi)

    nl, gw = DEPTH, GROUP_WIDTH
    x = nrm((BATCH, SEQ, D_MODEL), 1.0)
    w_in = nrm((nl, D_MODEL, IN_COLS), D_MODEL ** -0.5)
    w_out = nrm((nl, MIX_WIDTH, D_MODEL), MIX_WIDTH ** -0.5)
    norm_mix_w = 1.0 + nrm((nl, D_MODEL), 0.02)
    norm_ffn_w = 1.0 + nrm((nl, D_MODEL), 0.02)
    final_norm_w = 1.0 + nrm((D_MODEL,), 0.02)
    hg_lb_param = 1.0 + nrm((nl, gw), 0.1)
    hg_norm_w = 1.0 + nrm((nl, gw), 0.02)
    ssm_conv_w = nrm((nl, SSM_CONV, SSM_CONV_DIM), SSM_CONV ** -0.5)
    ssm_conv_b = nrm((nl, SSM_CONV_DIM), 0.02)
    dt0 = jnp.exp(unif((nl, SSM_HEADS), math.log(1e-3), math.log(1e-1)))
    ssm_dt_bias = dt0 + jnp.log(-jnp.expm1(-dt0))
    ssm_a_log = jnp.log(unif((nl, SSM_HEADS), 1.0, 16.0))
    ssm_d = 1.0 + nrm((nl, SSM_HEADS), 0.1)
    ssm_norm_w = 1.0 + nrm((nl, gw), 0.02)
    rg_conv_w = nrm((nl, RG_CONV, gw), RG_CONV ** -0.5)
    rg_conv_b = nrm((nl, gw), 0.02)
    rg_w_a = nrm((nl, RG_BLOCKS, RG_BLOCK, RG_BLOCK), RG_BLOCK ** -0.5)
    rg_b_a = nrm((nl, gw), 0.02)
    rg_w_x = nrm((nl, RG_BLOCKS, RG_BLOCK, RG_BLOCK), RG_BLOCK ** -0.5)
    rg_b_x = nrm((nl, gw), 0.02)
    a_c = unif((nl, gw), 0.9, 0.999)
    s = a_c ** (1.0 / RG_C)
    rg_lambda = jnp.log(s) - jnp.log1p(-s)
    rw_mu = unif((nl, RW_COLS), 0.0, 1.0)
    rw_w0 = jnp.linspace(-7.0, -2.0, gw, dtype=f32)[None, :] + 0.5 + nrm((nl, gw), 0.1)
    rw_w2 = nrm((nl, RW_DECAY_RANK, gw), 0.5 * RW_DECAY_RANK ** -0.5)
    rw_a0 = nrm((nl, gw), 0.1)
    rw_a2 = nrm((nl, RW_A_RANK, gw), RW_A_RANK ** -0.5)
    rw_g2 = nrm((nl, RW_GATE_RANK, gw), RW_GATE_RANK ** -0.5)
    rw_k_k = 0.85 + nrm((nl, gw), 0.05)
    rw_k_a = 1.0 + nrm((nl, gw), 0.05)
    rw_r_k = nrm((nl, gw), 0.1)
    rw_ln_w = 1.0 + nrm((nl, gw), 0.02)
    rw_ln_b = nrm((nl, gw), 0.02)
    router_group_w = nrm((nl, D_MODEL, N_GROUPS), D_MODEL ** -0.5)
    router_group_b = nrm((nl, N_GROUPS), 0.01)
    router_expert_w = nrm((nl, D_MODEL, N_EXPERTS), D_MODEL ** -0.5)
    router_expert_b = nrm((nl, N_EXPERTS), 0.01)
    moe_w_gate = nrm((nl, N_EXPERTS, D_MODEL, D_EXPERT), D_MODEL ** -0.5)
    moe_w_up = nrm((nl, N_EXPERTS, D_MODEL, D_EXPERT), D_MODEL ** -0.5)
    moe_w_down = nrm((nl, N_EXPERTS, D_EXPERT, D_MODEL), D_EXPERT ** -0.5)
    return {'x': x, 'w_in': w_in, 'w_out': w_out, 'norm_mix_w': norm_mix_w, 'norm_ffn_w': norm_ffn_w, 'final_norm_w': final_norm_w, 'hg_lb_param': hg_lb_param, 'hg_norm_w': hg_norm_w, 'ssm_conv_w': ssm_conv_w, 'ssm_conv_b': ssm_conv_b, 'ssm_dt_bias': ssm_dt_bias, 'ssm_a_log': ssm_a_log, 'ssm_d': ssm_d, 'ssm_norm_w': ssm_norm_w, 'rg_conv_w': rg_conv_w, 'rg_conv_b': rg_conv_b, 'rg_w_a': rg_w_a, 'rg_b_a': rg_b_a, 'rg_w_x': rg_w_x, 'rg_b_x': rg_b_x, 'rg_lambda': rg_lambda, 'rw_mu': rw_mu, 'rw_w0': rw_w0, 'rw_w2': rw_w2, 'rw_a0': rw_a0, 'rw_a2': rw_a2, 'rw_g2': rw_g2, 'rw_k_k': rw_k_k, 'rw_k_a': rw_k_a, 'rw_r_k': rw_r_k, 'rw_ln_w': rw_ln_w, 'rw_ln_b': rw_ln_b, 'router_group_w': router_group_w, 'router_group_b': router_group_b, 'router_expert_w': router_expert_w, 'router_expert_b': router_expert_b, 'moe_w_gate': moe_w_gate, 'moe_w_up': moe_w_up, 'moe_w_down': moe_w_down}


def reference(x, w_in, w_out, norm_mix_w, norm_ffn_w, final_norm_w, hg_lb_param, hg_norm_w, ssm_conv_w, ssm_conv_b, ssm_dt_bias, ssm_a_log, ssm_d, ssm_norm_w, rg_conv_w, rg_conv_b, rg_w_a, rg_b_a, rg_w_x, rg_b_x, rg_lambda, rw_mu, rw_w0, rw_w2, rw_a0, rw_a2, rw_g2, rw_k_k, rw_k_a, rw_r_k, rw_ln_w, rw_ln_b, router_group_w, router_group_b, router_expert_w, router_expert_b, moe_w_gate, moe_w_up, moe_w_down):
    sm = jax.nn.softmax(hg_lb_param.astype(jnp.float32), axis=0)
    lower_bounds = jnp.cumsum(sm, axis=0) - sm[0]
    splits = [HG_COLS, HG_COLS + SSM_COLS, HG_COLS + SSM_COLS + RG_COLS]
    h = x
    for l in range(DEPTH):
        u = rms_norm(h, norm_mix_w[l])
        proj = (u @ w_in[l]).astype(jnp.float32)
        pa, pb, pc, pd = jnp.split(proj, splits, axis=-1)
        ya = hgrn2_mixer(pa, lower_bounds[l], hg_norm_w[l])
        yb = mamba2_mixer(pb, ssm_conv_w[l], ssm_conv_b[l], ssm_dt_bias[l], ssm_a_log[l], ssm_d[l], ssm_norm_w[l])
        yc = rglru_mixer(pc, rg_conv_w[l], rg_conv_b[l], rg_w_a[l], rg_b_a[l], rg_w_x[l], rg_b_x[l], rg_lambda[l])
        yd = rwkv7_mixer(pd, rw_mu[l], rw_w0[l], rw_w2[l], rw_a0[l], rw_a2[l], rw_g2[l], rw_k_k[l], rw_k_a[l], rw_r_k[l], rw_ln_w[l], rw_ln_b[l])
        mixed = jnp.concatenate([ya, yb, yc, yd], axis=-1).astype(h.dtype)
        h = h + mixed @ w_out[l]
        h = h + hier_moe(rms_norm(h, norm_ffn_w[l]), router_group_w[l], router_group_b[l], router_expert_w[l], router_expert_b[l], moe_w_gate[l], moe_w_up[l], moe_w_down[l])
    return rms_norm(h, final_norm_w)
```

```cpp
#include <hip/hip_runtime.h>
#include <stdint.h>
#include <stdio.h>

#ifndef MK_MULTI
#define MK_MULTI 0
#endif

#define LAS __attribute__((address_space(3)))
#define LDS_BARRIER() do { asm volatile("s_waitcnt lgkmcnt(0)" ::: "memory"); __builtin_amdgcn_s_barrier(); asm volatile("" ::: "memory"); } while (0)
typedef unsigned short bf16_t;
typedef short bf16x8 __attribute__((ext_vector_type(8)));
typedef float f32x4 __attribute__((ext_vector_type(4)));
typedef unsigned u32x4 __attribute__((ext_vector_type(4)));
typedef unsigned u32x2 __attribute__((ext_vector_type(2)));

constexpr int D = 2048, SEQ = 4096, NTOK = 16384, DEPTH = 2, GW = 512;
constexpr int IN_COLS = 6600, PS = 6656;
constexpr int C_HG_Q = 0, C_HG_F = 512, C_HG_I = 1024, C_HG_G = 1536;
constexpr int C_SS_Z = 2048, C_SS_X = 2560, C_SS_DT = 3584;
constexpr int C_RG_G = 3592, C_RG_X = 4104;
constexpr int C_RW = 4616;
constexpr int RW_COLS = 1984;
constexpr int QS = 5120;
constexpr int Q_RGA = 512, Q_RGU = 1024, Q_R = 1536, Q_W = 2048, Q_K = 2560, Q_V = 3072, Q_KK = 3584, Q_KKA = 4096, Q_G = 4608;
constexpr int NEXP = 32, DEXP = 1024;
constexpr int MAXSLOT = 40960, MAXTILE = 160;
constexpr float NORM_EPS = 1e-6f;

constexpr size_t al256(size_t x) { return (x + 255) & ~(size_t)255; }
constexpr size_t WS_CTL = 0;
constexpr size_t CTL_BYTES = 65536;
constexpr size_t WS_TAB = WS_CTL + CTL_BYTES;
constexpr size_t TAB_ROUTE = 0;
constexpr size_t TAB_TOKSLOT = TAB_ROUTE + (size_t)NTOK * 32;
constexpr size_t TAB_SLOTGATE = TAB_TOKSLOT + (size_t)NTOK * 8;
constexpr size_t TAB_PADSTART = TAB_SLOTGATE + (size_t)MAXSLOT * 4;
constexpr size_t TAB_TILEEXP = TAB_PADSTART + 256;
constexpr size_t TAB_NTILES = TAB_TILEEXP + 1024;
constexpr size_t TAB_SLOTTOK = TAB_NTILES + 256;
constexpr size_t TAB_BYTES = al256(TAB_SLOTTOK + (size_t)MAXSLOT * 4);
constexpr size_t WS_WIN = al256(WS_TAB + TAB_BYTES);
constexpr size_t WS_WOUT = WS_WIN + (size_t)2 * PS * D * 2;
constexpr size_t WS_WGU = WS_WOUT + (size_t)2 * D * D * 2;
constexpr size_t WS_WD = WS_WGU + (size_t)2 * NEXP * 2048 * 2048 * 2;
constexpr size_t WS_U = WS_WD + (size_t)2 * NEXP * 2048 * 1024 * 2;
constexpr size_t WS_MIX = WS_U + (size_t)NTOK * D * 2;
constexpr size_t WS_R1 = WS_MIX + (size_t)NTOK * D * 2;
constexpr size_t R1_HID = (size_t)MAXSLOT * D * 2;
constexpr size_t R1_BYTES = R1_HID + (size_t)MAXSLOT * DEXP * 2;
static_assert((size_t)NTOK * PS * 2 <= R1_BYTES, "R1 alias");
constexpr size_t WS_R2 = WS_R1 + R1_BYTES;
constexpr size_t R2_BYTES = (size_t)NTOK * QS * 4;
static_assert((size_t)MAXSLOT * D * 2 <= R2_BYTES, "R2 alias");
constexpr size_t WS_R3 = WS_R2 + R2_BYTES;
constexpr size_t WS_R4 = WS_R3 + (size_t)NTOK * D * 4;
constexpr size_t R4_HGS = 0;
constexpr size_t R4_SSS = R4_HGS + (size_t)16 * 64 * 16384 * 4;
constexpr size_t R4_HGD = R4_SSS + (size_t)32 * 64 * 8192 * 4;
constexpr size_t R4_SSD = R4_HGD + (size_t)16 * 64 * 128 * 4;
constexpr size_t R4_RGC = R4_SSD + (size_t)32 * 64 * 4;
constexpr size_t WS_RWAAB = al256(WS_R4 + R4_RGC + (size_t)4 * 64 * 512 * 2 * 4);
constexpr size_t WS_RWGC = WS_RWAAB + (size_t)2048 * 4096 * 4;
constexpr size_t WS_SW = WS_RWGC + (size_t)2048 * 64 * 4;
constexpr size_t SW_W2T = 0, SW_A2T = SW_W2T + 512 * 96 * 2, SW_G2T = SW_A2T + 512 * 96 * 2, SW_WAT = SW_G2T + 512 * 256 * 2, SW_WXT = SW_WAT + 8 * 64 * 64 * 2, SW_LAYER = SW_WXT + 8 * 64 * 64 * 2;
constexpr size_t WS_WRT = al256(WS_SW + 2 * SW_LAYER);
constexpr size_t WS_BON = al256(WS_WRT + (size_t)2 * 48 * 2048 * 4);
constexpr size_t WS_SLOTRS = al256(WS_BON + (size_t)NTOK * 8 * 4);
constexpr size_t WS_END = WS_SLOTRS + (size_t)MAXSLOT * 4;
constexpr size_t RW_REC = 65536;
constexpr int RO_AR = 0, RO_RR = 8192, RO_BRT = 16384, RO_ARBT = 24576, RO_TT = 32768, RO_XL = 40960, RO_LT = 49152, RO_YL = 57344;
static_assert(WS_MIX == WS_U + (size_t)NTOK * D * 2 && (size_t)2048 * RW_REC <= (size_t)2 * NTOK * D * 2, "RW record region");

constexpr int CW_BAR = 0;
constexpr int CW_CNT = 4096;

typedef __bf16 bf16v2 __attribute__((ext_vector_type(2)));
typedef float f32x2 __attribute__((ext_vector_type(2)));
__device__ __forceinline__ unsigned cvt_pk_bf16(float lo, float hi) { const f32x2 v = {lo, hi}; const bf16v2 b = __builtin_convertvector(v, bf16v2); return __builtin_bit_cast(unsigned, b); }
__device__ __forceinline__ bf16_t f2bf(float f) { return (bf16_t)(cvt_pk_bf16(f, 0.0f) & 0xffffu); }
#define DPP_ADD(v, ctrl, rmask, bc) ((v) + __uint_as_float(__builtin_amdgcn_update_dpp(0u, __float_as_uint(v), (ctrl), (rmask), 0xf, (bc))))
__device__ __forceinline__ float row16_sum(float v) {
    v = DPP_ADD(v, 0xB1, 0xf, true); v = DPP_ADD(v, 0x4E, 0xf, true); v = DPP_ADD(v, 0x141, 0xf, true); v = DPP_ADD(v, 0x140, 0xf, true);
    return v;
}
__device__ __forceinline__ float wave_sum(float v) {
    v = row16_sum(v);
    v = DPP_ADD(v, 0x142, 0xa, false);
    v = DPP_ADD(v, 0x143, 0xc, false);
    return __int_as_float(__builtin_amdgcn_readlane(__float_as_int(v), 63));
}
__device__ __forceinline__ float fexp(float x) { return __expf(x); }
__device__ __forceinline__ float flog(float x) { return __logf(x); }
__device__ __forceinline__ float frcp(float x) { return __builtin_amdgcn_rcpf(x); }
__device__ __forceinline__ float sigmoid_f(float x) { return frcp(1.0f + fexp(-x)); }
__device__ __forceinline__ float silu_f(float x) { return x * sigmoid_f(x); }
__device__ __forceinline__ float softplus_f(float x) { return fmaxf(x, 0.f) + flog(1.0f + fexp(-fabsf(x))); }
__device__ __forceinline__ float ftanh(float x) { const float e = fexp(-2.0f * fabsf(x)); const float t = (1.0f - e) * frcp(1.0f + e); return x < 0.f ? -t : t; }
__device__ __forceinline__ float gelu_tanh_f(float x) { const float u = 0.7978845608028654f * (x + 0.044715f * x * x * x); return 0.5f * x * (1.0f + ftanh(u)); }

__device__ __forceinline__ int opaque_tid() { int t = threadIdx.x; asm volatile("" : "+v"(t)); return t; }

#define XB_TMO      128
#define XB_XCNT(j)  (256  + 64 * (j))
#define XB_XSUB(j)  (1280 + 64 * (j))
#define XB_XGEN(j)  (2304 + 64 * (j))
#define XB_TOP      3328
#define XB_TOPGEN   3392
#define XCD_BAR_WORDS 3456
#define XB_SPIN_CAP (1u << 18)
__device__ __forceinline__ unsigned xb_ld(unsigned* p)              { return __hip_atomic_load(p, __ATOMIC_RELAXED, __HIP_MEMORY_SCOPE_AGENT); }
__device__ __forceinline__ unsigned xb_add(unsigned* p, unsigned v) { return __hip_atomic_fetch_add(p, v, __ATOMIC_RELAXED, __HIP_MEMORY_SCOPE_AGENT); }
__device__ __forceinline__ unsigned xb_xcc_id() { return (unsigned)__builtin_amdgcn_s_getreg((3 << 11) | 20) & 0xFu; }
#define XB_SPIN(cond, bar) do { unsigned _sp = 0; while (cond) { __builtin_amdgcn_s_sleep(1); \
    if ((++_sp & 255u) == 0u) { if (xb_ld(&(bar)[XB_TMO])) break; if (_sp > XB_SPIN_CAP) { atomicAdd(&(bar)[XB_TMO], 1u); break; } } } } while (0)
struct XcdBarrier { unsigned* bar; unsigned x; volatile LAS unsigned* st; };
__device__ __forceinline__ XcdBarrier xcd_barrier_post(unsigned* bar, volatile LAS unsigned* st) {
    XcdBarrier b; b.bar = bar; b.x = xb_xcc_id(); b.st = st;
    if (threadIdx.x == 0) (void)xb_add(&bar[XB_XCNT(b.x)], 1u);
    return b;
}
__device__ __forceinline__ void xcd_barrier_complete(unsigned* bar, unsigned x, unsigned& nloc, unsigned& nx) {
    const unsigned G = gridDim.x * gridDim.y * gridDim.z;
    unsigned sum, cnt, mine, sp = 0u;
    for (;;) {
        sum = 0u; cnt = 0u; mine = 0u;
#pragma unroll
        for (unsigned j = 0; j < 16; ++j) { const unsigned c = xb_ld(&bar[XB_XCNT(j)]); sum += c; cnt += (c > 0u) ? 1u : 0u; mine = (j == x) ? c : mine; }
        if (sum == G) break;
        __builtin_amdgcn_s_sleep(1);
        if ((++sp & 255u) == 0u) { if (xb_ld(&bar[XB_TMO])) break; if (sp > XB_SPIN_CAP) { atomicAdd(&bar[XB_TMO], 1u); break; } }
    }
    nloc = mine > 0u ? mine : 1u; nx = cnt > 0u ? cnt : 1u;
}
__device__ __forceinline__ void xcd_barrier(const XcdBarrier& b) {
    asm volatile("s_waitcnt vmcnt(0)" ::: "memory");
    __syncthreads();
    if (threadIdx.x == 0) {
        unsigned* bar = b.bar;
        __builtin_amdgcn_s_waitcnt(0);
        unsigned nloc = b.st[0], nx = b.st[1];
        if (nloc == 0u) { xcd_barrier_complete(bar, b.x, nloc, nx); b.st[0] = nloc; b.st[1] = nx; }
        const unsigned old = xb_add(&bar[XB_XSUB(b.x)], 1u);
        const unsigned gen = old / nloc;
        if (old + 1u == (gen + 1u) * nloc) {
            __builtin_amdgcn_fence(__ATOMIC_RELEASE, "agent");
            asm volatile("s_waitcnt vmcnt(0)" ::: "memory");
            const unsigned og = xb_add(&bar[XB_TOP], 1u);
            const unsigned tg = og / nx;
            if (og + 1u == (tg + 1u) * nx) xb_add(&bar[XB_TOPGEN], 1u);
            else XB_SPIN(xb_ld(&bar[XB_TOPGEN]) == tg, bar);
            __builtin_amdgcn_fence(__ATOMIC_ACQUIRE, "agent");
            xb_add(&bar[XB_XGEN(b.x)], 1u);
            asm volatile("s_waitcnt vmcnt(0)" ::: "memory");
        } else {
            XB_SPIN(xb_ld(&bar[XB_XGEN(b.x)]) == gen, bar);
            __builtin_amdgcn_fence(__ATOMIC_ACQUIRE, "agent");
            asm volatile("s_waitcnt vmcnt(0)" ::: "memory");
        }
    }
    __syncthreads();
}

namespace pg8 {
constexpr int BM = 256, BK = 64, HALF = 128, HTB = HALF * BK * 2, STAGE_BYTES = 8 * HTB, NXCD = 8;
__host__ __device__ __forceinline__ int lds_byte(int r, int c) { const int st = (r >> 4) * 2 + (c >> 5), rr = r & 15, cc = c & 31, ob = rr * 64 + cc * 2; return st * 1024 + (ob ^ (((ob >> 9) & 1) << 5)); }
__host__ __device__ __forceinline__ void stage_rc(int b, int& R, int& C) { const int st = b / 1024, sb = b % 1024, swz = sb ^ (((sb >> 9) & 1) << 5); R = (st >> 1) * 16 + swz / 64; C = (st & 1) * 32 + (swz % 64) / 2; }

struct Unit { int pm, pn, e; };
struct Gemm { const bf16_t* A; const bf16_t* Bt; int K; size_t ebytes; const int* rowmap; };

struct StaticOrder {
    int nM, nN, nwg, G, c, WGM;
    __device__ void init(int M, int N, int G_, int c_, int wgm = 4) { nM = M / BM; nN = N / BM; nwg = nM * nN; G = G_; c = c_; WGM = wgm; }
    __device__ bool next(int i, Unit& u) const {
        const long L = (long)i * G + c; if (L >= nwg) return false;
        int wgid = (int)L; { const int q = nwg / NXCD, r = nwg % NXCD, xcd = wgid % NXCD, off = wgid / NXCD; wgid = (xcd < r ? xcd * (q + 1) : r * (q + 1) + (xcd - r) * q) + off; }
        const int nig = WGM * nN, gid = wgid / nig, fm = gid * WGM, gsz = (nM - fm) < WGM ? (nM - fm) : WGM;
        u.pm = fm + ((wgid % nig) % gsz); u.pn = (wgid % nig) / gsz; u.e = 0; return true;
    }
};
struct MoeOrder {
    int nt; const int* tile_exp; int nN, G, c;
    __device__ bool next(int i, Unit& u) const {
        int t, pn;
        if ((G & 255) == 0 && nN == 8) { const int x = c & 7, idx = c >> 3, per = G >> 8;
            const int grp = idx >> 5;
            t = 4 * ((i * per + grp) * 8 + x) + ((idx & 31) >> 3); pn = idx & 7; (void)per; }
        else { const long L = (long)i * G + c; t = (int)(L / nN); pn = (int)(L % nN); }
        const bool ok = t < nt;
        u.pm = ok ? t : 0; u.pn = ok ? pn : 0; u.e = tile_exp[u.pm]; return ok;
    }
};

struct EpiBf {
    bf16_t* C; int ldc;
    __device__ __forceinline__ void operator()(const f32x4 (&acc)[2][2][4][2], const Unit& u, int wr, int wc, int fr, int fq) const {
        const int row0 = u.pm * BM + wr * 64 + fr, col0 = u.pn * BM + wc * 32 + 4 * fq;
#pragma unroll
        for (int ai = 0; ai < 2; ++ai)
#pragma unroll
            for (int m = 0; m < 4; ++m) { bf16_t* rowp = C + (size_t)(row0 + ai * HALF + m * 16) * ldc + col0;
#pragma unroll
                for (int bj = 0; bj < 2; ++bj)
#pragma unroll
                    for (int n = 0; n < 2; ++n) { const f32x4 v = acc[ai][bj][m][n]; u32x2 w; w.x = cvt_pk_bf16(v[0], v[1]); w.y = cvt_pk_bf16(v[2], v[3]); *(u32x2*)(rowp + bj * HALF + n * 16) = w; } }
    }
};
struct EpiRes {
    const float* Hsrc; float* H; int ldc;
    __device__ __forceinline__ void operator()(const f32x4 (&acc)[2][2][4][2], const Unit& u, int wr, int wc, int fr, int fq) const {
        const int row0 = u.pm * BM + wr * 64 + fr, col0 = u.pn * BM + wc * 32 + 4 * fq;
#pragma unroll
        for (int ai = 0; ai < 2; ++ai) {
            f32x4 r[4][2][2];
#pragma unroll
            for (int m = 0; m < 4; ++m) { const size_t off = (size_t)(row0 + ai * HALF + m * 16) * ldc + col0;
#pragma unroll
                for (int bj = 0; bj < 2; ++bj)
#pragma unroll
                    for (int n = 0; n < 2; ++n) r[m][bj][n] = *(const f32x4*)(Hsrc + off + bj * HALF + n * 16); }
#pragma unroll
            for (int m = 0; m < 4; ++m) { const size_t off = (size_t)(row0 + ai * HALF + m * 16) * ldc + col0;
#pragma unroll
                for (int bj = 0; bj < 2; ++bj)
#pragma unroll
                    for (int n = 0; n < 2; ++n) *(f32x4*)(H + off + bj * HALF + n * 16) = r[m][bj][n] + acc[ai][bj][m][n]; }
        }
    }
};
struct EpiGU {
    bf16_t* Hid; const float* rs;
    __device__ __forceinline__ void operator()(const f32x4 (&acc)[2][2][4][2], const Unit& u, int wr, int wc, int fr, int fq) const {
        const int row0 = u.pm * BM + wr * 64 + fr, col0 = u.pn * HALF + wc * 32 + 4 * fq;
        float sc[2][4];
#pragma unroll
        for (int ai = 0; ai < 2; ++ai)
#pragma unroll
            for (int m = 0; m < 4; ++m) sc[ai][m] = rs[row0 + ai * HALF + m * 16];
#pragma unroll
        for (int ai = 0; ai < 2; ++ai)
#pragma unroll
            for (int m = 0; m < 4; ++m) { bf16_t* rowp = Hid + (size_t)(row0 + ai * HALF + m * 16) * DEXP + col0;
#pragma unroll
                for (int n = 0; n < 2; ++n) { const f32x4 g = acc[ai][0][m][n] * sc[ai][m], uu = acc[ai][1][m][n] * sc[ai][m]; float h[4];
#pragma unroll
                    for (int j = 0; j < 4; ++j) h[j] = g[j] * __builtin_amdgcn_rcpf(1.0f + __expf(-g[j])) * uu[j];
                    u32x2 w; w.x = cvt_pk_bf16(h[0], h[1]); w.y = cvt_pk_bf16(h[2], h[3]); *(u32x2*)(rowp + n * 16) = w; } }
    }
};
struct EpiDown {
    bf16_t* Y; const float* gate;
    __device__ __forceinline__ void operator()(const f32x4 (&acc)[2][2][4][2], const Unit& u, int wr, int wc, int fr, int fq) const {
        const int row0 = u.pm * BM + wr * 64 + fr, col0 = u.pn * BM + wc * 32 + 4 * fq;
#pragma unroll
        for (int ai = 0; ai < 2; ++ai)
#pragma unroll
            for (int m = 0; m < 4; ++m) { const int row = row0 + ai * HALF + m * 16; const float gt = gate[row]; bf16_t* rowp = Y + (size_t)row * D + col0;
#pragma unroll
                for (int bj = 0; bj < 2; ++bj)
#pragma unroll
                    for (int n = 0; n < 2; ++n) { const f32x4 v = acc[ai][bj][m][n] * gt; u32x2 w; w.x = cvt_pk_bf16(v[0], v[1]); w.y = cvt_pk_bf16(v[2], v[3]); *(u32x2*)(rowp + bj * HALF + n * 16) = w; } }
    }
};

template <class Epi, class Sched, bool GATHER = false, bool SP2 = true, bool ALIGN_EPI = true>
__device__ __forceinline__ void gemm_phase(LAS unsigned char* lds, const Gemm g, const Sched& S, const Epi& E) {
    const int tid = opaque_tid(), wid = __builtin_amdgcn_readfirstlane(tid >> 6), lane = tid & 63, wr = wid >> 2, wc = wid & 3, fr = lane & 15, fq = lane >> 4;
    const int K = g.K, nt = K / BK;
    unsigned voffA[2];
#pragma unroll
    for (int i = 0; i < 2; ++i) { int R, C; stage_rc(tid * 16 + i * 8192, R, C); voffA[i] = (unsigned)(R * K + C) * 2u; }
    unsigned gA[2][2], gN[2][2];
#define PG8_GLOAD(dst, pm_) do { if constexpr (GATHER) { int rm_[2][2]; \
        _Pragma("unroll") for (int _h = 0; _h < 2; ++_h) _Pragma("unroll") for (int _i = 0; _i < 2; ++_i) { int R_, C_; stage_rc(tid * 16 + _i * 8192, R_, C_); rm_[_h][_i] = g.rowmap[(pm_) * BM + _h * HALF + R_]; } \
        _Pragma("unroll") for (int _h = 0; _h < 2; ++_h) _Pragma("unroll") for (int _i = 0; _i < 2; ++_i) { int R_, C_; stage_rc(tid * 16 + _i * 8192, R_, C_); dst[_h][_i] = (unsigned)(rm_[_h][_i] * K + C_) * 2u; } } } while (0)
    const size_t kstep = (size_t)(BK * 2);
    const size_t hstep = (size_t)HALF * K * 2;
    const size_t tstep = 2 * hstep;
    const unsigned ldsw = (unsigned)wid * 1024u;
    const int aoff = lds_byte(wr * 64 + fr, fq * 8), boff = lds_byte(wc * 32 + fr, fq * 8);
#define PG8_SA(b, h) (((b) * 2 + (h)) * HTB)
#define PG8_SB(b, h) ((4 + (b) * 2 + (h)) * HTB)
#define PG8_STAGE(bufoff, gbase, voff) do { _Pragma("unroll") for (int _i = 0; _i < 2; ++_i) \
        __builtin_amdgcn_global_load_lds((const unsigned*)((const char*)(gbase) + (voff)[_i]), (LAS unsigned*)(lds + (bufoff) + ldsw + _i * 8192), 16, 0, 0); } while (0)
#define PG8_STAGE_A(bufoff, gbase, half, nextsel) do { if constexpr (GATHER) { unsigned _vo[2]; _Pragma("unroll") for (int _i = 0; _i < 2; ++_i) _vo[_i] = (nextsel) ? gN[half][_i] : gA[half][_i]; PG8_STAGE(bufoff, gbase, _vo); } \
        else { PG8_STAGE(bufoff, (gbase) + (half) * hstep, voffA); } } while (0)
#define PG8_LDA(dst, b, h) do { _Pragma("unroll") for (int m = 0; m < 4; ++m) _Pragma("unroll") for (int k = 0; k < 2; ++k) dst[m][k] = *(const LAS bf16x8*)(lds + PG8_SA(b, h) + aoff + m * 2048 + k * 1024); } while (0)
#define PG8_LDB(dst, b, h) do { _Pragma("unroll") for (int n = 0; n < 2; ++n) _Pragma("unroll") for (int k = 0; k < 2; ++k) dst[n][k] = *(const LAS bf16x8*)(lds + PG8_SB(b, h) + boff + n * 2048 + k * 1024); } while (0)
#define PG8_MMA(ai, bj, At, Bt) do { __builtin_amdgcn_s_setprio(1); _Pragma("unroll") for (int m = 0; m < 4; ++m) _Pragma("unroll") for (int n = 0; n < 2; ++n) _Pragma("unroll") for (int k = 0; k < 2; ++k) \
        acc[ai][bj][m][n] = __builtin_amdgcn_mfma_f32_16x16x32_bf16(Bt[n][k], At[m][k], acc[ai][bj][m][n], 0, 0, 0); __builtin_amdgcn_s_setprio(0); } while (0)
#define PG8_WAIT_V(n) asm volatile("s_waitcnt vmcnt(" #n ")" ::: "memory")
#define PG8_WAIT_L(n) asm volatile("s_waitcnt lgkmcnt(" #n ")" ::: "memory")
#define PG8_BAR __builtin_amdgcn_s_barrier()
#define PG8_SCHED __builtin_amdgcn_sched_barrier(0)
    Unit cur, nxt; int ui = 0;
    if (!S.next(0, cur)) return;
    f32x4 acc[2][2][4][2];
#pragma unroll
    for (int a = 0; a < 2; ++a)
#pragma unroll
        for (int b = 0; b < 2; ++b)
#pragma unroll
            for (int m = 0; m < 4; ++m)
#pragma unroll
                for (int n = 0; n < 2; ++n) acc[a][b][m][n] = (f32x4){0.f, 0.f, 0.f, 0.f};
    bf16x8 At[4][2], B0[2][2], B1[2][2];
    const char* cA = GATHER ? (const char*)g.A : (const char*)g.A + (size_t)cur.pm * tstep; const char* cB = (const char*)g.Bt + (size_t)cur.e * g.ebytes + (size_t)cur.pn * tstep;
    PG8_GLOAD(gA, cur.pm);
    if constexpr (SP2) {
        PG8_STAGE(PG8_SB(0, 0), cB, voffA); PG8_STAGE(PG8_SB(0, 1), cB + hstep, voffA); PG8_STAGE_A(PG8_SA(0, 0), cA, 0, false); PG8_STAGE_A(PG8_SA(0, 1), cA, 1, false);
        if (wr == 1) PG8_BAR;
        PG8_WAIT_V(2); PG8_BAR;
        PG8_STAGE(PG8_SB(1, 0), cB + kstep, voffA); PG8_STAGE_A(PG8_SA(1, 0), cA + kstep, 0, false); PG8_STAGE(PG8_SB(1, 1), cB + hstep + kstep, voffA);
        PG8_WAIT_V(6); PG8_BAR;
    } else {
    PG8_STAGE(PG8_SB(0, 0), cB, voffA); PG8_STAGE_A(PG8_SA(0, 0), cA, 0, false); PG8_STAGE(PG8_SB(0, 1), cB + hstep, voffA); PG8_STAGE_A(PG8_SA(0, 1), cA, 1, false);
    if (wr == 1) PG8_BAR;
    PG8_WAIT_V(4); PG8_BAR;
    PG8_STAGE(PG8_SB(1, 0), cB + kstep, voffA); PG8_STAGE_A(PG8_SA(1, 0), cA + kstep, 0, false); PG8_STAGE(PG8_SB(1, 1), cB + hstep + kstep, voffA);
    PG8_WAIT_V(6); PG8_BAR;
    }
    for (;;) {
        const bool has_next = S.next(ui + 1, nxt);
        const char* nA = GATHER ? cA : (has_next ? (const char*)g.A + (size_t)nxt.pm * tstep : cA); const char* nB = has_next ? (const char*)g.Bt + (size_t)nxt.e * g.ebytes + (size_t)nxt.pn * tstep : cB;
        PG8_GLOAD(gN, nxt.pm);
        for (int t = 0; t < nt; t += 2) {
            const bool last = (t == nt - 2);
            const char* a1 = cA + (size_t)(t + 1) * kstep;
            const char* a2 = last ? nA : cA + (size_t)(t + 2) * kstep; const char* b2 = last ? nB : cB + (size_t)(t + 2) * kstep;
            const char* a3 = a2 + kstep; const char* b3 = b2 + kstep;
            if constexpr (SP2) {
            PG8_LDB(B0, 0, 0); PG8_LDB(B1, 0, 1); PG8_SCHED; PG8_LDA(At, 0, 0); PG8_STAGE_A(PG8_SA(1, 1), a1, 1, false);
            PG8_WAIT_V(8); PG8_WAIT_L(0); PG8_BAR; PG8_MMA(0, 0, At, B0); PG8_MMA(0, 1, At, B1); PG8_BAR; PG8_SCHED;
            PG8_LDA(At, 0, 1); PG8_STAGE(PG8_SB(0, 0), b2, voffA); PG8_STAGE(PG8_SB(0, 1), b2 + hstep, voffA); PG8_STAGE_A(PG8_SA(0, 0), a2, 0, last);
            PG8_WAIT_V(8); PG8_WAIT_L(0); PG8_BAR; PG8_MMA(1, 0, At, B0); PG8_MMA(1, 1, At, B1); PG8_BAR; PG8_SCHED;
            PG8_LDB(B0, 1, 0); PG8_LDB(B1, 1, 1); PG8_SCHED; PG8_LDA(At, 1, 0); PG8_STAGE_A(PG8_SA(0, 1), a2, 1, last);
            PG8_WAIT_V(8); PG8_WAIT_L(0); PG8_BAR; PG8_MMA(0, 0, At, B0); PG8_MMA(0, 1, At, B1); PG8_BAR; PG8_SCHED;
            PG8_LDA(At, 1, 1); PG8_STAGE(PG8_SB(1, 0), b3, voffA); PG8_STAGE(PG8_SB(1, 1), b3 + hstep, voffA); PG8_STAGE_A(PG8_SA(1, 0), a3, 0, last);
            PG8_WAIT_V(8); PG8_WAIT_L(0); PG8_BAR; PG8_MMA(1, 0, At, B0); PG8_MMA(1, 1, At, B1); PG8_BAR; PG8_SCHED;
            } else {
            PG8_LDB(B0, 0, 0); PG8_SCHED; PG8_LDA(At, 0, 0); PG8_STAGE_A(PG8_SA(1, 1), a1, 1, false);
            PG8_WAIT_L(8); PG8_BAR; PG8_WAIT_L(0); PG8_MMA(0, 0, At, B0); PG8_BAR; PG8_SCHED;
            PG8_LDB(B1, 0, 1); PG8_STAGE(PG8_SB(0, 0), b2, voffA);
            PG8_BAR; PG8_WAIT_L(0); PG8_MMA(0, 1, At, B1); PG8_BAR;
            PG8_LDA(At, 0, 1); PG8_STAGE_A(PG8_SA(0, 0), a2, 0, last);
            PG8_BAR; PG8_WAIT_L(0); PG8_MMA(1, 0, At, B0); PG8_BAR; PG8_SCHED;
            PG8_STAGE(PG8_SB(0, 1), b2 + hstep, voffA);
            PG8_WAIT_V(6); PG8_BAR; PG8_MMA(1, 1, At, B1); PG8_BAR;
            PG8_LDB(B0, 1, 0); PG8_SCHED; PG8_LDA(At, 1, 0); PG8_STAGE_A(PG8_SA(0, 1), a2, 1, last);
            PG8_WAIT_L(8); PG8_BAR; PG8_WAIT_L(0); PG8_MMA(0, 0, At, B0); PG8_BAR; PG8_SCHED;
            PG8_LDB(B1, 1, 1); PG8_STAGE(PG8_SB(1, 0), b3, voffA);
            PG8_BAR; PG8_WAIT_L(0); PG8_MMA(0, 1, At, B1); PG8_BAR;
            PG8_LDA(At, 1, 1); PG8_STAGE_A(PG8_SA(1, 0), a3, 0, last);
            PG8_BAR; PG8_WAIT_L(0); PG8_MMA(1, 0, At, B0); PG8_BAR; PG8_SCHED;
            PG8_STAGE(PG8_SB(1, 1), b3 + hstep, voffA);
            PG8_WAIT_V(6); PG8_BAR; PG8_MMA(1, 1, At, B1); PG8_BAR;
            }
        }
        if constexpr (ALIGN_EPI) { if (wr == 0) PG8_BAR; }
        E(acc, cur, wr, wc, fr, fq);
        if (!has_next) break;
#pragma unroll
        for (int a = 0; a < 2; ++a)
#pragma unroll
            for (int b = 0; b < 2; ++b)
#pragma unroll
                for (int m = 0; m < 4; ++m)
#pragma unroll
                    for (int n = 0; n < 2; ++n) acc[a][b][m][n] = (f32x4){0.f, 0.f, 0.f, 0.f};
        cur = nxt; cA = nA; cB = nB; ++ui;
        if constexpr (GATHER) { _Pragma("unroll") for (int _h = 0; _h < 2; ++_h) _Pragma("unroll") for (int _i = 0; _i < 2; ++_i) gA[_h][_i] = gN[_h][_i]; }
        if constexpr (ALIGN_EPI) { if (wr == 1) PG8_BAR; }
    }
    PG8_WAIT_V(0);
    if constexpr (!ALIGN_EPI) { if (wr == 0) PG8_BAR; }
    PG8_BAR;
#undef PG8_SA
#undef PG8_SB
#undef PG8_STAGE
#undef PG8_STAGE_A
#undef PG8_GLOAD
#undef PG8_LDA
#undef PG8_LDB
#undef PG8_MMA
#undef PG8_WAIT_V
#undef PG8_WAIT_L
#undef PG8_BAR
#undef PG8_SCHED
}
}

constexpr int NIN = 39;
constexpr int LDS_STAGE = 131072;
constexpr int LDS_MISC = LDS_STAGE;
constexpr int LDS_BYTES = LDS_STAGE + 1024;
struct Args { const float* in[NIN]; float* out; unsigned char* ws; int ph_lo, ph_hi; };
enum { I_X = 0, I_WIN, I_WOUT, I_NMIX, I_NFFN, I_NFIN, I_HGLB, I_HGNW, I_SCW, I_SCB, I_SDTB, I_SALOG, I_SD, I_SNW, I_RCW, I_RCB, I_RWA, I_RBA, I_RWX, I_RBX, I_RLAM,
       I_WMU, I_WW0, I_WW2, I_WA0, I_WA2, I_WG2, I_WKK, I_WKA, I_WRK, I_WLNW, I_WLNB, I_RGW, I_RGB, I_REW, I_REB, I_MG, I_MU, I_MD };

__device__ __forceinline__ float bf2f(bf16_t x) { return __uint_as_float(((unsigned)x) << 16); }
struct BfPtr {
    const bf16_t* p;
    __device__ __forceinline__ float operator[](long i) const { return bf2f(p[i]); }
    __device__ __forceinline__ BfPtr operator+(long o) const { return BfPtr{p + o}; }
};
struct Frame {
    const float* const* in; float* h; unsigned char* ws; unsigned char* lds;
    int G, bid;
    BfPtr P; bf16_t* Pw; float* Q; float* O; bf16_t* U; bf16_t* MIX; bf16_t* XPERM; bf16_t* HID; bf16_t* Y;
    unsigned* ctl; unsigned char* tab;
};

__device__ __forceinline__ void tconv_tile256(float* sm, const float* __restrict__ src, int N, int k0, int n0, int nlim, bf16_t* dstA, bf16_t* dstB, int K, int tid) {
    {
        const int r = tid >> 6, c4 = (tid & 63) * 4; const int n = n0 + c4;
        f32x4 v[8];
#pragma unroll
        for (int it = 0; it < 8; ++it) { v[it] = (f32x4){0.f, 0.f, 0.f, 0.f}; if (n < nlim) v[it] = *(const f32x4*)(src + (size_t)(k0 + r + 8 * it) * N + n); }
#pragma unroll
        for (int it = 0; it < 8; ++it) *(f32x4*)(sm + (r + 8 * it) * 260 + c4) = v[it];
    }
    __syncthreads();
    {
        const int kq = (tid & 7) * 8;
#pragma unroll
        for (int ps = 0; ps < 4; ++ps) {
            const int n = (tid >> 3) + 64 * ps;
            float v[8];
#pragma unroll
            for (int i = 0; i < 8; ++i) v[i] = sm[(kq + i) * 260 + n];
            u32x4 w; w.x = cvt_pk_bf16(v[0], v[1]); w.y = cvt_pk_bf16(v[2], v[3]); w.z = cvt_pk_bf16(v[4], v[5]); w.w = cvt_pk_bf16(v[6], v[7]);
            bf16_t* dst = (n < 128) ? dstA + (size_t)n * K : dstB + (size_t)(n - 128) * K;
            *(u32x4*)(dst + k0 + kq) = w;
        }
    }
    __syncthreads();
}

constexpr int DEFER_TILES = 1152, DEFER_GEMM = 1536, DEFER_MOE = 384;
constexpr int DEFER_ALL = DEFER_TILES + DEFER_GEMM + 3 * DEFER_MOE;
__device__ __forceinline__ void conv_down_tile(const Frame& F, int q, int tid_) {
    const int le = q / 128, r = q % 128, kt = r / 8, ntl = r % 8;
    bf16_t* d = (bf16_t*)(F.ws + WS_WD) + ((size_t)le * D + ntl * 256) * DEXP;
    tconv_tile256((float*)F.lds, F.in[I_MD] + (size_t)le * DEXP * D, D, kt * 64, ntl * 256, D, d, d + (size_t)128 * DEXP, DEXP, tid_);
}
__device__ __forceinline__ void phase_prologue(const Frame& F) {
    const int tid_ = opaque_tid();
    float* sm = (float*)F.lds;
    constexpr int T_IN = 2 * 32 * 26, T_OUT = 2 * 32 * 8, T_G = 64 * 32 * 4, T_D = 64 * 16 * 8;
    constexpr int T_ALL = T_IN + T_OUT + 2 * T_G + T_D;
    for (int t = F.bid; t < T_ALL - DEFER_ALL; t += F.G) {
        if (t < T_IN) {
            const int l = t / (32 * 26), r = t % (32 * 26), kt = r / 26, ntl = r % 26;
            bf16_t* d = (bf16_t*)(F.ws + WS_WIN) + ((size_t)l * PS + ntl * 256) * D;
            tconv_tile256(sm, F.in[I_WIN] + (size_t)l * D * IN_COLS, IN_COLS, kt * 64, ntl * 256, IN_COLS, d, d + (size_t)128 * D, D, tid_);
        } else if (t < T_IN + T_OUT) {
            const int q = t - T_IN; const int l = q / 256, r = q % 256, kt = r / 8, ntl = r % 8;
            bf16_t* d = (bf16_t*)(F.ws + WS_WOUT) + ((size_t)l * D + ntl * 256) * D;
            tconv_tile256(sm, F.in[I_WOUT] + (size_t)l * D * D, D, kt * 64, ntl * 256, D, d, d + (size_t)128 * D, D, tid_);
        } else if (t < T_IN + T_OUT + 2 * T_G) {
            int q = t - T_IN - T_OUT; const int sgu = q / T_G; q %= T_G;
            const int le = q / 128, r = q % 128, kt = r / 4, ntl = r % 4;
            const int n0 = ntl * 256;
            bf16_t* d = (bf16_t*)(F.ws + WS_WGU) + ((size_t)le * 2048 + 256 * (n0 >> 7) + 128 * sgu) * D;
            tconv_tile256(sm, F.in[sgu ? I_MU : I_MG] + (size_t)le * D * DEXP, DEXP, kt * 64, n0, DEXP, d, d + (size_t)256 * D, D, tid_);
        } else {
            conv_down_tile(F, t - T_IN - T_OUT - 2 * T_G, tid_);
        }
    }
    for (int e = F.bid * 512 + tid_; e < 2 * 48 * 2048; e += F.G * 512) {
        const int l = e / (48 * 2048), c = (e / 2048) % 48, k = e % 2048;
        float v = 0.f;
        if (c < 4) v = F.in[I_RGW][((size_t)l * D + k) * 4 + c]; else if (c < 36) v = F.in[I_REW][((size_t)l * D + k) * 32 + (c - 4)];
        ((float*)(F.ws + WS_WRT))[e] = v * F.in[I_NFFN][(size_t)l * D + k];
    }
    for (int e = F.bid * 512 + tid_; e < 2 * 294912; e += F.G * 512) {
        const int l = e / 294912; int r = e % 294912;
        bf16_t* sw = (bf16_t*)(F.ws + WS_SW + (size_t)l * SW_LAYER);
        int K, n, k, base;
        if (r < 49152) { base = SW_W2T / 2; K = 96; } else if (r < 98304) { r -= 49152; base = SW_A2T / 2; K = 96; } else if (r < 229376) { r -= 98304; base = SW_G2T / 2; K = 256; }
        else if (r < 262144) { r -= 229376; base = SW_WAT / 2; K = 64; } else { r -= 262144; base = SW_WXT / 2; K = 64; }
        { const int j = r & 7, ln = (r >> 3) & 63, blk = r >> 9, KS = K / 32, nt = blk / KS, ks = blk % KS; n = nt * 16 + (ln & 15); k = ks * 32 + (ln >> 4) * 8 + j; }
        float v;
        if (base == (int)(SW_W2T / 2)) v = F.in[I_WW2][((size_t)l * 96 + k) * GW + n];
        else if (base == (int)(SW_A2T / 2)) v = F.in[I_WA2][((size_t)l * 96 + k) * GW + n];
        else if (base == (int)(SW_G2T / 2)) v = F.in[I_WG2][((size_t)l * 256 + k) * GW + n];
        else if (base == (int)(SW_WAT / 2)) v = F.in[I_RWA][(((size_t)l * 8 + (n >> 6)) * 64 + k) * 64 + (n & 63)];
        else v = F.in[I_RWX][(((size_t)l * 8 + (n >> 6)) * 64 + k) * 64 + (n & 63)];
        sw[base + r] = f2bf(v);
    }
}

__device__ __forceinline__ void phase_norm1(const Frame& F, int mode, const float* __restrict__ w) {
    const int tid_ = opaque_tid(); const int lane_ = tid_ & 63; const int wave_ = __builtin_amdgcn_readfirstlane(tid_ >> 6); (void)lane_; (void)wave_;
    const int gw = F.bid * 8 + wave_, nw = F.G * 8;
    const int* tokslot = (const int*)(F.tab + TAB_TOKSLOT);
    for (int t = gw; t < NTOK; t += nw) {
        float4 v[8];
        const float* src = (mode == 0) ? F.in[I_X] : F.h;
#pragma unroll
        for (int j = 0; j < 8; ++j) v[j] = *(const float4*)(src + (size_t)t * D + 4 * (lane_ + 64 * j));
        if (mode != 0) {
            const int s0 = tokslot[2 * t], s1 = tokslot[2 * t + 1];
#pragma unroll
            for (int j = 0; j < 8; ++j) {
                const u32x2 pa = *(const u32x2*)(F.Y + (size_t)s0 * D + 4 * (lane_ + 64 * j));
                const u32x2 pb = *(const u32x2*)(F.Y + (size_t)s1 * D + 4 * (lane_ + 64 * j));
                v[j].x += __uint_as_float(pa.x << 16) + __uint_as_float(pb.x << 16); v[j].y += __uint_as_float(pa.x & 0xffff0000u) + __uint_as_float(pb.x & 0xffff0000u);
                v[j].z += __uint_as_float(pa.y << 16) + __uint_as_float(pb.y << 16); v[j].w += __uint_as_float(pa.y & 0xffff0000u) + __uint_as_float(pb.y & 0xffff0000u);
            }
        }
        float ss = 0.f;
#pragma unroll
        for (int j = 0; j < 8; ++j) ss += v[j].x * v[j].x + v[j].y * v[j].y + v[j].z * v[j].z + v[j].w * v[j].w;
        ss = wave_sum(ss);
        const float rs = rsqrtf(ss * (1.0f / D) + NORM_EPS);
#pragma unroll
        for (int j = 0; j < 8; ++j) {
            const int c = 4 * (lane_ + 64 * j);
            const float4 wv = *(const float4*)(w + c);
            if (mode == 2) {
                float4 o; o.x = v[j].x * rs * wv.x; o.y = v[j].y * rs * wv.y; o.z = v[j].z * rs * wv.z; o.w = v[j].w * rs * wv.w;
                *(float4*)(F.h + (size_t)t * D + c) = o;
            } else {
                if (mode != 0) *(float4*)(F.h + (size_t)t * D + c) = v[j];
                u32x2 p; p.x = cvt_pk_bf16(v[j].x * rs * wv.x, v[j].y * rs * wv.y); p.y = cvt_pk_bf16(v[j].z * rs * wv.z, v[j].w * rs * wv.w);
                *(u32x2*)(F.U + (size_t)t * D + c) = p;
            }
        }
    }
}


template <int K>
__device__ __forceinline__ f32x4 mma16(const bf16_t* A, int lda, const bf16_t* Bt, int ldb, int lane, f32x4 acc);
__device__ __forceinline__ u32x4 pack8(const float (&v)[8]);
__device__ __forceinline__ float bflo(unsigned u) { return __uint_as_float(u << 16); }
__device__ __forceinline__ float bfhi(unsigned u) { return __uint_as_float(u & 0xffff0000u); }
__device__ __forceinline__ float bfel(const u32x4 r, int e) { const unsigned u = (e < 2) ? r.x : (e < 4) ? r.y : (e < 6) ? r.z : r.w; return (e & 1) ? bfhi(u) : bflo(u); }
__device__ __forceinline__ void pre_steps14(const Frame& F, int l, int ch) {
    const int tid = opaque_tid();
    bf16_t* XB = (bf16_t*)F.lds;
    bf16_t* AW = (bf16_t*)(F.lds + 66560);
    bf16_t* AA = (bf16_t*)(F.lds + 79872);
    bf16_t* AG = (bf16_t*)(F.lds + 93184);
    const size_t t0 = (size_t)ch * 64; const bool has_prev = (ch & 63) != 0;
    const bf16_t* Pb = F.P.p;
    const u32x4 zero4 = {0u, 0u, 0u, 0u};
    const int tsG = tid >> 6, tsW = tid / 56, j0W = 8 * (tid % 56);
    u32x4 rawG[11], rawW[9];
#pragma unroll
    for (int i = 0; i < 11; ++i) { const int tok = tsG * 8 - 3 + i; rawG[i] = (tok >= 0 || has_prev) ? *(const u32x4*)(Pb + (long)((long)t0 + tok) * PS + C_RG_X + 8 * (tid & 63)) : zero4; }
    if (tid < 448) {
#pragma unroll
        for (int i = 0; i < 9; ++i) { const int tok = tsW * 8 - 1 + i; rawW[i] = (tok >= 0 || has_prev) ? *(const u32x4*)(Pb + (long)((long)t0 + tok) * PS + C_RW + 1536 + j0W) : zero4; }
    }
    {
        const int c0 = 8 * (tid & 127), tq = tid >> 7;
        const float* scw = F.in[I_SCW] + (size_t)l * 4 * 1024 + c0; const float* scb = F.in[I_SCB] + (size_t)l * 1024 + c0;
        u32x4 raw[19];
#pragma unroll
        for (int i = 0; i < 19; ++i) { const int tok = tq * 16 - 3 + i; raw[i] = (tok >= 0 || has_prev) ? *(const u32x4*)(Pb + (long)((long)t0 + tok) * PS + C_SS_X + c0) : zero4; }
        float cw[4][8], cb[8];
#pragma unroll
        for (int k = 0; k < 4; ++k) { const f32x4 a = *(const f32x4*)(scw + k * 1024), b = *(const f32x4*)(scw + k * 1024 + 4);
#pragma unroll
            for (int e = 0; e < 4; ++e) { cw[k][e] = a[e]; cw[k][4 + e] = b[e]; } }
        { const f32x4 a = *(const f32x4*)(scb), b = *(const f32x4*)(scb + 4);
#pragma unroll
            for (int e = 0; e < 4; ++e) { cb[e] = a[e]; cb[4 + e] = b[e]; } }
#pragma unroll
        for (int t = 0; t < 16; ++t) {
            float o[8];
#pragma unroll
            for (int e = 0; e < 8; ++e) o[e] = silu_f(cb[e] + cw[3][e] * bfel(raw[t + 3], e) + cw[2][e] * bfel(raw[t + 2], e) + cw[1][e] * bfel(raw[t + 1], e) + cw[0][e] * bfel(raw[t], e));
            *(u32x4*)((bf16_t*)(F.Q + (t0 + tq * 16 + t) * QS) + c0) = pack8(o);
        }
    }
    {
        const int c0 = 8 * (tid & 63);
        const float* rcw = F.in[I_RCW] + (size_t)l * 4 * GW + c0; const float* rcb = F.in[I_RCB] + (size_t)l * GW + c0;
        float cw[4][8], cb[8];
#pragma unroll
        for (int k = 0; k < 4; ++k) { const f32x4 a = *(const f32x4*)(rcw + k * GW), b = *(const f32x4*)(rcw + k * GW + 4);
#pragma unroll
            for (int e = 0; e < 4; ++e) { cw[k][e] = a[e]; cw[k][4 + e] = b[e]; } }
        { const f32x4 a = *(const f32x4*)(rcb), b = *(const f32x4*)(rcb + 4);
#pragma unroll
            for (int e = 0; e < 4; ++e) { cb[e] = a[e]; cb[4 + e] = b[e]; } }
#pragma unroll
        for (int t = 0; t < 8; ++t) {
            float o[8];
#pragma unroll
            for (int e = 0; e < 8; ++e) o[e] = cb[e] + cw[3][e] * bfel(rawG[t + 3], e) + cw[2][e] * bfel(rawG[t + 2], e) + cw[1][e] * bfel(rawG[t + 1], e) + cw[0][e] * bfel(rawG[t], e);
            *(u32x4*)(XB + (tsG * 8 + t) * 520 + c0) = pack8(o);
        }
    }
    if (tid < 448) {
        const int ts = tsW, j0 = j0W;
        const float* mu = F.in[I_WMU] + (size_t)l * RW_COLS + 1536 + j0;
        float m8[8];
        { const f32x4 a = *(const f32x4*)(mu), b = *(const f32x4*)(mu + 4);
#pragma unroll
            for (int e = 0; e < 4; ++e) { m8[e] = a[e]; m8[4 + e] = b[e]; } }
#pragma unroll
        for (int t = 0; t < 8; ++t) {
            float o[8];
#pragma unroll
            for (int e = 0; e < 8; ++e) { const float cur = bfel(rawW[t + 1], e), prev = bfel(rawW[t], e); const float v = cur + (prev - cur) * m8[e]; o[e] = (j0 < 96) ? ftanh(v) : (j0 < 192) ? v : sigmoid_f(v); }
            const int tt = ts * 8 + t;
            bf16_t* dst = (j0 < 96) ? AW + tt * 104 + j0 : (j0 < 192) ? AA + tt * 104 + (j0 - 96) : AG + tt * 264 + (j0 - 192);
            *(u32x4*)dst = pack8(o);
        }
    }
}
template <int KS>
__device__ __forceinline__ f32x4 mma16f(const bf16_t* A, int lda, const bf16_t* Bf, int lane, f32x4 acc) {
    const bf16_t* ap = A + (lane & 15) * lda + (lane >> 4) * 8; const bf16_t* bp = Bf + lane * 8;
#pragma unroll
    for (int ks = 0; ks < KS; ++ks) { const bf16x8 a = *(const bf16x8*)(ap + ks * 32); const bf16x8 b = *(const bf16x8*)(bp + ks * 512); acc = __builtin_amdgcn_mfma_f32_16x16x32_bf16(a, b, acc, 0, 0, 0); }
    return acc;
}
template <int KS>
__device__ __forceinline__ f32x4 mma16p(const bf16_t* A, int lda, const bf16x8* f, int lane, f32x4 acc) {
    const bf16_t* ap = A + (lane & 15) * lda + (lane >> 4) * 8;
#pragma unroll
    for (int ks = 0; ks < KS; ++ks) { const bf16x8 a = *(const bf16x8*)(ap + ks * 32); acc = __builtin_amdgcn_mfma_f32_16x16x32_bf16(a, f[ks], acc, 0, 0, 0); }
    return acc;
}
__device__ __forceinline__ void store_pair(float* base, int q, int cl, int jj, float va, float vb) {
    const auto sw = __builtin_amdgcn_permlane32_swap(__float_as_uint(va), __float_as_uint(vb), false, false);
    const bool lo = q < 2; const int qq = q & 1, ch = lo ? cl : 16 + cl;
    base[(size_t)(4 * qq + jj) * QS + ch] = __uint_as_float(sw[0]);
    base[(size_t)(4 * (qq + 2) + jj) * QS + ch] = __uint_as_float(sw[1]);
}
__device__ __forceinline__ void pre_5a(const Frame& F, int l, int ch) {
    const int j = opaque_tid(); const int lane = j & 63; const int w = __builtin_amdgcn_readfirstlane(j >> 6);
    bf16_t* XB = (bf16_t*)F.lds;
    bf16_t* AW = (bf16_t*)(F.lds + 66560);
    bf16_t* AA = (bf16_t*)(F.lds + 79872);
    bf16_t* AG = (bf16_t*)(F.lds + 93184);
    const bf16_t* sw = (const bf16_t*)(F.ws + WS_SW + (size_t)l * SW_LAYER);
    const bf16_t* W2T = sw + SW_W2T / 2; const bf16_t* A2T = sw + SW_A2T / 2; const bf16_t* G2T = sw + SW_G2T / 2; const bf16_t* WAT = sw + SW_WAT / 2; const bf16_t* WXT = sw + SW_WXT / 2;
    float lb = 0.f;
    if (l > 0) { const float p0 = F.in[I_HGLB][j], p1 = F.in[I_HGLB][GW + j]; const float m = fmaxf(p0, p1); const float e0 = fexp(p0 - m), e1 = fexp(p1 - m); lb = e1 / (e0 + e1); }
    const float* scw = F.in[I_SCW] + (size_t)l * 4 * 1024; const float* scb = F.in[I_SCB] + (size_t)l * 1024;
    const float* rcw = F.in[I_RCW] + (size_t)l * 4 * GW; const float* rcb = F.in[I_RCB] + (size_t)l * GW;
    const float* mu = F.in[I_WMU] + (size_t)l * RW_COLS;
        const size_t t0 = (size_t)ch * 64;
        const f32x4 z4 = (f32x4){0.f, 0.f, 0.f, 0.f};
        const int cl = lane & 15, rq = 4 * (lane >> 4);
#ifndef SKIP_5A
        {
            int l5 = l; asm volatile("" : "+s"(l5));
            float ba[4], bx[4], spl[4];
#pragma unroll
            for (int n = 0; n < 4; ++n) { const int c = w * 64 + n * 16 + cl; ba[n] = F.in[I_RBA][l5 * GW + c]; bx[n] = F.in[I_RBX][l5 * GW + c]; spl[n] = softplus_f(-F.in[I_RLAM][l5 * GW + c]); }
#pragma unroll
            for (int m = 0; m < 4; ++m)
#pragma unroll
                for (int np = 0; np < 2; ++np) {
                    float av[2][4], uv[2][4];
#pragma unroll
                    for (int h2 = 0; h2 < 2; ++h2) {
                        const int n = 2 * np + h2, c = w * 64 + n * 16 + cl;
                        const f32x4 ra = mma16f<2>(XB + m * 16 * 520 + w * 64, 520, WAT + ((w * 4 + n) * 2) * 512, lane, z4);
                        const f32x4 ri = mma16f<2>(XB + m * 16 * 520 + w * 64, 520, WXT + ((w * 4 + n) * 2) * 512, lane, z4);
#pragma unroll
                        for (int jj = 0; jj < 4; ++jj) {
                            const int t = m * 16 + rq + jj;
                            const float r = sigmoid_f(ra[jj] + ba[n]), ii = sigmoid_f(ri[jj] + bx[n]);
                            const float la = -8.0f * r * spl[n]; av[h2][jj] = fexp(la);
                            uv[h2][jj] = __builtin_amdgcn_sqrtf(1.0f - fexp(2.0f * la)) * (ii * bf2f(XB[t * 520 + c]));
                        }
                    }
                    float* qb = F.Q + (t0 + m * 16) * QS + w * 64 + np * 32;
#pragma unroll
                    for (int jj = 0; jj < 4; ++jj) { store_pair(qb + Q_RGA, lane >> 4, cl, jj, av[0][jj], av[1][jj]); store_pair(qb + Q_RGU, lane >> 4, cl, jj, uv[0][jj], uv[1][jj]); }
                }
        }
#endif
}
__device__ __forceinline__ void pre_5b(const Frame& F, int l, int ch) {
    const int j = opaque_tid(); const int lane = j & 63; const int w = __builtin_amdgcn_readfirstlane(j >> 6);
    bf16_t* XB = (bf16_t*)F.lds;
    bf16_t* AW = (bf16_t*)(F.lds + 66560);
    bf16_t* AA = (bf16_t*)(F.lds + 79872);
    bf16_t* AG = (bf16_t*)(F.lds + 93184);
    const bf16_t* sw = (const bf16_t*)(F.ws + WS_SW + (size_t)l * SW_LAYER);
    const bf16_t* W2T = sw + SW_W2T / 2; const bf16_t* A2T = sw + SW_A2T / 2; const bf16_t* G2T = sw + SW_G2T / 2; const bf16_t* WAT = sw + SW_WAT / 2; const bf16_t* WXT = sw + SW_WXT / 2;
    float lb = 0.f;
    if (l > 0) { const float p0 = F.in[I_HGLB][j], p1 = F.in[I_HGLB][GW + j]; const float m = fmaxf(p0, p1); const float e0 = fexp(p0 - m), e1 = fexp(p1 - m); lb = e1 / (e0 + e1); }
    const float* scw = F.in[I_SCW] + (size_t)l * 4 * 1024; const float* scb = F.in[I_SCB] + (size_t)l * 1024;
    const float* rcw = F.in[I_RCW] + (size_t)l * 4 * GW; const float* rcb = F.in[I_RCB] + (size_t)l * GW;
    const float* mu = F.in[I_WMU] + (size_t)l * RW_COLS;
        const size_t t0 = (size_t)ch * 64;
        const f32x4 z4 = (f32x4){0.f, 0.f, 0.f, 0.f};
        const int cl = lane & 15, rq = 4 * (lane >> 4);
#ifndef SKIP_5B
        {
            int l5 = l; asm volatile("" : "+s"(l5));
            const float* mu5 = F.in[I_WMU] + (size_t)l5 * RW_COLS;
            float kkc[4], mk[4];
#pragma unroll
            for (int n = 0; n < 4; ++n) { const int c = w * 64 + n * 16 + cl; kkc[n] = F.in[I_WKK][l5 * GW + c]; mk[n] = mu5[512 + c]; }
#define PRE5B_LOADW(dst, n_) do { const bf16_t* b2_ = W2T + ((w * 4 + (n_)) * 3) * 512 + lane * 8; \
        _Pragma("unroll") for (int ks_ = 0; ks_ < 3; ++ks_) dst[ks_] = *(const bf16x8*)(b2_ + ks_ * 512); } while (0)
#define PRE5B_LOADA(dst, n_) do { const bf16_t* ba_ = A2T + ((w * 4 + (n_)) * 3) * 512 + lane * 8; \
        _Pragma("unroll") for (int ks_ = 0; ks_ < 3; ++ks_) dst[ks_] = *(const bf16x8*)(ba_ + ks_ * 512); } while (0)
#define PRE5B_LOADG(dst, n_) do { const bf16_t* bg_ = G2T + ((w * 4 + (n_)) * 8) * 512 + lane * 8; \
        _Pragma("unroll") for (int ks_ = 0; ks_ < 8; ++ks_) dst[ks_] = *(const bf16x8*)(bg_ + ks_ * 512); } while (0)
            for (int m = 0; m < 4; ++m) {
                {
                    bf16_t* stg = (bf16_t*)F.lds + w * 4096;
                    const size_t trow0 = t0 + m * 16;
                    const bool hp0 = ((trow0 & (SEQ - 1)) != 0);
#pragma unroll
                    for (int it = 0; it < 7; ++it) {
                        const int seg = it * 8 + (lane >> 3);
                        if (seg < 51) {
                            const int row = seg / 3, grp = seg - row * 3;
                            u32x4 v = {0u, 0u, 0u, 0u};
                            if (row > 0 || hp0) v = *(const u32x4*)(F.P.p + (long)((long)trow0 - 1 + row) * PS + C_RW + grp * 512 + w * 64 + (lane & 7) * 8);
                            *(u32x4*)(stg + row * 196 + grp * 64 + (lane & 7) * 8) = v;
                        }
                    }
                }
                const bf16_t* spb = (const bf16_t*)F.lds + w * 4096 + rq * 196 + cl;
                bf16x8 wa0[3]; PRE5B_LOADW(wa0, 0);
                float inv[4];
                {
                    float ssq[4] = {0.f, 0.f, 0.f, 0.f};
#pragma unroll
                    for (int n = 0; n < 4; ++n) { float kp = bf2f(spb[n * 16 + 64]);
#pragma unroll
                        for (int jj = 0; jj < 4; ++jj) { const float kc = bf2f(spb[(jj + 1) * 196 + n * 16 + 64]); const float x = (kc + (kp - kc) * mk[n]) * kkc[n]; ssq[jj] += x * x; kp = kc; } }
#pragma unroll
                    for (int jj = 0; jj < 4; ++jj) inv[jj] = frcp(fmaxf(__builtin_amdgcn_sqrtf(row16_sum(ssq[jj])), 1e-12f));
                }
#define PRE5B_TILE(n, wac, wan, more) do { const int c = w * 64 + (n) * 16 + cl; bf16x8 fa[3], fg[8]; PRE5B_LOADA(fa, n); PRE5B_LOADG(fg, n); \
        const f32x4 ws = mma16p<3>(AW + m * 16 * 104, 104, wac, lane, z4); \
        if (more) PRE5B_LOADW(wan, (n) + 1); \
        const f32x4 as = mma16p<3>(AA + m * 16 * 104, 104, fa, lane, z4); \
        __builtin_amdgcn_sched_barrier(0); \
        f32x4 gs = mma16p<4>(AG + m * 16 * 264, 264, fg, lane, z4); \
        __builtin_amdgcn_sched_barrier(0); \
        gs = mma16p<4>(AG + m * 16 * 264 + 128, 264, fg + 4, lane, gs); \
        __builtin_amdgcn_sched_barrier(0); \
        const float w0n = F.in[I_WW0][l5 * GW + c], a0n = F.in[I_WA0][l5 * GW + c], kan = F.in[I_WKA][l5 * GW + c]; \
        const bf16_t* spk = (const bf16_t*)F.lds + w * 4096 + rq * 196 + 64 + (n) * 16 + cl; float kprev = bf2f(spk[0]); \
        _Pragma("unroll") for (int jj = 0; jj < 4; ++jj) { \
            const float kcur = bf2f(spk[(jj + 1) * 196]); const float k0v = kcur + (kprev - kcur) * mk[n]; kprev = kcur; \
            const float wlog = -softplus_f(-(w0n + ws[jj])) - 0.5f; const float decay = fexp(-fexp(wlog)); const float a = sigmoid_f(a0n + as[jj]); \
            const float kk = k0v * kkc[n] * inv[jj]; const float k = k0v * (1.0f + (a - 1.0f) * kan); \
            float* q = F.Q + (t0 + m * 16 + rq + jj) * QS; \
            q[Q_W + c] = decay; q[Q_K + c] = k; q[Q_KKA + c] = kk * a; q[Q_G + c] = gs[jj]; } } while (0)
                {
                    bf16x8 wa1[3];
                    PRE5B_TILE(0, wa0, wa1, true);
                    PRE5B_TILE(1, wa1, wa0, true);
                    PRE5B_TILE(2, wa0, wa1, true);
                    PRE5B_TILE(3, wa1, wa0, false);
                }
#undef PRE5B_TILE
            }
#undef PRE5B_LOADW
#undef PRE5B_LOADA
#undef PRE5B_LOADG
        }
#endif
}
__device__ __forceinline__ void phase_pre(const Frame& F, int l) {
    for (int ch = F.bid; ch < NTOK / 64; ch += F.G) { pre_steps14(F, l, ch); __syncthreads(); pre_5a(F, l, ch); pre_5b(F, l, ch); __syncthreads(); }
}


template <int K>
__device__ __forceinline__ f32x4 mma16(const bf16_t* A, int lda, const bf16_t* Bt, int ldb, int lane, f32x4 acc) {
    const int r = lane & 15, kq = (lane >> 4) * 8;
    const bf16_t* ap = A + r * lda + kq; const bf16_t* bp = Bt + r * ldb + kq;
#pragma unroll
    for (int k0 = 0; k0 < K; k0 += 32) {
        const bf16x8 a = *(const bf16x8*)(ap + k0); const bf16x8 b = *(const bf16x8*)(bp + k0);
        acc = __builtin_amdgcn_mfma_f32_16x16x32_bf16(a, b, acc, 0, 0, 0);
    }
    return acc;
}
__device__ __forceinline__ float wave_scan_incl(float v, int lane) {
#pragma unroll
    for (int o = 1; o < 64; o <<= 1) { const float u = __shfl_up(v, o); if (lane >= o) v += u; }
    return v;
}

__device__ __forceinline__ void rg_local(const Frame& F, int u, int tid) {
    const int b = u >> 6, c = u & 63; const size_t t0 = (size_t)b * SEQ + c * 64;
    float* rgc = (float*)(F.ws + WS_R4 + R4_RGC);
    float ap = 1.f, h = 0.f;
#pragma unroll 1
    for (int tb = 0; tb < 64; tb += 32) {
        float a[32], uu[32];
#pragma unroll
        for (int i = 0; i < 32; ++i) { a[i] = F.Q[(t0 + tb + i) * QS + Q_RGA + tid]; uu[i] = F.Q[(t0 + tb + i) * QS + Q_RGU + tid]; }
#pragma unroll
        for (int i = 0; i < 32; ++i) { h = a[i] * h + uu[i]; ap *= a[i]; }
    }
    rgc[((size_t)u * 512 + tid) * 2] = ap; rgc[((size_t)u * 512 + tid) * 2 + 1] = h;
}
__device__ __forceinline__ void rg_scan(const Frame& F, int e) {
    const int b = e >> 9, j = e & 511;
    float* rgc = (float*)(F.ws + WS_R4 + R4_RGC);
    float h = 0.f;
    for (int c = 0; c < 64; ++c) { float* p = rgc + ((size_t)(b * 64 + c) * 512 + j) * 2; const float ap = p[0], he = p[1]; p[1] = h; h = ap * h + he; }
}
__device__ __forceinline__ void rg_out(const Frame& F, int u, int tid) {
    const int b = u >> 6, c = u & 63; const size_t t0 = (size_t)b * SEQ + c * 64;
    const float* rgc = (const float*)(F.ws + WS_R4 + R4_RGC);
    float h = rgc[((size_t)u * 512 + tid) * 2 + 1];
#pragma unroll 1
    for (int tb = 0; tb < 64; tb += 32) {
        float a[32], uu[32], gt[32];
#pragma unroll
        for (int i = 0; i < 32; ++i) { a[i] = F.Q[(t0 + tb + i) * QS + Q_RGA + tid]; uu[i] = F.Q[(t0 + tb + i) * QS + Q_RGU + tid]; gt[i] = F.P[(t0 + tb + i) * PS + C_RG_G + tid]; }
#pragma unroll
        for (int i = 0; i < 32; ++i) { h = a[i] * h + uu[i]; F.MIX[(t0 + tb + i) * D + 1024 + tid] = f2bf(h * gelu_tanh_f(gt[i])); }
    }
}

__device__ __forceinline__ void ssd_acum(const Frame& F, int l, size_t t0, int g, float* acum, int tid) {
    const int lane = tid & 63, w = tid >> 6;
    if (w < 4) {
        const int head = 4 * g + w;
        const float A = -fexp(F.in[I_SALOG][l * 8 + head]);
        const float dtv = softplus_f(F.P[(t0 + lane) * PS + C_SS_DT + head] + F.in[I_SDTB][l * 8 + head]);
        acum[256 + w * 64 + lane] = dtv;
        acum[w * 64 + lane] = wave_scan_incl(dtv * A, lane);
    }
}
__device__ __forceinline__ void ssd_local(const Frame& F, int l, int u, int tid) {
    const int g = u & 1, c = (u >> 1) & 63, b = u >> 7; const size_t t0 = (size_t)b * SEQ + c * 64;
    const int lane = tid & 63, w = __builtin_amdgcn_readfirstlane(tid >> 6);
    float* acum = (float*)F.lds;
    bf16_t* BmT = (bf16_t*)(F.lds + 2048);
    bf16_t* XW = (bf16_t*)(F.lds + 2048 + 18432);
    ssd_acum(F, l, t0, g, acum, tid);
    LDS_BARRIER();
    if (tid < 256) {
        const int hh = tid >> 6, p = tid & 63, head = 4 * g + hh;
        const float aend = acum[hh * 64 + 63];
#pragma unroll
        for (int l8 = 0; l8 < 8; ++l8) {
            float v[8];
#pragma unroll
            for (int i = 0; i < 8; ++i) { const int tt = l8 * 8 + i; const float x = bf2f(((const bf16_t*)(F.Q + (t0 + tt) * QS))[head * 64 + p]); const float dtv = acum[256 + hh * 64 + tt];
                v[i] = x * dtv * fexp(aend - acum[hh * 64 + tt]); }
            u32x4 pk; pk.x = cvt_pk_bf16(v[0], v[1]); pk.y = cvt_pk_bf16(v[2], v[3]); pk.z = cvt_pk_bf16(v[4], v[5]); pk.w = cvt_pk_bf16(v[6], v[7]);
            *(u32x4*)(XW + (hh * 64 + p) * 72 + l8 * 8) = pk;
        }
    } else {
        const int n = tid & 127, lh = (tid - 256) >> 7;
#pragma unroll
        for (int l8 = 0; l8 < 4; ++l8) {
            float v[8];
#pragma unroll
            for (int i = 0; i < 8; ++i) { const int tt = lh * 32 + l8 * 8 + i; v[i] = bf2f(((const bf16_t*)(F.Q + (t0 + tt) * QS))[512 + g * 128 + n]); }
            u32x4 pk; pk.x = cvt_pk_bf16(v[0], v[1]); pk.y = cvt_pk_bf16(v[2], v[3]); pk.z = cvt_pk_bf16(v[4], v[5]); pk.w = cvt_pk_bf16(v[6], v[7]);
            *(u32x4*)(BmT + n * 72 + lh * 32 + l8 * 8) = pk;
        }
    }
    LDS_BARRIER();
    {
        const int hh = w >> 1, head = 4 * g + hh;
        bf16_t* dst = (bf16_t*)(F.ws + WS_R4 + R4_SSS) + ((size_t)(b * 8 + head) * 64 + c) * 8192;
#pragma unroll
        for (int pi = 0; pi < 4; ++pi)
#pragma unroll
            for (int nn = 0; nn < 4; ++nn) {
                const int ni = (w & 1) * 4 + nn;
                const f32x4 acc = mma16<64>(BmT + ni * 16 * 72, 72, XW + (hh * 64 + pi * 16) * 72, 72, lane, (f32x4){0.f, 0.f, 0.f, 0.f});
                u32x2 pk; pk.x = cvt_pk_bf16(acc[0], acc[1]); pk.y = cvt_pk_bf16(acc[2], acc[3]);
                *(u32x2*)(dst + (pi * 16 + (lane & 15)) * 128 + ni * 16 + 4 * (lane >> 4)) = pk;
            }
        if (tid < 4) ((float*)(F.ws + WS_R4 + R4_SSD))[(size_t)(b * 8 + 4 * g + tid) * 64 + c] = fexp(acum[tid * 64 + 63]);
    }
    LDS_BARRIER();
}
__device__ __forceinline__ void ssd_scan(const Frame& F, int e) {
    const int bh = e >> 13, r = e & 8191;
    bf16_t* st = (bf16_t*)(F.ws + WS_R4 + R4_SSS) + (size_t)bh * 64 * 8192 + r; const float* dec = (const float*)(F.ws + WS_R4 + R4_SSD) + bh * 64;
    float h = 0.f;
    for (int c0 = 0; c0 < 64; c0 += 16) {
        float tmp[16], dd[16];
#pragma unroll
        for (int i = 0; i < 16; ++i) { tmp[i] = bf2f(st[(size_t)(c0 + i) * 8192]); dd[i] = dec[c0 + i]; }
#pragma unroll
        for (int i = 0; i < 16; ++i) { st[(size_t)(c0 + i) * 8192] = f2bf(h); h = h * dd[i] + tmp[i]; }
    }
}
__device__ __forceinline__ void ssd_out(const Frame& F, int l, int u, int tid) {
    const int g = u & 1, c = (u >> 1) & 63, b = u >> 7; const size_t t0 = (size_t)b * SEQ + c * 64;
    const int lane = tid & 63, w = __builtin_amdgcn_readfirstlane(tid >> 6);
    float* acum = (float*)F.lds;
    bf16_t* Cm = (bf16_t*)(F.lds + 2048);
    bf16_t* Bm = (bf16_t*)(F.lds + 19456);
    bf16_t* XT = (bf16_t*)(F.lds + 36864);
    bf16_t* PV = (bf16_t*)(F.lds + 46080);
    bf16_t* Mh = (bf16_t*)(F.lds + 63488);
    bf16_t* XS = (bf16_t*)(F.lds + 72704);
    ssd_acum(F, l, t0, g, acum, tid);
    const int row8 = tid >> 3, seg8 = tid & 7;
    {
        const bf16_t* qrow = (const bf16_t*)(F.Q + (t0 + row8) * QS);
#pragma unroll
        for (int hf = 0; hf < 2; ++hf) {
            *(u32x4*)(Bm + row8 * 136 + (seg8 + 8 * hf) * 8) = *(const u32x4*)(qrow + 512 + g * 128 + (seg8 + 8 * hf) * 8);
            *(u32x4*)(Cm + row8 * 136 + (seg8 + 8 * hf) * 8) = *(const u32x4*)(qrow + 768 + g * 128 + (seg8 + 8 * hf) * 8);
        }
#pragma unroll
        for (int it = 0; it < 4; ++it) *(u32x4*)(XS + row8 * 264 + (seg8 + 8 * it) * 8) = *(const u32x4*)(qrow + g * 256 + (seg8 + 8 * it) * 8);
    }
    u32x4 pv[2];
    { const bf16_t* src = (const bf16_t*)(F.ws + WS_R4 + R4_SSS) + ((size_t)(b * 8 + 4 * g) * 64 + c) * 8192 + row8 * 128;
      pv[0] = *(const u32x4*)(src + seg8 * 8); pv[1] = *(const u32x4*)(src + (seg8 + 8) * 8); }
    LDS_BARRIER();
    const int ti = w >> 1, sj0 = 2 * (w & 1);
    f32x4 cb[2];
#pragma unroll
    for (int q = 0; q < 2; ++q) cb[q] = mma16<128>(Cm + ti * 16 * 136, 136, Bm + (sj0 + q) * 16 * 136, 136, lane, (f32x4){0.f, 0.f, 0.f, 0.f});
    for (int hh = 0; hh < 4; ++hh) {
        const int head = 4 * g + hh;
#pragma unroll
        for (int q = 0; q < 2; ++q)
#pragma unroll
            for (int j = 0; j < 4; ++j) {
                const int lrow = ti * 16 + 4 * (lane >> 4) + j, sidx = (sj0 + q) * 16 + (lane & 15);
                const float v = (sidx <= lrow) ? cb[q][j] * fexp(acum[hh * 64 + lrow] - acum[hh * 64 + sidx]) : 0.f;
                Mh[lrow * 72 + sidx] = f2bf(v);
            }
        {
            const int p = tid & 63, sq = tid >> 6;
            float v[8];
#pragma unroll
            for (int i = 0; i < 8; ++i) { const int sidx = sq * 8 + i; v[i] = bf2f(XS[sidx * 264 + hh * 64 + p]) * acum[256 + hh * 64 + sidx]; }
            *(u32x4*)(XT + p * 72 + sq * 8) = pack8(v);
        }
        *(u32x4*)(PV + row8 * 136 + seg8 * 8) = pv[0]; *(u32x4*)(PV + row8 * 136 + (seg8 + 8) * 8) = pv[1];
        if (hh < 3) { const bf16_t* src = (const bf16_t*)(F.ws + WS_R4 + R4_SSS) + ((size_t)(b * 8 + head + 1) * 64 + c) * 8192 + row8 * 128;
            pv[0] = *(const u32x4*)(src + seg8 * 8); pv[1] = *(const u32x4*)(src + (seg8 + 8) * 8); }
        LDS_BARRIER();
        const float Dk = F.in[I_SD][l * 8 + head];
#pragma unroll
        for (int q = 0; q < 2; ++q) {
            const int pj = sj0 + q;
            const f32x4 a1 = mma16<64>(Mh + ti * 16 * 72, 72, XT + pj * 16 * 72, 72, lane, (f32x4){0.f, 0.f, 0.f, 0.f});
            const f32x4 a2 = mma16<128>(Cm + ti * 16 * 136, 136, PV + pj * 16 * 136, 136, lane, (f32x4){0.f, 0.f, 0.f, 0.f});
#pragma unroll
            for (int j = 0; j < 4; ++j) {
                const int lrow = ti * 16 + 4 * (lane >> 4) + j, p = pj * 16 + (lane & 15);
                const float xs = bf2f(XS[lrow * 264 + hh * 64 + p]);
                F.O[(t0 + lrow) * D + 512 + head * 64 + p] = a1[j] + fexp(acum[hh * 64 + lrow]) * a2[j] + Dk * xs;
            }
        }
        LDS_BARRIER();
    }
}


struct HgIn { float fr[16], q[16], v[16]; u32x4 sp[4]; };
__device__ __forceinline__ void hg_load(const Frame& F, int u, int tid, HgIn& x, bool out_phase) {
    const int h = u & 3, c = (u >> 2) & 63, b = u >> 8; const size_t t0 = (size_t)b * SEQ + c * 64;
    const int k = tid & 127, tq = tid >> 7;
#pragma unroll
    for (int i = 0; i < 16; ++i) { const BfPtr p = F.P + (t0 + tq * 16 + i) * PS + h * 128 + k; x.fr[i] = p[C_HG_F]; x.v[i] = p[C_HG_I]; if (out_phase) x.q[i] = p[C_HG_Q]; }
    if (out_phase) {
        const bf16_t* src = (const bf16_t*)(F.ws + WS_R4 + R4_HGS) + ((size_t)(b * 4 + h) * 64 + c) * 16384 + (tid >> 2) * 128;
#pragma unroll
        for (int i8 = 0; i8 < 4; ++i8) x.sp[i8] = *(const u32x4*)(src + (i8 * 4 + (tid & 3)) * 8);
    }
}
__device__ __forceinline__ void hg_cumlog(const Frame& F, int l, int h, float* gt, float (&freg)[16], float (&bown)[16], int tid, const HgIn& x) {
    const int k = tid & 127, tq = tid >> 7;
    float lb = 0.f;
    if (l > 0) { const float p0 = F.in[I_HGLB][h * 128 + k], p1 = F.in[I_HGLB][GW + h * 128 + k]; const float m = fmaxf(p0, p1); const float e0 = fexp(p0 - m), e1 = fexp(p1 - m); lb = e1 * frcp(e0 + e1); }
    float run = 0.f;
#pragma unroll
    for (int i = 0; i < 16; ++i) { const float f = lb + (1.0f - lb) * sigmoid_f(x.fr[i]); freg[i] = f; run += flog(f); bown[i] = run; }
    gt[tq * 128 + k] = run;
    LDS_BARRIER();
    float off = 0.f;
#pragma unroll
    for (int g2 = 0; g2 < 3; ++g2) off += (g2 < tq) ? gt[g2 * 128 + k] : 0.f;
#pragma unroll
    for (int i = 0; i < 16; ++i) bown[i] += off;
}
__device__ __forceinline__ void hg_local(const Frame& F, int l, int u, int tid, const HgIn& x) {
    const int h = u & 3, c = (u >> 2) & 63, b = u >> 8;
    const int lane = tid & 63, w = __builtin_amdgcn_readfirstlane(tid >> 6);
    float* gt = (float*)F.lds;
    bf16_t* kdT = (bf16_t*)(F.lds + 32768);
    bf16_t* vT = (bf16_t*)(F.lds + 51200);
    float freg[16], bown[16];
    hg_cumlog(F, l, h, gt, freg, bown, tid, x);
    {
        const int k = tid & 127, tq = tid >> 7;
        const float bend = gt[k] + gt[128 + k] + gt[256 + k] + gt[384 + k];
        float kd[16];
#pragma unroll
        for (int i = 0; i < 16; ++i) kd[i] = (1.0f - freg[i]) * fexp(bend - bown[i]);
        u32x4 p0, p1;
        p0.x = cvt_pk_bf16(kd[0], kd[1]); p0.y = cvt_pk_bf16(kd[2], kd[3]); p0.z = cvt_pk_bf16(kd[4], kd[5]); p0.w = cvt_pk_bf16(kd[6], kd[7]);
        p1.x = cvt_pk_bf16(kd[8], kd[9]); p1.y = cvt_pk_bf16(kd[10], kd[11]); p1.z = cvt_pk_bf16(kd[12], kd[13]); p1.w = cvt_pk_bf16(kd[14], kd[15]);
        *(u32x4*)(kdT + k * 72 + tq * 16) = p0; *(u32x4*)(kdT + k * 72 + tq * 16 + 8) = p1;
        p0.x = cvt_pk_bf16(x.v[0], x.v[1]); p0.y = cvt_pk_bf16(x.v[2], x.v[3]); p0.z = cvt_pk_bf16(x.v[4], x.v[5]); p0.w = cvt_pk_bf16(x.v[6], x.v[7]);
        p1.x = cvt_pk_bf16(x.v[8], x.v[9]); p1.y = cvt_pk_bf16(x.v[10], x.v[11]); p1.z = cvt_pk_bf16(x.v[12], x.v[13]); p1.w = cvt_pk_bf16(x.v[14], x.v[15]);
        *(u32x4*)(vT + k * 72 + tq * 16) = p0; *(u32x4*)(vT + k * 72 + tq * 16 + 8) = p1;
        if (tq == 0) ((float*)(F.ws + WS_R4 + R4_HGD))[((size_t)(b * 4 + h) * 64 + c) * 128 + k] = fexp(bend);
    }
    LDS_BARRIER();
    {
        bf16_t* dst = (bf16_t*)(F.ws + WS_R4 + R4_HGS) + ((size_t)(b * 4 + h) * 64 + c) * 16384;
#pragma unroll
        for (int ki = 0; ki < 8; ++ki) {
            const f32x4 acc = mma16<64>(kdT + ki * 16 * 72, 72, vT + w * 16 * 72, 72, lane, (f32x4){0.f, 0.f, 0.f, 0.f});
            u32x2 pk; pk.x = cvt_pk_bf16(acc[0], acc[1]); pk.y = cvt_pk_bf16(acc[2], acc[3]);
            *(u32x2*)(dst + (w * 16 + (lane & 15)) * 128 + ki * 16 + 4 * (lane >> 4)) = pk;
        }
    }
    LDS_BARRIER();
}
__device__ __forceinline__ void hg_scan(const Frame& F, int e) {
    const int bh = e >> 14, r = e & 16383, k = r & 127;
    bf16_t* st = (bf16_t*)(F.ws + WS_R4 + R4_HGS) + (size_t)bh * 64 * 16384 + r; const float* dec = (const float*)(F.ws + WS_R4 + R4_HGD) + (size_t)bh * 64 * 128 + k;
    float h = 0.f;
    for (int c0 = 0; c0 < 64; c0 += 16) {
        float tmp[16], dd[16];
#pragma unroll
        for (int i = 0; i < 16; ++i) { tmp[i] = bf2f(st[(size_t)(c0 + i) * 16384]); dd[i] = dec[(c0 + i) * 128]; }
#pragma unroll
        for (int i = 0; i < 16; ++i) { st[(size_t)(c0 + i) * 16384] = f2bf(h); h = h * dd[i] + tmp[i]; }
    }
}
__device__ __forceinline__ void hg_out(const Frame& F, int l, int u, int tid, const HgIn& x) {
    const int h = u & 3, c = (u >> 2) & 63, b = u >> 8; const size_t t0 = (size_t)b * SEQ + c * 64;
    const int lane = tid & 63, w = __builtin_amdgcn_readfirstlane(tid >> 6);
    float* gt = (float*)F.lds;
    bf16_t* Sc = (bf16_t*)F.lds;
    bf16_t* qh = (bf16_t*)(F.lds + 32768);
    bf16_t* kh = (bf16_t*)(F.lds + 50176);
    bf16_t* vT = (bf16_t*)(F.lds + 67584);
    bf16_t* Sp = (bf16_t*)(F.lds + 86016);
    float freg[16], bown[16];
    hg_cumlog(F, l, h, gt, freg, bown, tid, x);
    {
        const int k = tid & 127, tq = tid >> 7;
        const float m = gt[k] + gt[128 + k];
#pragma unroll
        for (int i = 0; i < 16; ++i) {
            const int t = tq * 16 + i; const float bb = bown[i];
            qh[t * 136 + k] = f2bf(silu_f(x.q[i]) * fexp(bb - m)); kh[t * 136 + k] = f2bf((1.0f - freg[i]) * fexp(m - bb));
        }
        u32x4 p0, p1;
        p0.x = cvt_pk_bf16(x.v[0], x.v[1]); p0.y = cvt_pk_bf16(x.v[2], x.v[3]); p0.z = cvt_pk_bf16(x.v[4], x.v[5]); p0.w = cvt_pk_bf16(x.v[6], x.v[7]);
        p1.x = cvt_pk_bf16(x.v[8], x.v[9]); p1.y = cvt_pk_bf16(x.v[10], x.v[11]); p1.z = cvt_pk_bf16(x.v[12], x.v[13]); p1.w = cvt_pk_bf16(x.v[14], x.v[15]);
        *(u32x4*)(vT + k * 72 + tq * 16) = p0; *(u32x4*)(vT + k * 72 + tq * 16 + 8) = p1;
        const int v = tid >> 2;
#pragma unroll
        for (int i8 = 0; i8 < 4; ++i8) {
            const u32x4 raw = x.sp[i8]; const int kq = (i8 * 4 + (tid & 3)) * 8 - i8 * 8;
            float mm[8];
#pragma unroll
            for (int e = 0; e < 8; ++e) mm[e] = gt[kq + i8 * 8 + e] + gt[128 + kq + i8 * 8 + e];
            u32x4 pk; pk.x = cvt_pk_bf16(__uint_as_float(raw.x << 16) * fexp(mm[0]), __uint_as_float(raw.x & 0xffff0000u) * fexp(mm[1])); pk.y = cvt_pk_bf16(__uint_as_float(raw.y << 16) * fexp(mm[2]), __uint_as_float(raw.y & 0xffff0000u) * fexp(mm[3]));
            pk.z = cvt_pk_bf16(__uint_as_float(raw.z << 16) * fexp(mm[4]), __uint_as_float(raw.z & 0xffff0000u) * fexp(mm[5])); pk.w = cvt_pk_bf16(__uint_as_float(raw.w << 16) * fexp(mm[6]), __uint_as_float(raw.w & 0xffff0000u) * fexp(mm[7]));
            *(u32x4*)(Sp + v * 136 + kq + i8 * 8) = pk;
        }
    }
    LDS_BARRIER();
    const int ti = w >> 1;
    {
        f32x4 sc[2];
#pragma unroll
        for (int q = 0; q < 2; ++q) sc[q] = mma16<128>(qh + ti * 16 * 136, 136, kh + (2 * (w & 1) + q) * 16 * 136, 136, lane, (f32x4){0.f, 0.f, 0.f, 0.f});
#pragma unroll
        for (int q = 0; q < 2; ++q)
#pragma unroll
            for (int j = 0; j < 4; ++j) {
                const int t = ti * 16 + 4 * (lane >> 4) + j, sidx = (2 * (w & 1) + q) * 16 + (lane & 15);
                Sc[t * 72 + sidx] = f2bf(sidx <= t ? sc[q][j] : 0.f);
            }
    }
    LDS_BARRIER();
#pragma unroll
    for (int q = 0; q < 4; ++q) {
        const int vj = (w & 1) * 4 + q;
        f32x4 acc = mma16<64>(Sc + ti * 16 * 72, 72, vT + vj * 16 * 72, 72, lane, (f32x4){0.f, 0.f, 0.f, 0.f});
        acc = mma16<128>(qh + ti * 16 * 136, 136, Sp + vj * 16 * 136, 136, lane, acc);
#pragma unroll
        for (int j = 0; j < 4; ++j) F.O[(t0 + ti * 16 + 4 * (lane >> 4) + j) * D + h * 128 + vj * 16 + (lane & 15)] = acc[j];
    }
    LDS_BARRIER();
}


__device__ __forceinline__ u32x2 pack4(const f32x4 v) { u32x2 p; p.x = cvt_pk_bf16(v[0], v[1]); p.y = cvt_pk_bf16(v[2], v[3]); return p; }
__device__ __forceinline__ f32x4 unpack4(const u32x2 p) { f32x4 v; v[0] = __uint_as_float(p.x << 16); v[1] = __uint_as_float(p.x & 0xffff0000u); v[2] = __uint_as_float(p.y << 16); v[3] = __uint_as_float(p.y & 0xffff0000u); return v; }
__device__ __forceinline__ u32x4 pack8(const float (&v)[8]) { u32x4 p; p.x = cvt_pk_bf16(v[0], v[1]); p.y = cvt_pk_bf16(v[2], v[3]); p.z = cvt_pk_bf16(v[4], v[5]); p.w = cvt_pk_bf16(v[6], v[7]); return p; }

struct RwRaw { float w[8], kka[8], k[8]; bf16_t pr[9], pk[9], pv[9]; };
struct RwIn { float w[8], kk[8], r[8], kka[8], k[8], v[8]; };
__device__ __forceinline__ void rw_load(const Frame& F, int b, int c, int h, int tid, RwRaw& x) {
    const size_t t0 = (size_t)b * SEQ + c * 64; const int k = tid & 63, ig = tid >> 6;
#pragma unroll
    for (int ii = 0; ii < 8; ++ii) { const float* q = F.Q + (t0 + ig * 8 + ii) * QS + h * 64 + k; x.w[ii] = q[Q_W]; x.kka[ii] = q[Q_KKA]; x.k[ii] = q[Q_K]; }
    const bool first = (ig == 0) && (c == 0);
#pragma unroll
    for (int j = 0; j < 9; ++j) { const bf16_t* p = F.P.p + (long)((long)t0 + ig * 8 - 1 + j) * PS + C_RW + h * 64 + k;
        const bool z = first && (j == 0); x.pr[j] = z ? (bf16_t)0 : p[0]; x.pk[j] = z ? (bf16_t)0 : p[512]; x.pv[j] = z ? (bf16_t)0 : p[1024]; }
}
__device__ __forceinline__ void rw_finish(const Frame& F, int l, int h, int tid, const RwRaw& a, RwIn& x) {
    const int k = tid & 63; const float* mu = F.in[I_WMU] + (size_t)l * RW_COLS + h * 64 + k;
    const float mr = mu[0], mkk = mu[512], mv = mu[1024], kkc = F.in[I_WKK][l * GW + h * 64 + k];
#pragma unroll
    for (int ii = 0; ii < 8; ++ii) {
        const float rc = bf2f(a.pr[ii + 1]), rp = bf2f(a.pr[ii]), kc = bf2f(a.pk[ii + 1]), kp = bf2f(a.pk[ii]), vc = bf2f(a.pv[ii + 1]), vp = bf2f(a.pv[ii]);
        x.r[ii] = rc + (rp - rc) * mr; x.v[ii] = vc + (vp - vc) * mv;
        const float kx = (kc + (kp - kc) * mkk) * kkc; const float ss = wave_sum(kx * kx);
        x.kk[ii] = kx * frcp(fmaxf(__builtin_amdgcn_sqrtf(ss), 1e-12f));
        x.w[ii] = a.w[ii]; x.kka[ii] = a.kka[ii]; x.k[ii] = a.k[ii];
    }
}
__device__ __forceinline__ void rw_prep(const Frame& F, int l, int b, int c, int h, int tid, const RwIn& x) {
    const int ru = (b * 64 + c) * 8 + h;
    unsigned char* rec = F.ws + WS_U + (size_t)ru * RW_REC;
    float* aabT = (float*)(F.ws + WS_RWAAB) + (size_t)ru * 4096;
    const int lane = tid & 63, w = __builtin_amdgcn_readfirstlane(tid >> 6);
    float* cumL = (float*)F.lds;
    bf16_t* Ar = (bf16_t*)(F.lds + 16640);
    bf16_t* Rr = Ar + 64 * 72; bf16_t* Br = Rr + 64 * 72; bf16_t* Kr = Br + 64 * 72; bf16_t* KrT = Kr + 64 * 72; bf16_t* vT = KrT + 64 * 72; bf16_t* AakT = vT + 64 * 72; bf16_t* ArkT = AakT + 64 * 72;
    const int k = tid & 63, ig = tid >> 6;
    {
        const float rkc = F.in[I_WRK][l * GW + h * 64 + k]; float* bon = (float*)(F.ws + WS_BON) + ((size_t)b * SEQ + c * 64 + ig * 8) * 8 + h;
#pragma unroll
        for (int ii = 0; ii < 8; ++ii) { const float sv = wave_sum(x.r[ii] * x.k[ii] * rkc); if (k == 0) bon[ii * 8] = sv; }
    }
    float pre[8];
    { float run = 0.f;
#pragma unroll
      for (int ii = 0; ii < 8; ++ii) { run += flog(x.w[ii]); pre[ii] = run; }
      cumL[ig * 64 + k] = run; }
    LDS_BARRIER();
    float off = 0.f, tot = 0.f;
#pragma unroll
    for (int g2 = 0; g2 < 8; ++g2) { const float gv = cumL[g2 * 64 + k]; off += (g2 < ig) ? gv : 0.f; tot += gv; }
    {
        float brv[8], krv[8], vvv[8];
#pragma unroll
        for (int ii = 0; ii < 8; ++ii) {
            const int i = ig * 8 + ii;
            const float cu = off + pre[ii]; const float cux = (ii > 0) ? off + pre[ii - 1] : off;
            const float e_in = fexp(cu), e_ex = fexp(cux), e_neg = fexp(-cu);
            const float ar = -x.kk[ii] * e_ex, rr = x.r[ii] * e_in; brv[ii] = x.kka[ii] * e_neg; krv[ii] = x.k[ii] * e_neg; vvv[ii] = x.v[ii];
            const bf16_t arb = f2bf(ar), rrb = f2bf(rr);
            Ar[i * 72 + k] = arb; Rr[i * 72 + k] = rrb; Br[i * 72 + k] = f2bf(brv[ii]); Kr[i * 72 + k] = f2bf(krv[ii]);
            ((bf16_t*)(rec + RO_AR))[i * 64 + k] = arb; ((bf16_t*)(rec + RO_RR))[i * 64 + k] = rrb;
        }
        *(u32x4*)(KrT + k * 72 + ig * 8) = pack8(krv); *(u32x4*)(vT + k * 72 + ig * 8) = pack8(vvv);
        *(u32x4*)((bf16_t*)(rec + RO_BRT) + k * 64 + ig * 8) = pack8(brv);
        if (ig == 0) ((float*)(F.ws + WS_RWGC))[ru * 64 + k] = fexp(tot);
    }
    LDS_BARRIER();
    const int ri = w >> 1, cj0 = 2 * (w & 1);
    const f32x4 z4 = (f32x4){0.f, 0.f, 0.f, 0.f};
#pragma unroll
    for (int q = 0; q < 2; ++q) {
        const int cj = cj0 + q;
        f32x4 aab = mma16<64>(Br + ri * 16 * 72, 72, Ar + cj * 16 * 72, 72, lane, z4);
        f32x4 aak = mma16<64>(Kr + ri * 16 * 72, 72, Ar + cj * 16 * 72, 72, lane, z4);
        f32x4 arb = mma16<64>(Br + ri * 16 * 72, 72, Rr + cj * 16 * 72, 72, lane, z4);
        f32x4 ark = mma16<64>(Kr + ri * 16 * 72, 72, Rr + cj * 16 * 72, 72, lane, z4);
        const int i0 = ri * 16 + 4 * (lane >> 4), t = cj * 16 + (lane & 15);
#pragma unroll
        for (int j = 0; j < 4; ++j) { const bool st = (i0 + j) < t, inc = (i0 + j) <= t; aab[j] = st ? aab[j] : 0.f; aak[j] = st ? aak[j] : 0.f; arb[j] = inc ? arb[j] : 0.f; ark[j] = inc ? ark[j] : 0.f; }
        *(f32x4*)(aabT + t * 64 + i0) = aab;
        *(u32x2*)(AakT + t * 72 + i0) = pack4(aak);
        *(u32x2*)((bf16_t*)(rec + RO_ARBT) + t * 64 + i0) = pack4(arb);
        *(u32x2*)(ArkT + t * 72 + i0) = pack4(ark);
    }
    LDS_BARRIER();
#pragma unroll
    for (int q = 0; q < 2; ++q) {
        const int cj = cj0 + q, tile = ri * 4 + cj;
        const f32x4 xl = mma16<64>(AakT + ri * 16 * 72, 72, vT + cj * 16 * 72, 72, lane, z4);
        const f32x4 lt = mma16<64>(KrT + ri * 16 * 72, 72, vT + cj * 16 * 72, 72, lane, z4);
        const f32x4 yl = mma16<64>(ArkT + ri * 16 * 72, 72, vT + cj * 16 * 72, 72, lane, z4);
        *(u32x2*)(rec + RO_XL + tile * 512 + lane * 8) = pack4(xl);
        *(u32x2*)(rec + RO_LT + tile * 512 + lane * 8) = pack4(lt);
        *(u32x2*)(rec + RO_YL + tile * 512 + lane * 8) = pack4(yl);
    }
    LDS_BARRIER();
}

template <int t> __device__ __forceinline__ void tsolve_step(float (&T)[64], const LAS float* A, int lane) {
    if constexpr (t < 64) {
        float acc = (lane == t) ? 1.0f : 0.0f;
        const LAS float* row = A + t * 64;
        if constexpr (t > 0) asm("" : "+v"(row) : "v"(T[t - 1]));
        const LAS f32x4* row4 = (const LAS f32x4*)row;
#pragma unroll
        for (int i4 = 0; i4 < t / 4; ++i4) { const f32x4 v = row4[i4]; acc += T[4 * i4] * v[0]; acc += T[4 * i4 + 1] * v[1]; acc += T[4 * i4 + 2] * v[2]; acc += T[4 * i4 + 3] * v[3]; }
#pragma unroll
        for (int i = (t / 4) * 4; i < t; ++i) acc += T[i] * row[i];
        T[t] = acc;
        tsolve_step<t + 1>(T, A, lane);
    }
}
__device__ __forceinline__ void rw_tsolve(const Frame& F, int ru, int w, int lane) {
    LAS float* A = (LAS float*)((LAS unsigned char*)F.lds + w * 16384);
    const float* src = (const float*)(F.ws + WS_RWAAB) + (size_t)ru * 4096;
#pragma unroll
    for (int q = 0; q < 16; ++q) *(LAS f32x4*)(A + (q * 64 + lane) * 4) = *(const f32x4*)(src + (q * 64 + lane) * 4);
    float T[64];
    tsolve_step<0>(T, A, lane);
    bf16_t* Tl = (bf16_t*)(F.lds + w * 16384);
#pragma unroll
    for (int i8 = 0; i8 < 8; ++i8) { float v[8];
#pragma unroll
        for (int e = 0; e < 8; ++e) v[e] = T[i8 * 8 + e];
        *(u32x4*)(Tl + lane * 72 + i8 * 8) = pack8(v); }
    unsigned char* rec = F.ws + WS_U + (size_t)ru * RW_REC;
#pragma unroll 1
    for (int which = 0; which < 2; ++which) {
        bf16_t* M = (bf16_t*)(rec + (which ? RO_BRT : RO_ARBT));
#pragma unroll 1
        for (int tt = 0; tt < 4; ++tt) {
            bf16x8 bfr[2];
#pragma unroll
            for (int s2 = 0; s2 < 2; ++s2) bfr[s2] = *(const bf16x8*)(M + (tt * 16 + (lane & 15)) * 64 + (lane >> 4) * 8 + s2 * 32);
            f32x4 acc[4];
#pragma unroll
            for (int jt = 0; jt < 4; ++jt) {
                acc[jt] = (f32x4){0.f, 0.f, 0.f, 0.f};
#pragma unroll
                for (int s2 = 0; s2 < 2; ++s2) { const bf16x8 a = *(const bf16x8*)(Tl + (jt * 16 + (lane & 15)) * 72 + (lane >> 4) * 8 + s2 * 32); acc[jt] = __builtin_amdgcn_mfma_f32_16x16x32_bf16(a, bfr[s2], acc[jt], 0, 0, 0); }
            }
#pragma unroll
            for (int jt = 0; jt < 4; ++jt) *(u32x2*)(M + (tt * 16 + (lane & 15)) * 64 + jt * 16 + 4 * (lane >> 4)) = pack4(acc[jt]);
        }
    }
}

__device__ __forceinline__ f32x4 mma16r(const bf16x8 (&a)[2], const bf16_t* Bt, int ldb, int lane, f32x4 acc) {
    const bf16_t* bp = Bt + (lane & 15) * ldb + (lane >> 4) * 8;
#pragma unroll
    for (int s2 = 0; s2 < 2; ++s2) { const bf16x8 b = *(const bf16x8*)(bp + s2 * 32); acc = __builtin_amdgcn_mfma_f32_16x16x32_bf16(a[s2], b, acc, 0, 0, 0); }
    return acc;
}
struct RwStage { u32x4 a[4]; u32x2 dXl, dLt, dYl; f32x4 gc; };
__device__ __forceinline__ void rw_stage_load(const Frame& F, int b, int h, int cc, int tid, int tile, int lane, int r4, RwStage& S) {
    const int ru = (b * 64 + cc) * 8 + h; const unsigned char* rec = F.ws + WS_U + (size_t)ru * RW_REC;
#pragma unroll
    for (int m = 0; m < 4; ++m) S.a[m] = *(const u32x4*)(rec + m * 8192 + tid * 16);
    S.dXl = *(const u32x2*)(rec + RO_XL + tile * 512 + lane * 8); S.dLt = *(const u32x2*)(rec + RO_LT + tile * 512 + lane * 8); S.dYl = *(const u32x2*)(rec + RO_YL + tile * 512 + lane * 8);
    S.gc = *(const f32x4*)((const float*)(F.ws + WS_RWGC) + ru * 64 + r4);
}
static_assert(RO_AR == 0 && RO_RR == 8192 && RO_BRT == 16384 && RO_ARBT == 24576 && RO_TT == 32768, "record layout");
__device__ __forceinline__ void rw_stage_park(const RwStage& S, bf16_t* img, int tid) {
#pragma unroll
    for (int m = 0; m < 4; ++m) *(u32x4*)(img + m * 4608 + (tid >> 3) * 72 + (tid & 7) * 8) = S.a[m];
}
__device__ __forceinline__ f32x4 mma16l(const bf16_t* A, const bf16_t* Bt, int lane, f32x4 acc) { return mma16<64>(A, 72, Bt, 72, lane, acc); }
__device__ __forceinline__ void rw_seq(const Frame& F, int job, int tid) {
    const int bh = job >> 1, vh = job & 1, b = bh >> 3, h = bh & 7;
    const int lane = tid & 63, w = __builtin_amdgcn_readfirstlane(tid >> 6), ri = w >> 1, cjl = (w & 1), cj = 2 * vh + cjl;
    bf16_t* S0 = (bf16_t*)F.lds; bf16_t* Xb = S0 + 32 * 72; bf16_t* Ub = Xb + 32 * 72;
    bf16_t* IMG = (bf16_t*)(F.lds + 16384);
    for (int i = tid; i < 32 * 72 / 2; i += 512) ((unsigned*)S0)[i] = 0u;
    f32x4 st = (f32x4){0.f, 0.f, 0.f, 0.f};
    const int vcol = lane & 15, r4 = ri * 16 + 4 * (lane >> 4), tile = ri * 4 + cj;
    RwStage s0, s1, s2;
    rw_stage_load(F, b, h, 0, tid, tile, lane, r4, s0); rw_stage_load(F, b, h, 1, tid, tile, lane, r4, s1); rw_stage_load(F, b, h, 2, tid, tile, lane, r4, s2);
    rw_stage_park(s0, IMG, tid);
    __syncthreads();
    const size_t tb = (size_t)b * SEQ;
#define RW_STEP(cc, S, SN) do { const bf16_t* im = IMG + ((cc) & 1) * 23040 + ri * 16 * 72; \
        const f32x4 xl = unpack4(S.dXl), lt = unpack4(S.dLt); f32x4 y = unpack4(S.dYl); const f32x4 gcc = S.gc; \
        { const f32x4 x = mma16l(im + 0 * 4608, S0 + cjl * 16 * 72, lane, xl); y = mma16l(im + 1 * 4608, S0 + cjl * 16 * 72, lane, y); \
          *(u32x2*)(Xb + (cjl * 16 + vcol) * 72 + r4) = pack4(x); } \
        LDS_BARRIER(); \
        { y = mma16l(im + 3 * 4608, Xb + cjl * 16 * 72, lane, y);                   \
          _Pragma("unroll") for (int j = 0; j < 4; ++j) F.O[(tb + (size_t)(cc) * 64 + r4 + j) * D + 1536 + h * 64 + cj * 16 + vcol] = y[j]; \
          st = mma16l(im + 2 * 4608, Xb + cjl * 16 * 72, lane, st);                 \
          _Pragma("unroll") for (int j = 0; j < 4; ++j) st[j] = (st[j] + lt[j]) * gcc[j]; \
          *(u32x2*)(S0 + (cjl * 16 + vcol) * 72 + r4) = pack4(st); } \
        if ((cc) + 1 < 64) rw_stage_park(SN, IMG + (((cc) + 1) & 1) * 23040, tid); \
        LDS_BARRIER(); \
        if ((cc) + 3 < 64) rw_stage_load(F, b, h, (cc) + 3, tid, tile, lane, r4, S); } while (0)
#pragma unroll 1
    for (int c = 0; c < 64; c += 3) {
        RW_STEP(c, s0, s1);
        if (c + 1 < 64) RW_STEP(c + 1, s1, s2);
        if (c + 2 < 64) RW_STEP(c + 2, s2, s0);
    }
#undef RW_STEP
}

constexpr int NU_HG = 1024, NU_SSD = 512, NU_RG = 256;
__device__ __forceinline__ void hg_scan4(const Frame& F, int e4) {
    const int bh = e4 >> 12, r = (e4 & 4095) * 4, k = r & 127;
    bf16_t* st = (bf16_t*)(F.ws + WS_R4 + R4_HGS) + (size_t)bh * 64 * 16384 + r; const float* dec = (const float*)(F.ws + WS_R4 + R4_HGD) + (size_t)bh * 64 * 128 + k;
    f32x4 h = (f32x4){0.f, 0.f, 0.f, 0.f};
#pragma unroll 1
    for (int c0 = 0; c0 < 64; c0 += 16) {
        u32x2 tmp[16]; f32x4 dd[16];
#pragma unroll
        for (int i = 0; i < 16; ++i) { tmp[i] = *(const u32x2*)(st + (size_t)(c0 + i) * 16384); dd[i] = *(const f32x4*)(dec + (c0 + i) * 128); }
#pragma unroll
        for (int i = 0; i < 16; ++i) { *(u32x2*)(st + (size_t)(c0 + i) * 16384) = pack4(h); h = h * dd[i] + unpack4(tmp[i]); }
    }
}
__device__ __forceinline__ void ssd_scan8(const Frame& F, int e8) {
    const int bh = e8 >> 10, r = (e8 & 1023) * 8;
    bf16_t* st = (bf16_t*)(F.ws + WS_R4 + R4_SSS) + (size_t)bh * 64 * 8192 + r; const float* dec = (const float*)(F.ws + WS_R4 + R4_SSD) + bh * 64;
    float h[8];
#pragma unroll
    for (int j = 0; j < 8; ++j) h[j] = 0.f;
#pragma unroll 1
    for (int c0 = 0; c0 < 64; c0 += 16) {
        u32x4 tmp[16]; float dd[16];
#pragma unroll
        for (int i = 0; i < 16; ++i) { tmp[i] = *(const u32x4*)(st + (size_t)(c0 + i) * 8192); dd[i] = dec[c0 + i]; }
#pragma unroll
        for (int i = 0; i < 16; ++i) {
            *(u32x4*)(st + (size_t)(c0 + i) * 8192) = pack8(h);
#pragma unroll
            for (int j = 0; j < 8; ++j) h[j] = h[j] * dd[i] + bfel(tmp[i], j);
        }
    }
}
__device__ __forceinline__ void rg_scan2(const Frame& F, int e) {
    const int b = e >> 9, j = e & 511;
    float* rgc = (float*)(F.ws + WS_R4 + R4_RGC);
    float h = 0.f;
#pragma unroll 1
    for (int c0 = 0; c0 < 64; c0 += 32) {
        float2 pe[32];
#pragma unroll
        for (int i = 0; i < 32; ++i) pe[i] = *(const float2*)(rgc + ((size_t)(b * 64 + c0 + i) * 512 + j) * 2);
#pragma unroll
        for (int i = 0; i < 32; ++i) { rgc[((size_t)(b * 64 + c0 + i) * 512 + j) * 2 + 1] = h; h = pe[i].x * h + pe[i].y; }
    }
}
__device__ __forceinline__ void phase_m2(const Frame& F, int l) {
    const int tid = opaque_tid();
#ifndef SKIP_RWSEQ
    if (F.bid < 64) { rw_seq(F, F.bid, tid); return; }
#endif
    const int gt = (F.bid - 64) * 512 + tid, nthr = (F.G - 64) * 512;
    constexpr int N_HG = 16 * 4096, N_SS = 32 * 1024, N_RG = 2048;
    for (int it = gt; it < N_RG + N_HG + N_SS; it += nthr) {
        if (it < N_RG) rg_scan2(F, it); else if (it < N_RG + N_HG) hg_scan4(F, it - N_RG); else ssd_scan8(F, it - N_RG - N_HG);
    }
    __syncthreads();
    for (int i = F.bid - 64; i < DEFER_TILES / 2; i += F.G - 64) conv_down_tile(F, 64 * 16 * 8 - DEFER_TILES + l * (DEFER_TILES / 2) + i, tid);
}


__device__ __forceinline__ void phase_front(const Frame& F, int l) {
    for (int ch = F.bid; ch < NTOK / 64; ch += F.G) {
        pre_steps14(F, l, ch); LDS_BARRIER(); pre_5a(F, l, ch); LDS_BARRIER(); pre_5b(F, l, ch); __syncthreads();
        const int tid = opaque_tid();
        { RwRaw nx; rw_load(F, ch >> 6, ch & 63, 0, tid, nx);
#pragma unroll 1
          for (int hh = 0; hh < 8; ++hh) { RwIn cu; rw_finish(F, l, hh, tid, nx, cu); if (hh < 7) rw_load(F, ch >> 6, ch & 63, hh + 1, tid, nx); rw_prep(F, l, ch >> 6, ch & 63, hh, tid, cu); } }
        __syncthreads();
        { const int w = __builtin_amdgcn_readfirstlane(tid >> 6); rw_tsolve(F, ch * 8 + w, w, tid & 63); }
        LDS_BARRIER();
        { HgIn nx; hg_load(F, ch * 4, tid, nx, false);
#pragma unroll 1
          for (int h = 0; h < 4; ++h) { const HgIn cu = nx; if (h < 3) hg_load(F, ch * 4 + h + 1, tid, nx, false); hg_local(F, l, ch * 4 + h, tid, cu); } }
        for (int g = 0; g < 2; ++g) ssd_local(F, l, ch * 2 + g, tid);
        rg_local(F, ch, tid);
        __syncthreads();
    }
}
__device__ __forceinline__ void phase_c3_chunk(const Frame& F, int l, int ch);
__device__ __forceinline__ void phase_back(const Frame& F, int l) {
    for (int ch = F.bid; ch < NTOK / 64; ch += F.G) {
        const int tid = opaque_tid();
        { HgIn nx; hg_load(F, ch * 4, tid, nx, true);
#pragma unroll 1
          for (int h = 0; h < 4; ++h) { const HgIn cu = nx; if (h < 3) hg_load(F, ch * 4 + h + 1, tid, nx, true); hg_out(F, l, ch * 4 + h, tid, cu); } }
        for (int g = 0; g < 2; ++g) ssd_out(F, l, ch * 2 + g, tid);
        rg_out(F, ch, tid);
        __syncthreads();
        phase_c3_chunk(F, l, ch);
        __syncthreads();
    }
}

struct C3In { float o[32], pg[8], pz[8], qv[8], qg[8], bon[8]; };
__device__ __forceinline__ void c3_load(const Frame& F, int l, int t, int lane, C3In& x) {
    const float* o = F.O + (size_t)t * D; const BfPtr p = F.P + (size_t)t * PS; const float* q = F.Q + (size_t)t * QS;
#pragma unroll
    for (int j = 0; j < 32; ++j) if (j < 16 || j >= 24) x.o[j] = o[lane + 64 * j];
#pragma unroll
    for (int j = 0; j < 8; ++j) { const int c = lane + 64 * j; x.pg[j] = p[C_HG_G + c]; x.pz[j] = p[C_SS_Z + c]; { const float vc = p[C_RW + 1024 + c], vp = ((t & (SEQ - 1)) != 0) ? p[C_RW + 1024 + c - (long)PS] : 0.f; x.qv[j] = vc + (vp - vc) * F.in[I_WMU][(size_t)l * RW_COLS + 1024 + c]; } x.qg[j] = q[Q_G + c]; x.bon[j] = ((const float*)(F.ws + WS_BON))[(size_t)t * 8 + j]; }
}
__device__ __forceinline__ void c3_unpack(u32x2 p, float (&f)[4]) { f[0] = __uint_as_float(p.x << 16); f[1] = __uint_as_float(p.x & 0xffff0000u); f[2] = __uint_as_float(p.y << 16); f[3] = __uint_as_float(p.y & 0xffff0000u); }
__device__ __forceinline__ void phase_c3_chunk(const Frame& F, int l, int ch) {
    const int tid_ = opaque_tid(); const int lane = tid_ & 63; const int wave_ = __builtin_amdgcn_readfirstlane(tid_ >> 6);
    const int t0 = ch * 64 + wave_ * 8, c0 = 4 * lane;
    const bf16_t* P = F.Pw;
    const float* hgw = F.in[I_HGNW] + l * GW; const float* snw = F.in[I_SNW] + l * GW;
    const float* lnw = F.in[I_WLNW] + l * GW; const float* lnb = F.in[I_WLNB] + l * GW; const float* mu = F.in[I_WMU] + (size_t)l * RW_COLS + 1024;
    const float* BON = (const float*)(F.ws + WS_BON);
    f32x4 oA[8][2]; u32x2 gA[8][2]; f32x4 wA[2];
    f32x4 oB[8][2]; u32x2 zB[8][2]; f32x4 wB[2];
#pragma unroll
    for (int i = 0; i < 8; ++i)
#pragma unroll
        for (int jj = 0; jj < 2; ++jj) { oA[i][jj] = *(const f32x4*)(F.O + (size_t)(t0 + i) * D + c0 + 256 * jj); gA[i][jj] = *(const u32x2*)(P + (size_t)(t0 + i) * PS + C_HG_G + c0 + 256 * jj); }
#pragma unroll
    for (int jj = 0; jj < 2; ++jj) wA[jj] = *(const f32x4*)(hgw + c0 + 256 * jj);
#pragma unroll
    for (int i = 0; i < 8; ++i)
#pragma unroll
        for (int jj = 0; jj < 2; ++jj) { oB[i][jj] = *(const f32x4*)(F.O + (size_t)(t0 + i) * D + 512 + c0 + 256 * jj); zB[i][jj] = *(const u32x2*)(P + (size_t)(t0 + i) * PS + C_SS_Z + c0 + 256 * jj); }
#pragma unroll
    for (int jj = 0; jj < 2; ++jj) wB[jj] = *(const f32x4*)(snw + c0 + 256 * jj);
#pragma unroll
    for (int i = 0; i < 8; ++i)
#pragma unroll
        for (int jj = 0; jj < 2; ++jj) {
            const f32x4 ov = oA[i][jj];
            float ss = row16_sum(ov[0] * ov[0] + ov[1] * ov[1] + ov[2] * ov[2] + ov[3] * ov[3]); ss += __shfl_xor(ss, 16);
            const float rs = rsqrtf(ss * (1.0f / 128.0f) + NORM_EPS);
            float gf[4]; c3_unpack(gA[i][jj], gf);
            u32x2 pk; pk.x = cvt_pk_bf16(ov[0] * rs * wA[jj][0] * silu_f(gf[0]), ov[1] * rs * wA[jj][1] * silu_f(gf[1])); pk.y = cvt_pk_bf16(ov[2] * rs * wA[jj][2] * silu_f(gf[2]), ov[3] * rs * wA[jj][3] * silu_f(gf[3]));
            *(u32x2*)(F.MIX + (size_t)(t0 + i) * D + c0 + 256 * jj) = pk;
        }
    f32x4 w4[2], b4[2], m4[2];
#pragma unroll
    for (int jj = 0; jj < 2; ++jj) { w4[jj] = *(const f32x4*)(lnw + c0 + 256 * jj); b4[jj] = *(const f32x4*)(lnb + c0 + 256 * jj); m4[jj] = *(const f32x4*)(mu + c0 + 256 * jj); }
    f32x4 oR[2][4][2], qR[2][4][2]; u32x2 vcR[2][4][2], vpR[2][4][2]; float bonR[2][4][2];
#define C3_LOAD_RW(hb) do { _Pragma("unroll") for (int i = 0; i < 4; ++i) { const int t = t0 + 4 * (hb) + i; const bool first = (t & (SEQ - 1)) == 0; \
        _Pragma("unroll") for (int jj = 0; jj < 2; ++jj) { \
            oR[hb][i][jj] = *(const f32x4*)(F.O + (size_t)t * D + 1536 + c0 + 256 * jj); qR[hb][i][jj] = *(const f32x4*)(F.Q + (size_t)t * QS + Q_G + c0 + 256 * jj); \
            const bf16_t* pv = P + (size_t)t * PS + C_RW + 1024 + c0 + 256 * jj; vcR[hb][i][jj] = *(const u32x2*)pv; \
            vpR[hb][i][jj] = (u32x2){0u, 0u}; if (!first) vpR[hb][i][jj] = *(const u32x2*)(pv - PS); \
            bonR[hb][i][jj] = BON[(size_t)t * 8 + (lane >> 4) + 4 * jj]; } } } while (0)
#define C3_MATH_RW(hb) do { _Pragma("unroll") for (int i = 0; i < 4; ++i) _Pragma("unroll") for (int jj = 0; jj < 2; ++jj) { \
        const f32x4 y = oR[hb][i][jj]; const float mean = row16_sum(y[0] + y[1] + y[2] + y[3]) * (1.0f / 64.0f); \
        float d[4]; _Pragma("unroll") for (int k = 0; k < 4; ++k) d[k] = y[k] - mean; \
        const float var = row16_sum(d[0] * d[0] + d[1] * d[1] + d[2] * d[2] + d[3] * d[3]) * (1.0f / 64.0f); const float rstd = rsqrtf(var + 64e-5f); \
        float vcf[4], vpf[4], out[4]; c3_unpack(vcR[hb][i][jj], vcf); c3_unpack(vpR[hb][i][jj], vpf); \
        _Pragma("unroll") for (int k = 0; k < 4; ++k) { const float vv = vcf[k] + (vpf[k] - vcf[k]) * m4[jj][k]; out[k] = (d[k] * rstd * w4[jj][k] + b4[jj][k] + bonR[hb][i][jj] * vv) * qR[hb][i][jj][k]; } \
        u32x2 pk; pk.x = cvt_pk_bf16(out[0], out[1]); pk.y = cvt_pk_bf16(out[2], out[3]); \
        *(u32x2*)(F.MIX + (size_t)(t0 + 4 * (hb) + i) * D + 1536 + c0 + 256 * jj) = pk; } } while (0)
#pragma unroll
    for (int i = 0; i < 8; ++i)
#pragma unroll
        for (int jj = 0; jj < 2; ++jj) {
            float zf[4]; c3_unpack(zB[i][jj], zf);
            float v[4];
#pragma unroll
            for (int k = 0; k < 4; ++k) v[k] = oB[i][jj][k] * silu_f(zf[k]);
            const float ss = wave_sum(v[0] * v[0] + v[1] * v[1] + v[2] * v[2] + v[3] * v[3]);
            const float rs = rsqrtf(ss * (1.0f / 256.0f) + NORM_EPS);
            u32x2 pk; pk.x = cvt_pk_bf16(v[0] * rs * wB[jj][0], v[1] * rs * wB[jj][1]); pk.y = cvt_pk_bf16(v[2] * rs * wB[jj][2], v[3] * rs * wB[jj][3]);
            *(u32x2*)(F.MIX + (size_t)(t0 + i) * D + 512 + c0 + 256 * jj) = pk;
        }
    C3_LOAD_RW(0);
    C3_MATH_RW(0);
    C3_LOAD_RW(1);
    C3_MATH_RW(1);
#undef C3_LOAD_RW
#undef C3_MATH_RW
}


__device__ __forceinline__ void phase_router2(const Frame& F, int l) {
    const int tid = opaque_tid(); const int lane = tid & 63, w = __builtin_amdgcn_readfirstlane(tid >> 6);
    const int r = lane & 15, q = lane >> 4;
    const float* WRT = (const float*)(F.ws + WS_WRT) + (size_t)l * 48 * 2048;
    const float* nw = F.in[I_NFFN] + (size_t)l * D;
    const float* bg = F.in[I_RGB] + l * 4; const float* be = F.in[I_REB] + l * 32;
    unsigned* cnt = F.ctl + CW_CNT + l * 32;
    unsigned* route = (unsigned*)(F.tab + TAB_ROUTE);
    float* Lg = (float*)F.lds + w * (16 * 48);
    for (int tile = w * F.G + F.bid; tile < NTOK / 16; tile += 8 * F.G) {
        const size_t t0 = (size_t)tile * 16;
        f32x4 acc[3]; acc[0] = (f32x4){0.f, 0.f, 0.f, 0.f}; acc[1] = acc[0]; acc[2] = acc[0];
        float ss = 0.f;
        const float* hp = F.h + (t0 + r) * D + 4 * q; const float* bp = WRT + (size_t)r * 2048 + 4 * q;
#pragma unroll 4
        for (int kg = 0; kg < 128; ++kg) {
            const f32x4 a4 = *(const f32x4*)(hp + kg * 16);
            ss += a4[0] * a4[0] + a4[1] * a4[1] + a4[2] * a4[2] + a4[3] * a4[3];
#pragma unroll
            for (int n = 0; n < 3; ++n) {
                const f32x4 b4 = *(const f32x4*)(bp + (size_t)n * 16 * 2048 + kg * 16);
#pragma unroll
                for (int s2 = 0; s2 < 4; ++s2) acc[n] = __builtin_amdgcn_mfma_f32_16x16x4f32(a4[s2], b4[s2], acc[n], 0, 0, 0);
            }
        }
        ss += __shfl_xor(ss, 16); ss += __shfl_xor(ss, 32);
        const float rs = rsqrtf(ss * (1.0f / D) + NORM_EPS);
#pragma unroll
        for (int j = 0; j < 4; ++j) {
            const float rj = __shfl(rs, 4 * q + j);
#pragma unroll
            for (int n = 0; n < 3; ++n) Lg[(4 * q + j) * 48 + n * 16 + r] = acc[n][j] * rj;
        }
        if (lane < 16) {
            const float* lg = Lg + lane * 48; const int t = (int)t0 + lane;
            float gl[4];
#pragma unroll
            for (int i = 0; i < 4; ++i) gl[i] = lg[i] + bg[i];
            int gi = 0; float gm = gl[0];
#pragma unroll
            for (int i = 1; i < 4; ++i) if (gl[i] > gm) { gm = gl[i]; gi = i; }
            float gsum = 0.f;
#pragma unroll
            for (int i = 0; i < 4; ++i) gsum += fexp(gl[i] - gm);
            const float gtop = 1.0f / gsum;
            float el[8];
#pragma unroll
            for (int i = 0; i < 8; ++i) el[i] = lg[4 + gi * 8 + i] + be[gi * 8 + i];
            int j1 = 0; float m1 = el[0];
#pragma unroll
            for (int i = 1; i < 8; ++i) if (el[i] > m1) { m1 = el[i]; j1 = i; }
            int j2 = -1; float m2 = -INFINITY;
#pragma unroll
            for (int i = 0; i < 8; ++i) if (i != j1 && el[i] > m2) { m2 = el[i]; j2 = i; }
            if (j2 < 0) { j2 = (j1 == 0) ? 1 : 0; m2 = m1; }
            const float e2 = fexp(m2 - m1);
            const float g1 = gtop / (1.0f + e2), g2 = gtop * e2 / (1.0f + e2);
            const int x1 = gi * 8 + j1, x2 = gi * 8 + j2;
            const unsigned p1 = atomicAdd(&cnt[x1], 1u), p2 = atomicAdd(&cnt[x2], 1u);
            u32x4 a; a.x = (unsigned)x1; a.y = (unsigned)x2; a.z = p1; a.w = p2;
            *(u32x4*)(route + (size_t)t * 8) = a;
            route[(size_t)t * 8 + 4] = __float_as_uint(g1); route[(size_t)t * 8 + 5] = __float_as_uint(g2);
        }
#pragma unroll 1
        for (int r4b = 0; r4b < 16; r4b += 4) {
            f32x4 v[4][8];
#pragma unroll
            for (int ri = 0; ri < 4; ++ri)
#pragma unroll
                for (int jj = 0; jj < 8; ++jj) v[ri][jj] = *(const f32x4*)(F.h + (t0 + r4b + ri) * D + 4 * (lane + 64 * jj));
#pragma unroll
            for (int ri = 0; ri < 4; ++ri) {
                const float rj = __shfl(rs, r4b + ri);
                bf16_t* urow = F.U + (t0 + r4b + ri) * D;
#pragma unroll
                for (int jj = 0; jj < 8; ++jj) {
                    const int c = 4 * (lane + 64 * jj);
                    const f32x4 wv = *(const f32x4*)(nw + c);
                    u32x2 pk; pk.x = cvt_pk_bf16(v[ri][jj][0] * rj * wv[0], v[ri][jj][1] * rj * wv[1]); pk.y = cvt_pk_bf16(v[ri][jj][2] * rj * wv[2], v[ri][jj][3] * rj * wv[3]);
                    *(u32x2*)(urow + c) = pk;
                }
            }
        }
    }
}


__device__ __forceinline__ void phase_router3(const Frame& F, int l) {
    const int tid = opaque_tid(); const int lane = tid & 63, w = __builtin_amdgcn_readfirstlane(tid >> 6);
    const int r = lane & 15, q = lane >> 4;
    const float* WRT = (const float*)(F.ws + WS_WRT) + (size_t)l * 48 * 2048;
    const float* nw = F.in[I_NFFN] + (size_t)l * D;
    const float* bg = F.in[I_RGB] + l * 4; const float* be = F.in[I_REB] + l * 32;
    unsigned* cnt = F.ctl + CW_CNT + l * 32;
    unsigned* route = (unsigned*)(F.tab + TAB_ROUTE);
    float* As = (float*)F.lds; float* Bs = As + 64 * 260; float* Cs = Bs + 48 * 260;
    float* Lg = As;
    const int tile = w & 3, kh = w >> 2;
    const int lr = tid >> 6, lc = (tid & 63) * 4;
    for (int g = F.bid; g < NTOK / 64; g += F.G) {
        const size_t t0 = (size_t)g * 64;
        f32x4 va[8], vb[6], vn;
        vn = *(const f32x4*)(nw + lc);
#pragma unroll
        for (int it = 0; it < 8; ++it) va[it] = *(const f32x4*)(F.h + (t0 + lr + 8 * it) * D + lc);
#pragma unroll
        for (int it = 0; it < 6; ++it) vb[it] = *(const f32x4*)(WRT + (size_t)(lr + 8 * it) * 2048 + lc);
        f32x4 acc[3]; acc[0] = (f32x4){0.f, 0.f, 0.f, 0.f}; acc[1] = acc[0]; acc[2] = acc[0];
        float ss = 0.f;
#pragma unroll 1
        for (int s = 0; s < 8; ++s) {
            LDS_BARRIER();
#pragma unroll
            for (int it = 0; it < 8; ++it) *(f32x4*)(As + (lr + 8 * it) * 260 + lc) = va[it];
#pragma unroll
            for (int it = 0; it < 6; ++it) *(f32x4*)(Bs + (lr + 8 * it) * 260 + lc) = vb[it];
            LDS_BARRIER();
#pragma unroll
            for (int it = 0; it < 8; ++it) {
                u32x2 pk; pk.x = cvt_pk_bf16(va[it][0] * vn[0], va[it][1] * vn[1]); pk.y = cvt_pk_bf16(va[it][2] * vn[2], va[it][3] * vn[3]);
                *(u32x2*)(F.U + (t0 + lr + 8 * it) * D + 256 * s + lc) = pk;
            }
            if (s < 7) {
                const int c0 = 256 * (s + 1) + lc;
                vn = *(const f32x4*)(nw + c0);
#pragma unroll
                for (int it = 0; it < 8; ++it) va[it] = *(const f32x4*)(F.h + (t0 + lr + 8 * it) * D + c0);
#pragma unroll
                for (int it = 0; it < 6; ++it) vb[it] = *(const f32x4*)(WRT + (size_t)(lr + 8 * it) * 2048 + c0);
            }
            const float* ap = As + (16 * tile + r) * 260 + 4 * q + kh * 128; const float* bp = Bs + r * 260 + 4 * q + kh * 128;
#pragma unroll
            for (int kg = 0; kg < 8; ++kg) {
                const f32x4 a4 = *(const f32x4*)(ap + 16 * kg);
                ss += a4[0] * a4[0] + a4[1] * a4[1] + a4[2] * a4[2] + a4[3] * a4[3];
#pragma unroll
                for (int n = 0; n < 3; ++n) {
                    const f32x4 b4 = *(const f32x4*)(bp + n * 16 * 260 + 16 * kg);
#pragma unroll
                    for (int s2 = 0; s2 < 4; ++s2) acc[n] = __builtin_amdgcn_mfma_f32_16x16x4f32(a4[s2], b4[s2], acc[n], 0, 0, 0);
                }
            }
        }
        if (kh == 1) {
            float* c = Cs + (tile * 64 + lane) * 13;
#pragma unroll
            for (int n = 0; n < 3; ++n)
#pragma unroll
                for (int j = 0; j < 4; ++j) c[n * 4 + j] = acc[n][j];
            c[12] = ss;
        }
        LDS_BARRIER();
        if (kh == 0) {
            const float* c = Cs + (tile * 64 + lane) * 13;
#pragma unroll
            for (int n = 0; n < 3; ++n)
#pragma unroll
                for (int j = 0; j < 4; ++j) acc[n][j] += c[n * 4 + j];
            ss += c[12];
            ss += __shfl_xor(ss, 16); ss += __shfl_xor(ss, 32);
            const float rs = rsqrtf(ss * (1.0f / D) + NORM_EPS);
#pragma unroll
            for (int j = 0; j < 4; ++j) {
                const float rj = __shfl(rs, 4 * q + j);
#pragma unroll
                for (int n = 0; n < 3; ++n) Lg[(16 * tile + 4 * q + j) * 48 + n * 16 + r] = acc[n][j] * rj;
            }
            if (lane < 16) {
                const float* lg = Lg + (16 * tile + lane) * 48; const int t = (int)t0 + 16 * tile + lane;
                float gl[4];
#pragma unroll
                for (int i = 0; i < 4; ++i) gl[i] = lg[i] + bg[i];
                int gi = 0; float gm = gl[0];
#pragma unroll
                for (int i = 1; i < 4; ++i) if (gl[i] > gm) { gm = gl[i]; gi = i; }
                float gsum = 0.f;
#pragma unroll
                for (int i = 0; i < 4; ++i) gsum += fexp(gl[i] - gm);
                const float gtop = 1.0f / gsum;
                float el[8];
#pragma unroll
                for (int i = 0; i < 8; ++i) el[i] = lg[4 + gi * 8 + i] + be[gi * 8 + i];
                int j1 = 0; float m1 = el[0];
#pragma unroll
                for (int i = 1; i < 8; ++i) if (el[i] > m1) { m1 = el[i]; j1 = i; }
                int j2 = -1; float m2 = -INFINITY;
#pragma unroll
                for (int i = 0; i < 8; ++i) if (i != j1 && el[i] > m2) { m2 = el[i]; j2 = i; }
                if (j2 < 0) { j2 = (j1 == 0) ? 1 : 0; m2 = m1; }
                const float e2 = fexp(m2 - m1);
                const float g1 = gtop / (1.0f + e2), g2 = gtop * e2 / (1.0f + e2);
                const int x1 = gi * 8 + j1, x2 = gi * 8 + j2;
                const unsigned p1 = atomicAdd(&cnt[x1], 1u), p2 = atomicAdd(&cnt[x2], 1u);
                u32x4 a; a.x = (unsigned)x1; a.y = (unsigned)x2; a.z = p1; a.w = p2;
                *(u32x4*)(route + (size_t)t * 8) = a;
                route[(size_t)t * 8 + 4] = __float_as_uint(g1); route[(size_t)t * 8 + 5] = __float_as_uint(g2); route[(size_t)t * 8 + 6] = __float_as_uint(rs);
            }
        }
    }
}

__device__ __forceinline__ void phase_tables(const Frame& F, int l) {
    const int tid = opaque_tid(); const int lane = tid & 63;
    int* pst = (int*)F.lds;
    const unsigned* cnt = F.ctl + CW_CNT + l * 32;
    int* slot_tok = (int*)(F.tab + TAB_SLOTTOK);
    if (tid < 32) pst[32 + tid] = (int)__hip_atomic_load(&cnt[tid], __ATOMIC_RELAXED, __HIP_MEMORY_SCOPE_AGENT);
    __syncthreads();
    if (tid == 0) {
        int* tile_exp = (int*)(F.tab + TAB_TILEEXP); int* ntiles = (int*)(F.tab + TAB_NTILES);
        int off = 0, nt = 0;
        for (int e = 0; e < NEXP; ++e) {
            pst[e] = off; const int tiles = (pst[32 + e] + 255) >> 8;
            if (F.bid == 0) for (int i = 0; i < tiles && nt < MAXTILE; ++i) tile_exp[nt + i] = e;
            nt += tiles; off += tiles * 256;
        }
        if (F.bid == 0) *ntiles = nt < MAXTILE ? nt : MAXTILE;
    }
    __syncthreads();
    if (F.bid == 0) {
        for (int e = 0; e < NEXP; ++e) { const int c = pst[32 + e], beg = pst[e] + c, end = pst[e] + (((c + 255) >> 8) << 8); for (int sidx = beg + tid; sidx < end; sidx += 512) if (sidx < MAXSLOT) { slot_tok[sidx] = 0; ((float*)(F.ws + WS_SLOTRS))[sidx] = 0.f; } }
    }
    const unsigned* route = (const unsigned*)(F.tab + TAB_ROUTE);
    int* tokslot = (int*)(F.tab + TAB_TOKSLOT); float* slotgate = (float*)(F.tab + TAB_SLOTGATE); float* slotrs = (float*)(F.ws + WS_SLOTRS);
    for (int t = F.bid * 512 + tid; t < NTOK; t += F.G * 512) {
        const u32x4 a = *(const u32x4*)(route + (size_t)t * 8);
        int s0 = pst[a.x & 31u] + (int)a.z, s1 = pst[a.y & 31u] + (int)a.w;
        s0 = min(max(s0, 0), MAXSLOT - 1); s1 = min(max(s1, 0), MAXSLOT - 1);
        tokslot[2 * t] = s0; tokslot[2 * t + 1] = s1; slot_tok[s0] = t; slot_tok[s1] = t;
        slotgate[s0] = __uint_as_float(route[(size_t)t * 8 + 4]); slotgate[s1] = __uint_as_float(route[(size_t)t * 8 + 5]);
        const float rsv = __uint_as_float(route[(size_t)t * 8 + 6]); slotrs[s0] = rsv; slotrs[s1] = rsv;
    }
    (void)lane;
}

__device__ __forceinline__ void phase_offsets(const Frame& F, int l) {
    const int tid_ = opaque_tid(); const int lane_ = tid_ & 63; const int wave_ = __builtin_amdgcn_readfirstlane(tid_ >> 6); (void)lane_; (void)wave_;
    if (F.bid == 0 && tid_ == 0) {
        const unsigned* cnt = F.ctl + CW_CNT + l * 32;
        int* padstart = (int*)(F.tab + TAB_PADSTART); int* tile_exp = (int*)(F.tab + TAB_TILEEXP); int* ntiles = (int*)(F.tab + TAB_NTILES);
        int off = 0, nt = 0;
        for (int e = 0; e < NEXP; ++e) {
            const int c = (int)__hip_atomic_load(&cnt[e], __ATOMIC_RELAXED, __HIP_MEMORY_SCOPE_AGENT);
            padstart[e] = off;
            const int tiles = (c + 255) >> 8;
            for (int i = 0; i < tiles && nt < MAXTILE; ++i) tile_exp[nt++] = e;
            off += tiles * 256;
        }
        *ntiles = nt;
    }
}

__device__ __forceinline__ void phase_scatter(const Frame& F) {
    const int tid_ = opaque_tid(); const int lane_ = tid_ & 63; const int wave_ = __builtin_amdgcn_readfirstlane(tid_ >> 6); (void)lane_; (void)wave_;
    const int gw = F.bid * 8 + wave_, nw = F.G * 8, lane = lane_;
    const unsigned* route = (const unsigned*)(F.tab + TAB_ROUTE); const int* padstart = (const int*)(F.tab + TAB_PADSTART);
    int* tokslot = (int*)(F.tab + TAB_TOKSLOT); float* slotgate = (float*)(F.tab + TAB_SLOTGATE);
    for (int t = gw; t < NTOK; t += nw) {
        const u32x4 a = *(const u32x4*)(route + (size_t)t * 8);
        int s0 = padstart[a.x & 31u] + (int)a.z, s1 = padstart[a.y & 31u] + (int)a.w;
        s0 = min(max(s0, 0), MAXSLOT - 1); s1 = min(max(s1, 0), MAXSLOT - 1);
        if (lane == 0) { tokslot[2 * t] = s0; tokslot[2 * t + 1] = s1; slotgate[s0] = __uint_as_float(route[(size_t)t * 8 + 4]); slotgate[s1] = __uint_as_float(route[(size_t)t * 8 + 5]); }
        const u32x4* src = (const u32x4*)(F.U + (size_t)t * D);
        u32x4* d0 = (u32x4*)(F.XPERM + (size_t)s0 * D); u32x4* d1 = (u32x4*)(F.XPERM + (size_t)s1 * D);
#pragma unroll
        for (int i = 0; i < 4; ++i) { const u32x4 x = src[lane + 64 * i]; d0[lane + 64 * i] = x; d1[lane + 64 * i] = x; }
    }
}

__device__ __forceinline__ void host_moe_tail(const Frame& F, int base, int P, int Q) {
    const int tid_ = opaque_tid();
    const int nt = *(const int*)(F.tab + TAB_NTILES);
    int hosted = 0;
    if (F.G == 256 && nt > 0) {
        const int R = (nt + 31) >> 5, x = F.bid & 7, idx = F.bid >> 3;
        const int tl = 4 * ((R - 1) * 8 + x) + (idx >> 3);
        const int nidle = (32 * R - nt) * 8;
        hosted = nidle * Q < P ? nidle * Q : P;
        if (tl >= nt) { const int rank = (tl - nt) * 8 + (idx & 7);
            for (int k = 0; k < Q; ++k) { const int j = rank + k * nidle; if (j < hosted) conv_down_tile(F, base + j, tid_); } }
    }
    for (int j = hosted + F.bid; j < P; j += F.G) conv_down_tile(F, base + j, tid_);
}

constexpr int PH_PER_LAYER = 10, N_PHASES = 1 + DEPTH * PH_PER_LAYER;

__global__ void __launch_bounds__(512, 2) mega(Args args) {
    extern __shared__ __attribute__((aligned(16))) unsigned char lds[];
    Frame F;
    F.in = args.in; F.h = args.out; F.ws = args.ws; F.lds = lds;
    F.G = gridDim.x; F.bid = blockIdx.x;
    F.ctl = (unsigned*)(args.ws + WS_CTL); F.tab = args.ws + WS_TAB;
    F.P = BfPtr{(const bf16_t*)(args.ws + WS_R1)}; F.Pw = (bf16_t*)(args.ws + WS_R1); F.Y = (bf16_t*)(args.ws + WS_R1); F.HID = (bf16_t*)(args.ws + WS_R1 + R1_HID);
    F.Q = (float*)(args.ws + WS_R2); F.XPERM = (bf16_t*)(args.ws + WS_R2); F.O = (float*)(args.ws + WS_R3);
    F.U = (bf16_t*)(args.ws + WS_U); F.MIX = (bf16_t*)(args.ws + WS_MIX);
    LAS unsigned char* ldsl = (LAS unsigned char*)lds;
    volatile LAS unsigned* misc = (volatile LAS unsigned*)(ldsl + LDS_MISC);
    if (threadIdx.x < 16) misc[threadIdx.x] = 0u;
    __syncthreads();
    const int lo = args.ph_lo, hi = args.ph_hi;
    XcdBarrier bar; bar.bar = F.ctl + CW_BAR; bar.x = 0; bar.st = misc;
    if (hi - lo > 1) bar = xcd_barrier_post(F.ctl + CW_BAR, misc);
#define IN(k) (lo <= (k) && (k) < hi)

    int ph = 0;
#ifndef PROBE_GROUP
#define PROBE_GROUP 0
#endif
#define PHASE_BEGIN if (IN(ph)) {
#define PHASE_BEGIN_R(g) if (IN(ph)) { for (int rep_ = 0; rep_ < 1 + (PROBE_GROUP == (g)); ++rep_) {
#define PHASE_END_R } PHASE_END
#define PHASE_END } if (IN(ph) && IN(ph + 1)) xcd_barrier(bar); ++ph;
    PHASE_BEGIN_R(1) phase_prologue(F); __syncthreads(); phase_norm1(F, 0, F.in[I_NMIX]); PHASE_END_R
    for (int l = 0; l < DEPTH; ++l) {
        if (l > 0) { PHASE_BEGIN phase_norm1(F, 1, F.in[I_NMIX] + (size_t)l * D); PHASE_END }
        PHASE_BEGIN_R(2)
            pg8::Gemm g{F.U, (const bf16_t*)(F.ws + WS_WIN) + (size_t)l * PS * D, D, 0, nullptr};
            pg8::StaticOrder S; S.init(NTOK, PS, F.G, F.bid);
            pg8::EpiBf E{F.Pw, PS};
            pg8::gemm_phase(ldsl, g, S, E);
            { const int rem = S.nwg % F.G;
              if (rem > 0 && F.bid >= rem) { __syncthreads(); const int tid_ = opaque_tid();
                  for (int i = F.bid - rem; i < DEFER_GEMM / 2; i += F.G - rem) conv_down_tile(F, 64 * 16 * 8 - DEFER_TILES - DEFER_GEMM + l * (DEFER_GEMM / 2) + i, tid_); }
              else if (rem == 0) { __syncthreads(); const int tid_ = opaque_tid();
                  for (int i = F.bid; i < DEFER_GEMM / 2; i += F.G) conv_down_tile(F, 64 * 16 * 8 - DEFER_TILES - DEFER_GEMM + l * (DEFER_GEMM / 2) + i, tid_); } }
        PHASE_END_R
        PHASE_BEGIN_R(4) phase_front(F, l); PHASE_END_R
        PHASE_BEGIN phase_m2(F, l); PHASE_END
        PHASE_BEGIN_R(6) phase_back(F, l); PHASE_END_R
        PHASE_BEGIN
            pg8::Gemm g{F.MIX, (const bf16_t*)(F.ws + WS_WOUT) + (size_t)l * D * D, D, 0, nullptr};
            pg8::StaticOrder S; S.init(NTOK, D, F.G, F.bid);
            pg8::EpiRes E{l == 0 ? F.in[I_X] : F.h, F.h, D};
            pg8::gemm_phase(ldsl, g, S, E);
        PHASE_END
        PHASE_BEGIN phase_router3(F, l); PHASE_END
        PHASE_BEGIN phase_tables(F, l); PHASE_END
        PHASE_BEGIN_R(2)
            pg8::Gemm g{F.U, (const bf16_t*)(F.ws + WS_WGU) + (size_t)l * NEXP * 2048 * 2048, D, (size_t)2048 * 2048 * 2, (const int*)(F.tab + TAB_SLOTTOK)};
            pg8::MoeOrder S{*(const int*)(F.tab + TAB_NTILES), (const int*)(F.tab + TAB_TILEEXP), 8, F.G, F.bid};
            pg8::EpiGU E{F.HID, (const float*)(F.ws + WS_SLOTRS)};
            pg8::gemm_phase<pg8::EpiGU, pg8::MoeOrder, true>(ldsl, g, S, E);
            __syncthreads(); host_moe_tail(F, 64 * 16 * 8 - DEFER_ALL + (l == 0 ? 0 : 2 * DEFER_MOE), DEFER_MOE, 4);
        PHASE_END_R
        PHASE_BEGIN_R(2)
            pg8::Gemm g{F.HID, (const bf16_t*)(F.ws + WS_WD) + (size_t)l * NEXP * 2048 * 1024, DEXP, (size_t)2048 * 1024 * 2, nullptr};
            pg8::MoeOrder S{*(const int*)(F.tab + TAB_NTILES), (const int*)(F.tab + TAB_TILEEXP), 8, F.G, F.bid};
            pg8::EpiDown E{F.Y, (const float*)(F.tab + TAB_SLOTGATE)};
            pg8::gemm_phase(ldsl, g, S, E);
            if (l == 0) { __syncthreads(); host_moe_tail(F, 64 * 16 * 8 - DEFER_ALL + DEFER_MOE, DEFER_MOE, 2); }
        PHASE_END_R
    }
    PHASE_BEGIN phase_norm1(F, 2, F.in[I_NFIN]); PHASE_END
#undef PHASE_BEGIN
#undef PHASE_END
#undef IN
}

extern "C" void kernel_launch(void* const* d_in, const int* in_sizes, int n_in, void* d_out, int out_size, void* d_ws, size_t ws_size, hipStream_t stream) {
    static int grid = 0;
    if (grid == 0) {
        if (n_in != NIN || out_size != NTOK * D || ws_size < WS_END) { fprintf(stderr, "kernel_launch: unexpected shapes (n_in %d, out %d, ws %zu < %zu)\n", n_in, out_size, ws_size, (size_t)WS_END); grid = -1; return; }
        int dev = 0, cus = 0;
        if (hipGetDevice(&dev) != hipSuccess || hipDeviceGetAttribute(&cus, hipDeviceAttributeMultiprocessorCount, dev) != hipSuccess) { grid = -1; return; }
        if (hipFuncSetAttribute((const void*)mega, hipFuncAttributeMaxDynamicSharedMemorySize, LDS_BYTES) != hipSuccess) { fprintf(stderr, "kernel_launch: hipFuncSetAttribute failed\n"); grid = -1; return; }
        int per_cu = 0;
        if (hipOccupancyMaxActiveBlocksPerMultiprocessor(&per_cu, (const void*)mega, 512, LDS_BYTES) != hipSuccess || per_cu < 1) fprintf(stderr, "kernel_launch: occupancy query says %d\n", per_cu);
        (void)hipGetLastError();
        grid = cus;
    }
    if (grid < 0) return;
    (void)hipMemsetAsync((char*)d_ws + WS_CTL, 0, CTL_BYTES, stream);
    Args a{};
    for (int i = 0; i < NIN; ++i) a.in[i] = (const float*)d_in[i];
    a.out = (float*)d_out; a.ws = (unsigned char*)d_ws;
#if MK_MULTI
    for (int p = 0; p < N_PHASES; ++p) { a.ph_lo = p; a.ph_hi = p + 1; hipLaunchKernelGGL(mega, dim3(grid), dim3(512), LDS_BYTES, stream, a); }
#else
    a.ph_lo = 0; a.ph_hi = N_PHASES;
    hipLaunchKernelGGL(mega, dim3(grid), dim3(512), LDS_BYTES, stream, a);
#endif
}
```

```cpp
#include <hip/hip_runtime.h>
#include <stdint.h>
#include <stdio.h>

#ifndef MK_MULTI
#define MK_MULTI 0
#endif

#define LAS __attribute__((address_space(3)))
#define LDS_BARRIER() do { asm volatile("s_waitcnt lgkmcnt(0)" ::: "memory"); __builtin_amdgcn_s_barrier(); asm volatile("" ::: "memory"); } while (0)
typedef unsigned short bf16_t;
typedef short bf16x8 __attribute__((ext_vector_type(8)));
typedef float f32x4 __attribute__((ext_vector_type(4)));
typedef unsigned u32x4 __attribute__((ext_vector_type(4)));
typedef unsigned u32x2 __attribute__((ext_vector_type(2)));

constexpr int D = 2048, SEQ = 4096, NTOK = 16384, DEPTH = 2, GW = 512;
constexpr int IN_COLS = 6600, PS = 6656;
constexpr int C_HG_Q = 0, C_HG_F = 512, C_HG_I = 1024, C_HG_G = 1536;
constexpr int C_SS_Z = 2048, C_SS_X = 2560, C_SS_DT = 3584;
constexpr int C_RG_G = 3592, C_RG_X = 4104;
constexpr int C_RW = 4616;
constexpr int RW_COLS = 1984;
constexpr int QS = 5120;
constexpr int Q_RGA = 512, Q_RGU = 1024, Q_R = 1536, Q_W = 2048, Q_K = 2560, Q_V = 3072, Q_KK = 3584, Q_KKA = 4096, Q_G = 4608;
constexpr int NEXP = 32, DEXP = 1024;
constexpr int MAXSLOT = 40960, MAXTILE = 160;
constexpr float NORM_EPS = 1e-6f;

constexpr size_t al256(size_t x) { return (x + 255) & ~(size_t)255; }
constexpr size_t WS_CTL = 0;
constexpr size_t CTL_BYTES = 65536;
constexpr size_t WS_TAB = WS_CTL + CTL_BYTES;
constexpr size_t TAB_ROUTE = 0;
constexpr size_t TAB_TOKSLOT = TAB_ROUTE + (size_t)NTOK * 32;
constexpr size_t TAB_SLOTGATE = TAB_TOKSLOT + (size_t)NTOK * 8;
constexpr size_t TAB_PADSTART = TAB_SLOTGATE + (size_t)MAXSLOT * 4;
constexpr size_t TAB_TILEEXP = TAB_PADSTART + 256;
constexpr size_t TAB_NTILES = TAB_TILEEXP + 1024;
constexpr size_t TAB_SLOTTOK = TAB_NTILES + 256;
constexpr size_t TAB_BYTES = al256(TAB_SLOTTOK + (size_t)MAXSLOT * 4);
constexpr size_t WS_WIN = al256(WS_TAB + TAB_BYTES);
constexpr size_t WS_WOUT = WS_WIN + (size_t)2 * PS * D * 2;
constexpr size_t WS_WGU = WS_WOUT + (size_t)2 * D * D * 2;
constexpr size_t WS_WD = WS_WGU + (size_t)2 * NEXP * 2048 * 2048 * 2;
constexpr size_t WS_U = WS_WD + (size_t)2 * NEXP * 2048 * 1024 * 2;
constexpr size_t WS_MIX = WS_U + (size_t)NTOK * D * 2;
constexpr size_t WS_R1 = WS_MIX + (size_t)NTOK * D * 2;
constexpr size_t R1_HID = (size_t)MAXSLOT * D * 2;
constexpr size_t R1_BYTES = R1_HID + (size_t)MAXSLOT * DEXP * 2;
static_assert((size_t)NTOK * PS * 2 <= R1_BYTES, "R1 alias");
constexpr size_t WS_R2 = WS_R1 + R1_BYTES;
constexpr size_t R2_BYTES = (size_t)NTOK * QS * 4;
static_assert((size_t)MAXSLOT * D * 2 <= R2_BYTES, "R2 alias");
constexpr size_t WS_R3 = WS_R2 + R2_BYTES;
constexpr size_t WS_R4 = WS_R3 + (size_t)NTOK * D * 4;
constexpr size_t R4_HGS = 0;
constexpr size_t R4_SSS = R4_HGS + (size_t)16 * 64 * 16384 * 4;
constexpr size_t R4_HGD = R4_SSS + (size_t)32 * 64 * 8192 * 4;
constexpr size_t R4_SSD = R4_HGD + (size_t)16 * 64 * 128 * 4;
constexpr size_t R4_RGC = R4_SSD + (size_t)32 * 64 * 4;
constexpr size_t WS_RWAAB = al256(WS_R4 + R4_RGC + (size_t)4 * 64 * 512 * 2 * 4);
constexpr size_t WS_RWGC = WS_RWAAB + (size_t)2048 * 4096 * 4;
constexpr size_t WS_SW = WS_RWGC + (size_t)2048 * 64 * 4;
constexpr size_t SW_W2T = 0, SW_A2T = SW_W2T + 512 * 96 * 2, SW_G2T = SW_A2T + 512 * 96 * 2, SW_WAT = SW_G2T + 512 * 256 * 2, SW_WXT = SW_WAT + 8 * 64 * 64 * 2, SW_LAYER = SW_WXT + 8 * 64 * 64 * 2;
constexpr size_t WS_WRT = al256(WS_SW + 2 * SW_LAYER);
constexpr size_t WS_BON = al256(WS_WRT + (size_t)2 * 48 * 2048 * 4);
constexpr size_t WS_SLOTRS = al256(WS_BON + (size_t)NTOK * 8 * 4);
constexpr size_t WS_END = WS_SLOTRS + (size_t)MAXSLOT * 4;
constexpr size_t RW_REC = 65536;
constexpr int RO_AR = 0, RO_RR = 8192, RO_BRT = 16384, RO_ARBT = 24576, RO_TT = 32768, RO_XL = 40960, RO_LT = 49152, RO_YL = 57344;
static_assert(WS_MIX == WS_U + (size_t)NTOK * D * 2 && (size_t)2048 * RW_REC <= (size_t)2 * NTOK * D * 2, "RW record region");

constexpr int CW_BAR = 0;
constexpr int CW_CNT = 4096;

typedef __bf16 bf16v2 __attribute__((ext_vector_type(2)));
typedef float f32x2 __attribute__((ext_vector_type(2)));
__device__ __forceinline__ unsigned cvt_pk_bf16(float lo, float hi) { const f32x2 v = {lo, hi}; const bf16v2 b = __builtin_convertvector(v, bf16v2); return __builtin_bit_cast(unsigned, b); }
__device__ __forceinline__ bf16_t f2bf(float f) { return (bf16_t)(cvt_pk_bf16(f, 0.0f) & 0xffffu); }
#define DPP_ADD(v, ctrl, rmask, bc) ((v) + __uint_as_float(__builtin_amdgcn_update_dpp(0u, __float_as_uint(v), (ctrl), (rmask), 0xf, (bc))))
__device__ __forceinline__ float row16_sum(float v) {
    v = DPP_ADD(v, 0xB1, 0xf, true); v = DPP_ADD(v, 0x4E, 0xf, true); v = DPP_ADD(v, 0x141, 0xf, true); v = DPP_ADD(v, 0x140, 0xf, true);
    return v;
}
__device__ __forceinline__ float wave_sum(float v) {
    v = row16_sum(v);
    v = DPP_ADD(v, 0x142, 0xa, false);
    v = DPP_ADD(v, 0x143, 0xc, false);
    return __int_as_float(__builtin_amdgcn_readlane(__float_as_int(v), 63));
}
__device__ __forceinline__ float fexp(float x) { return __expf(x); }
__device__ __forceinline__ float flog(float x) { return __logf(x); }
__device__ __forceinline__ float frcp(float x) { return __builtin_amdgcn_rcpf(x); }
__device__ __forceinline__ float sigmoid_f(float x) { return frcp(1.0f + fexp(-x)); }
__device__ __forceinline__ float silu_f(float x) { return x * sigmoid_f(x); }
__device__ __forceinline__ float softplus_f(float x) { return fmaxf(x, 0.f) + flog(1.0f + fexp(-fabsf(x))); }
__device__ __forceinline__ float ftanh(float x) { const float e = fexp(-2.0f * fabsf(x)); const float t = (1.0f - e) * frcp(1.0f + e); return x < 0.f ? -t : t; }
__device__ __forceinline__ float gelu_tanh_f(float x) { const float u = 0.7978845608028654f * (x + 0.044715f * x * x * x); return 0.5f * x * (1.0f + ftanh(u)); }

__device__ __forceinline__ int opaque_tid() { int t = threadIdx.x; asm volatile("" : "+v"(t)); return t; }

#define XB_TMO      128
#define XB_XCNT(j)  (256  + 64 * (j))
#define XB_XSUB(j)  (1280 + 64 * (j))
#define XB_XGEN(j)  (2304 + 64 * (j))
#define XB_TOP      3328
#define XB_TOPGEN   3392
#define XCD_BAR_WORDS 3456
#define XB_SPIN_CAP (1u << 18)
__device__ __forceinline__ unsigned xb_ld(unsigned* p)              { return __hip_atomic_load(p, __ATOMIC_RELAXED, __HIP_MEMORY_SCOPE_AGENT); }
__device__ __forceinline__ unsigned xb_add(unsigned* p, unsigned v) { return __hip_atomic_fetch_add(p, v, __ATOMIC_RELAXED, __HIP_MEMORY_SCOPE_AGENT); }
__device__ __forceinline__ unsigned xb_xcc_id() { return (unsigned)__builtin_amdgcn_s_getreg((3 << 11) | 20) & 0xFu; }
#define XB_SPIN(cond, bar) do { unsigned _sp = 0; while (cond) { __builtin_amdgcn_s_sleep(1); \
    if ((++_sp & 255u) == 0u) { if (xb_ld(&(bar)[XB_TMO])) break; if (_sp > XB_SPIN_CAP) { atomicAdd(&(bar)[XB_TMO], 1u); break; } } } } while (0)
struct XcdBarrier { unsigned* bar; unsigned x; volatile LAS unsigned* st; };
__device__ __forceinline__ XcdBarrier xcd_barrier_post(unsigned* bar, volatile LAS unsigned* st) {
    XcdBarrier b; b.bar = bar; b.x = xb_xcc_id(); b.st = st;
    if (threadIdx.x == 0) (void)xb_add(&bar[XB_XCNT(b.x)], 1u);
    return b;
}
__device__ __forceinline__ void xcd_barrier_complete(unsigned* bar, unsigned x, unsigned& nloc, unsigned& nx) {
    const unsigned G = gridDim.x * gridDim.y * gridDim.z;
    unsigned sum, cnt, mine, sp = 0u;
    for (;;) {
        sum = 0u; cnt = 0u; mine = 0u;
#pragma unroll
        for (unsigned j = 0; j < 16; ++j) { const unsigned c = xb_ld(&bar[XB_XCNT(j)]); sum += c; cnt += (c > 0u) ? 1u : 0u; mine = (j == x) ? c : mine; }
        if (sum == G) break;
        __builtin_amdgcn_s_sleep(1);
        if ((++sp & 255u) == 0u) { if (xb_ld(&bar[XB_TMO])) break; if (sp > XB_SPIN_CAP) { atomicAdd(&bar[XB_TMO], 1u); break; } }
    }
    nloc = mine > 0u ? mine : 1u; nx = cnt > 0u ? cnt : 1u;
}
__device__ __forceinline__ void xcd_barrier(const XcdBarrier& b) {
    asm volatile("s_waitcnt vmcnt(0)" ::: "memory");
    __syncthreads();
    if (threadIdx.x == 0) {
        unsigned* bar = b.bar;
        __builtin_amdgcn_s_waitcnt(0);
        unsigned nloc = b.st[0], nx = b.st[1];
        if (nloc == 0u) { xcd_barrier_complete(bar, b.x, nloc, nx); b.st[0] = nloc; b.st[1] = nx; }
        const unsigned old = xb_add(&bar[XB_XSUB(b.x)], 1u);
        const unsigned gen = old / nloc;
        if (old + 1u == (gen + 1u) * nloc) {
            __builtin_amdgcn_fence(__ATOMIC_RELEASE, "agent");
            asm volatile("s_waitcnt vmcnt(0)" ::: "memory");
            const unsigned og = xb_add(&bar[XB_TOP], 1u);
            const unsigned tg = og / nx;
            if (og + 1u == (tg + 1u) * nx) xb_add(&bar[XB_TOPGEN], 1u);
            else XB_SPIN(xb_ld(&bar[XB_TOPGEN]) == tg, bar);
            __builtin_amdgcn_fence(__ATOMIC_ACQUIRE, "agent");
            xb_add(&bar[XB_XGEN(b.x)], 1u);
            asm volatile("s_waitcnt vmcnt(0)" ::: "memory");
        } else {
            XB_SPIN(xb_ld(&bar[XB_XGEN(b.x)]) == gen, bar);
            __builtin_amdgcn_fence(__ATOMIC_ACQUIRE, "agent");
            asm volatile("s_waitcnt vmcnt(0)" ::: "memory");
        }
    }
    __syncthreads();
}

namespace pg8 {
constexpr int BM = 256, BK = 64, HALF = 128, HTB = HALF * BK * 2, STAGE_BYTES = 8 * HTB, NXCD = 8;
__host__ __device__ __forceinline__ int lds_byte(int r, int c) { const int st = (r >> 4) * 2 + (c >> 5), rr = r & 15, cc = c & 31, ob = rr * 64 + cc * 2; return st * 1024 + (ob ^ (((ob >> 9) & 1) << 5)); }
__host__ __device__ __forceinline__ void stage_rc(int b, int& R, int& C) { const int st = b / 1024, sb = b % 1024, swz = sb ^ (((sb >> 9) & 1) << 5); R = (st >> 1) * 16 + swz / 64; C = (st & 1) * 32 + (swz % 64) / 2; }

struct Unit { int pm, pn, e; };
struct Gemm { const bf16_t* A; const bf16_t* Bt; int K; size_t ebytes; const int* rowmap; };

struct StaticOrder {
    int nM, nN, nwg, G, c, WGM;
    __device__ void init(int M, int N, int G_, int c_, int wgm = 4) { nM = M / BM; nN = N / BM; nwg = nM * nN; G = G_; c = c_; WGM = wgm; }
    __device__ bool next(int i, Unit& u) const {
        const long L = (long)i * G + c; if (L >= nwg) return false;
        int wgid = (int)L; { const int q = nwg / NXCD, r = nwg % NXCD, xcd = wgid % NXCD, off = wgid / NXCD; wgid = (xcd < r ? xcd * (q + 1) : r * (q + 1) + (xcd - r) * q) + off; }
        const int nig = WGM * nN, gid = wgid / nig, fm = gid * WGM, gsz = (nM - fm) < WGM ? (nM - fm) : WGM;
        u.pm = fm + ((wgid % nig) % gsz); u.pn = (wgid % nig) / gsz; u.e = 0; return true;
    }
};
struct MoeOrder {
    int nt; const int* tile_exp; int nN, G, c;
    __device__ bool next(int i, Unit& u) const {
        int t, pn;
        if ((G & 255) == 0 && nN == 8) { const int x = c & 7, idx = c >> 3, per = G >> 8;
            const int grp = idx >> 5;
            t = 4 * ((i * per + grp) * 8 + x) + ((idx & 31) >> 3); pn = idx & 7; (void)per; }
        else { const long L = (long)i * G + c; t = (int)(L / nN); pn = (int)(L % nN); }
        const bool ok = t < nt;
        u.pm = ok ? t : 0; u.pn = ok ? pn : 0; u.e = tile_exp[u.pm]; return ok;
    }
};

struct EpiBf {
    bf16_t* C; int ldc;
    __device__ __forceinline__ void operator()(const f32x4 (&acc)[2][2][4][2], const Unit& u, int wr, int wc, int fr, int fq) const {
        const int row0 = u.pm * BM + wr * 64 + fr, col0 = u.pn * BM + wc * 32 + 8 * (fq >> 1) + 16 * (fq & 1);
#pragma unroll
        for (int ai = 0; ai < 2; ++ai)
#pragma unroll
            for (int m = 0; m < 4; ++m) { bf16_t* rowp = C + (size_t)(row0 + ai * HALF + m * 16) * ldc + col0;
#pragma unroll
                for (int bj = 0; bj < 2; ++bj) {
                    const f32x4 v0 = acc[ai][bj][m][0], v1 = acc[ai][bj][m][1];
                    const auto sx = __builtin_amdgcn_permlane16_swap(cvt_pk_bf16(v0[0], v0[1]), cvt_pk_bf16(v1[0], v1[1]), false, false);
                    const auto sy = __builtin_amdgcn_permlane16_swap(cvt_pk_bf16(v0[2], v0[3]), cvt_pk_bf16(v1[2], v1[3]), false, false);
                    u32x4 w; w.x = sx[0]; w.y = sy[0]; w.z = sx[1]; w.w = sy[1];
                    *(u32x4*)(rowp + bj * HALF) = w; } }
    }
};
struct EpiRes {
    const float* Hsrc; float* H; int ldc;
    __device__ __forceinline__ void operator()(const f32x4 (&acc)[2][2][4][2], const Unit& u, int wr, int wc, int fr, int fq) const {
        const int row0 = u.pm * BM + wr * 64 + fr, col0 = u.pn * BM + wc * 32 + 4 * fq;
#pragma unroll
        for (int ai = 0; ai < 2; ++ai) {
            f32x4 r[4][2][2];
#pragma unroll
            for (int m = 0; m < 4; ++m) { const size_t off = (size_t)(row0 + ai * HALF + m * 16) * ldc + col0;
#pragma unroll
                for (int bj = 0; bj < 2; ++bj)
#pragma unroll
                    for (int n = 0; n < 2; ++n) r[m][bj][n] = *(const f32x4*)(Hsrc + off + bj * HALF + n * 16); }
#pragma unroll
            for (int m = 0; m < 4; ++m) { const size_t off = (size_t)(row0 + ai * HALF + m * 16) * ldc + col0;
#pragma unroll
                for (int bj = 0; bj < 2; ++bj)
#pragma unroll
                    for (int n = 0; n < 2; ++n) *(f32x4*)(H + off + bj * HALF + n * 16) = r[m][bj][n] + acc[ai][bj][m][n]; }
        }
    }
};
struct EpiGU {
    bf16_t* Hid; const float* rs;
    __device__ __forceinline__ void operator()(const f32x4 (&acc)[2][2][4][2], const Unit& u, int wr, int wc, int fr, int fq) const {
        const int row0 = u.pm * BM + wr * 64 + fr, col0 = u.pn * HALF + wc * 32 + 4 * fq;
        float sc[2][4];
#pragma unroll
        for (int ai = 0; ai < 2; ++ai)
#pragma unroll
            for (int m = 0; m < 4; ++m) sc[ai][m] = rs[row0 + ai * HALF + m * 16];
#pragma unroll
        for (int ai = 0; ai < 2; ++ai)
#pragma unroll
            for (int m = 0; m < 4; ++m) { bf16_t* rowp = Hid + (size_t)(row0 + ai * HALF + m * 16) * DEXP + col0;
#pragma unroll
                for (int n = 0; n < 2; ++n) { const f32x4 g = acc[ai][0][m][n] * sc[ai][m], uu = acc[ai][1][m][n] * sc[ai][m]; float h[4];
#pragma unroll
                    for (int j = 0; j < 4; ++j) h[j] = g[j] * __builtin_amdgcn_rcpf(1.0f + __expf(-g[j])) * uu[j];
                    u32x2 w; w.x = cvt_pk_bf16(h[0], h[1]); w.y = cvt_pk_bf16(h[2], h[3]); *(u32x2*)(rowp + n * 16) = w; } }
    }
};
struct EpiDown {
    bf16_t* Y; const float* gate;
    __device__ __forceinline__ void operator()(const f32x4 (&acc)[2][2][4][2], const Unit& u, int wr, int wc, int fr, int fq) const {
        const int row0 = u.pm * BM + wr * 64 + fr, col0 = u.pn * BM + wc * 32 + 4 * fq;
#pragma unroll
        for (int ai = 0; ai < 2; ++ai)
#pragma unroll
            for (int m = 0; m < 4; ++m) { const int row = row0 + ai * HALF + m * 16; const float gt = gate[row]; bf16_t* rowp = Y + (size_t)row * D + col0;
#pragma unroll
                for (int bj = 0; bj < 2; ++bj)
#pragma unroll
                    for (int n = 0; n < 2; ++n) { const f32x4 v = acc[ai][bj][m][n] * gt; u32x2 w; w.x = cvt_pk_bf16(v[0], v[1]); w.y = cvt_pk_bf16(v[2], v[3]); *(u32x2*)(rowp + bj * HALF + n * 16) = w; } }
    }
};

template <class Epi, class Sched, bool GATHER = false, bool SP2 = true, bool ALIGN_EPI = true>
__device__ __forceinline__ void gemm_phase(LAS unsigned char* lds, const Gemm g, const Sched& S, const Epi& E) {
    const int tid = opaque_tid(), wid = __builtin_amdgcn_readfirstlane(tid >> 6), lane = tid & 63, wr = wid >> 2, wc = wid & 3, fr = lane & 15, fq = lane >> 4;
    const int K = g.K, nt = K / BK;
    unsigned voffA[2];
#pragma unroll
    for (int i = 0; i < 2; ++i) { int R, C; stage_rc(tid * 16 + i * 8192, R, C); voffA[i] = (unsigned)(R * K + C) * 2u; }
    unsigned gA[2][2], gN[2][2];
#define PG8_GLOAD(dst, pm_) do { if constexpr (GATHER) { int rm_[2][2]; \
        _Pragma("unroll") for (int _h = 0; _h < 2; ++_h) _Pragma("unroll") for (int _i = 0; _i < 2; ++_i) { int R_, C_; stage_rc(tid * 16 + _i * 8192, R_, C_); rm_[_h][_i] = g.rowmap[(pm_) * BM + _h * HALF + R_]; } \
        _Pragma("unroll") for (int _h = 0; _h < 2; ++_h) _Pragma("unroll") for (int _i = 0; _i < 2; ++_i) { int R_, C_; stage_rc(tid * 16 + _i * 8192, R_, C_); dst[_h][_i] = (unsigned)(rm_[_h][_i] * K + C_) * 2u; } } } while (0)
    const size_t kstep = (size_t)(BK * 2);
    const size_t hstep = (size_t)HALF * K * 2;
    const size_t tstep = 2 * hstep;
    const unsigned ldsw = (unsigned)wid * 1024u;
    const int aoff = lds_byte(wr * 64 + fr, fq * 8), boff = lds_byte(wc * 32 + fr, fq * 8);
#define PG8_SA(b, h) (((b) * 2 + (h)) * HTB)
#define PG8_SB(b, h) ((4 + (b) * 2 + (h)) * HTB)
#define PG8_STAGE(bufoff, gbase, voff) do { _Pragma("unroll") for (int _i = 0; _i < 2; ++_i) \
        __builtin_amdgcn_global_load_lds((const unsigned*)((const char*)(gbase) + (voff)[_i]), (LAS unsigned*)(lds + (bufoff) + ldsw + _i * 8192), 16, 0, 0); } while (0)
#define PG8_STAGE_A(bufoff, gbase, half, nextsel) do { if constexpr (GATHER) { unsigned _vo[2]; _Pragma("unroll") for (int _i = 0; _i < 2; ++_i) _vo[_i] = (nextsel) ? gN[half][_i] : gA[half][_i]; PG8_STAGE(bufoff, gbase, _vo); } \
        else { PG8_STAGE(bufoff, (gbase) + (half) * hstep, voffA); } } while (0)
#define PG8_LDA(dst, b, h) do { _Pragma("unroll") for (int m = 0; m < 4; ++m) _Pragma("unroll") for (int k = 0; k < 2; ++k) dst[m][k] = *(const LAS bf16x8*)(lds + PG8_SA(b, h) + aoff + m * 2048 + k * 1024); } while (0)
#define PG8_LDB(dst, b, h) do { _Pragma("unroll") for (int n = 0; n < 2; ++n) _Pragma("unroll") for (int k = 0; k < 2; ++k) dst[n][k] = *(const LAS bf16x8*)(lds + PG8_SB(b, h) + boff + n * 2048 + k * 1024); } while (0)
#define PG8_MMA(ai, bj, At, Bt) do { __builtin_amdgcn_s_setprio(1); _Pragma("unroll") for (int m = 0; m < 4; ++m) _Pragma("unroll") for (int n = 0; n < 2; ++n) _Pragma("unroll") for (int k = 0; k < 2; ++k) \
        acc[ai][bj][m][n] = __builtin_amdgcn_mfma_f32_16x16x32_bf16(Bt[n][k], At[m][k], acc[ai][bj][m][n], 0, 0, 0); __builtin_amdgcn_s_setprio(0); } while (0)
#define PG8_WAIT_V(n) asm volatile("s_waitcnt vmcnt(" #n ")" ::: "memory")
#define PG8_WAIT_L(n) asm volatile("s_waitcnt lgkmcnt(" #n ")" ::: "memory")
#define PG8_BAR __builtin_amdgcn_s_barrier()
#define PG8_SCHED __builtin_amdgcn_sched_barrier(0)
    Unit cur, nxt; int ui = 0;
    if (!S.next(0, cur)) return;
    f32x4 acc[2][2][4][2];
#pragma unroll
    for (int a = 0; a < 2; ++a)
#pragma unroll
        for (int b = 0; b < 2; ++b)
#pragma unroll
            for (int m = 0; m < 4; ++m)
#pragma unroll
                for (int n = 0; n < 2; ++n) acc[a][b][m][n] = (f32x4){0.f, 0.f, 0.f, 0.f};
    bf16x8 At[4][2], B0[2][2], B1[2][2];
    const char* cA = GATHER ? (const char*)g.A : (const char*)g.A + (size_t)cur.pm * tstep; const char* cB = (const char*)g.Bt + (size_t)cur.e * g.ebytes + (size_t)cur.pn * tstep;
    PG8_GLOAD(gA, cur.pm);
    if constexpr (SP2) {
        PG8_STAGE(PG8_SB(0, 0), cB, voffA); PG8_STAGE(PG8_SB(0, 1), cB + hstep, voffA); PG8_STAGE_A(PG8_SA(0, 0), cA, 0, false); PG8_STAGE_A(PG8_SA(0, 1), cA, 1, false);
        if (wr == 1) PG8_BAR;
        PG8_WAIT_V(2); PG8_BAR;
        PG8_STAGE(PG8_SB(1, 0), cB + kstep, voffA); PG8_STAGE_A(PG8_SA(1, 0), cA + kstep, 0, false); PG8_STAGE(PG8_SB(1, 1), cB + hstep + kstep, voffA);
        PG8_WAIT_V(6); PG8_BAR;
    } else {
    PG8_STAGE(PG8_SB(0, 0), cB, voffA); PG8_STAGE_A(PG8_SA(0, 0), cA, 0, false); PG8_STAGE(PG8_SB(0, 1), cB + hstep, voffA); PG8_STAGE_A(PG8_SA(0, 1), cA, 1, false);
    if (wr == 1) PG8_BAR;
    PG8_WAIT_V(4); PG8_BAR;
    PG8_STAGE(PG8_SB(1, 0), cB + kstep, voffA); PG8_STAGE_A(PG8_SA(1, 0), cA + kstep, 0, false); PG8_STAGE(PG8_SB(1, 1), cB + hstep + kstep, voffA);
    PG8_WAIT_V(6); PG8_BAR;
    }
    for (;;) {
        const bool has_next = S.next(ui + 1, nxt);
        const char* nA = GATHER ? cA : (has_next ? (const char*)g.A + (size_t)nxt.pm * tstep : cA); const char* nB = has_next ? (const char*)g.Bt + (size_t)nxt.e * g.ebytes + (size_t)nxt.pn * tstep : cB;
        PG8_GLOAD(gN, nxt.pm);
        for (int t = 0; t < nt; t += 2) {
            const bool last = (t == nt - 2);
            const char* a1 = cA + (size_t)(t + 1) * kstep;
            const char* a2 = last ? nA : cA + (size_t)(t + 2) * kstep; const char* b2 = last ? nB : cB + (size_t)(t + 2) * kstep;
            const char* a3 = a2 + kstep; const char* b3 = b2 + kstep;
            if constexpr (SP2) {
            PG8_LDB(B0, 0, 0); PG8_LDB(B1, 0, 1); PG8_SCHED; PG8_LDA(At, 0, 0); PG8_STAGE_A(PG8_SA(1, 1), a1, 1, false);
            PG8_WAIT_V(8); PG8_WAIT_L(0); PG8_BAR; PG8_MMA(0, 0, At, B0); PG8_MMA(0, 1, At, B1); PG8_BAR; PG8_SCHED;
            PG8_LDA(At, 0, 1); PG8_STAGE(PG8_SB(0, 0), b2, voffA); PG8_STAGE(PG8_SB(0, 1), b2 + hstep, voffA); PG8_STAGE_A(PG8_SA(0, 0), a2, 0, last);
            PG8_WAIT_V(8); PG8_WAIT_L(0); PG8_BAR; PG8_MMA(1, 0, At, B0); PG8_MMA(1, 1, At, B1); PG8_BAR; PG8_SCHED;
            PG8_LDB(B0, 1, 0); PG8_LDB(B1, 1, 1); PG8_SCHED; PG8_LDA(At, 1, 0); PG8_STAGE_A(PG8_SA(0, 1), a2, 1, last);
            PG8_WAIT_V(8); PG8_WAIT_L(0); PG8_BAR; PG8_MMA(0, 0, At, B0); PG8_MMA(0, 1, At, B1); PG8_BAR; PG8_SCHED;
            PG8_LDA(At, 1, 1); PG8_STAGE(PG8_SB(1, 0), b3, voffA); PG8_STAGE(PG8_SB(1, 1), b3 + hstep, voffA); PG8_STAGE_A(PG8_SA(1, 0), a3, 0, last);
            PG8_WAIT_V(8); PG8_WAIT_L(0); PG8_BAR; PG8_MMA(1, 0, At, B0); PG8_MMA(1, 1, At, B1); PG8_BAR; PG8_SCHED;
            } else {
            PG8_LDB(B0, 0, 0); PG8_SCHED; PG8_LDA(At, 0, 0); PG8_STAGE_A(PG8_SA(1, 1), a1, 1, false);
            PG8_WAIT_L(8); PG8_BAR; PG8_WAIT_L(0); PG8_MMA(0, 0, At, B0); PG8_BAR; PG8_SCHED;
            PG8_LDB(B1, 0, 1); PG8_STAGE(PG8_SB(0, 0), b2, voffA);
            PG8_BAR; PG8_WAIT_L(0); PG8_MMA(0, 1, At, B1); PG8_BAR;
            PG8_LDA(At, 0, 1); PG8_STAGE_A(PG8_SA(0, 0), a2, 0, last);
            PG8_BAR; PG8_WAIT_L(0); PG8_MMA(1, 0, At, B0); PG8_BAR; PG8_SCHED;
            PG8_STAGE(PG8_SB(0, 1), b2 + hstep, voffA);
            PG8_WAIT_V(6); PG8_BAR; PG8_MMA(1, 1, At, B1); PG8_BAR;
            PG8_LDB(B0, 1, 0); PG8_SCHED; PG8_LDA(At, 1, 0); PG8_STAGE_A(PG8_SA(0, 1), a2, 1, last);
            PG8_WAIT_L(8); PG8_BAR; PG8_WAIT_L(0); PG8_MMA(0, 0, At, B0); PG8_BAR; PG8_SCHED;
            PG8_LDB(B1, 1, 1); PG8_STAGE(PG8_SB(1, 0), b3, voffA);
            PG8_BAR; PG8_WAIT_L(0); PG8_MMA(0, 1, At, B1); PG8_BAR;
            PG8_LDA(At, 1, 1); PG8_STAGE_A(PG8_SA(1, 0), a3, 0, last);
            PG8_BAR; PG8_WAIT_L(0); PG8_MMA(1, 0, At, B0); PG8_BAR; PG8_SCHED;
            PG8_STAGE(PG8_SB(1, 1), b3 + hstep, voffA);
            PG8_WAIT_V(6); PG8_BAR; PG8_MMA(1, 1, At, B1); PG8_BAR;
            }
        }
        if constexpr (ALIGN_EPI) { if (wr == 0) PG8_BAR; }
        E(acc, cur, wr, wc, fr, fq);
        if (!has_next) break;
#pragma unroll
        for (int a = 0; a < 2; ++a)
#pragma unroll
            for (int b = 0; b < 2; ++b)
#pragma unroll
                for (int m = 0; m < 4; ++m)
#pragma unroll
                    for (int n = 0; n < 2; ++n) acc[a][b][m][n] = (f32x4){0.f, 0.f, 0.f, 0.f};
        cur = nxt; cA = nA; cB = nB; ++ui;
        if constexpr (GATHER) { _Pragma("unroll") for (int _h = 0; _h < 2; ++_h) _Pragma("unroll") for (int _i = 0; _i < 2; ++_i) gA[_h][_i] = gN[_h][_i]; }
        if constexpr (ALIGN_EPI) { if (wr == 1) PG8_BAR; }
    }
    PG8_WAIT_V(0);
    if constexpr (!ALIGN_EPI) { if (wr == 0) PG8_BAR; }
    PG8_BAR;
#undef PG8_SA
#undef PG8_SB
#undef PG8_STAGE
#undef PG8_STAGE_A
#undef PG8_GLOAD
#undef PG8_LDA
#undef PG8_LDB
#undef PG8_MMA
#undef PG8_WAIT_V
#undef PG8_WAIT_L
#undef PG8_BAR
#undef PG8_SCHED
}
}

constexpr int NIN = 39;
constexpr int LDS_STAGE = 131072;
constexpr int LDS_MISC = LDS_STAGE;
constexpr int LDS_BYTES = LDS_STAGE + 1024;
struct Args { const float* in[NIN]; float* out; unsigned char* ws; int ph_lo, ph_hi; };
enum { I_X = 0, I_WIN, I_WOUT, I_NMIX, I_NFFN, I_NFIN, I_HGLB, I_HGNW, I_SCW, I_SCB, I_SDTB, I_SALOG, I_SD, I_SNW, I_RCW, I_RCB, I_RWA, I_RBA, I_RWX, I_RBX, I_RLAM,
       I_WMU, I_WW0, I_WW2, I_WA0, I_WA2, I_WG2, I_WKK, I_WKA, I_WRK, I_WLNW, I_WLNB, I_RGW, I_RGB, I_REW, I_REB, I_MG, I_MU, I_MD };

__device__ __forceinline__ float bf2f(bf16_t x) { return __uint_as_float(((unsigned)x) << 16); }
struct BfPtr {
    const bf16_t* p;
    __device__ __forceinline__ float operator[](long i) const { return bf2f(p[i]); }
    __device__ __forceinline__ BfPtr operator+(long o) const { return BfPtr{p + o}; }
};
struct Frame {
    const float* const* in; float* h; unsigned char* ws; unsigned char* lds;
    int G, bid;
    BfPtr P; bf16_t* Pw; float* Q; float* O; bf16_t* U; bf16_t* MIX; bf16_t* XPERM; bf16_t* HID; bf16_t* Y;
    unsigned* ctl; unsigned char* tab;
};

__device__ __forceinline__ void tconv_tile256(float* sm, const float* __restrict__ src, int N, int k0, int n0, int nlim, bf16_t* dstA, bf16_t* dstB, int K, int tid) {
    {
        const int r = tid >> 6, c4 = (tid & 63) * 4; const int n = n0 + c4;
        f32x4 v[8];
#pragma unroll
        for (int it = 0; it < 8; ++it) { v[it] = (f32x4){0.f, 0.f, 0.f, 0.f}; if (n < nlim) v[it] = *(const f32x4*)(src + (size_t)(k0 + r + 8 * it) * N + n); }
#pragma unroll
        for (int it = 0; it < 8; ++it) *(f32x4*)(sm + (r + 8 * it) * 260 + c4) = v[it];
    }
    __syncthreads();
    {
        const int kq = (tid & 7) * 8;
#pragma unroll
        for (int ps = 0; ps < 4; ++ps) {
            const int n = (tid >> 3) + 64 * ps;
            float v[8];
#pragma unroll
            for (int i = 0; i < 8; ++i) v[i] = sm[(kq + i) * 260 + n];
            u32x4 w; w.x = cvt_pk_bf16(v[0], v[1]); w.y = cvt_pk_bf16(v[2], v[3]); w.z = cvt_pk_bf16(v[4], v[5]); w.w = cvt_pk_bf16(v[6], v[7]);
            bf16_t* dst = (n < 128) ? dstA + (size_t)n * K : dstB + (size_t)(n - 128) * K;
            *(u32x4*)(dst + k0 + kq) = w;
        }
    }
    __syncthreads();
}

constexpr int DEFER_TILES = 1152, DEFER_GEMM = 1536;
__device__ __forceinline__ void conv_down_tile(const Frame& F, int q, int tid_) {
    const int le = q / 128, r = q % 128, kt = r / 8, ntl = r % 8;
    bf16_t* d = (bf16_t*)(F.ws + WS_WD) + ((size_t)le * D + ntl * 256) * DEXP;
    tconv_tile256((float*)F.lds, F.in[I_MD] + (size_t)le * DEXP * D, D, kt * 64, ntl * 256, D, d, d + (size_t)128 * DEXP, DEXP, tid_);
}
__device__ __forceinline__ void phase_prologue(const Frame& F) {
    const int tid_ = opaque_tid();
    float* sm = (float*)F.lds;
    constexpr int T_IN = 2 * 32 * 26, T_OUT = 2 * 32 * 8, T_G = 64 * 32 * 4, T_D = 64 * 16 * 8;
    constexpr int T_ALL = T_IN + T_OUT + 2 * T_G + T_D;
    for (int t = F.bid; t < T_ALL - DEFER_TILES - DEFER_GEMM; t += F.G) {
        if (t < T_IN) {
            const int l = t / (32 * 26), r = t % (32 * 26), kt = r / 26, ntl = r % 26;
            bf16_t* d = (bf16_t*)(F.ws + WS_WIN) + ((size_t)l * PS + ntl * 256) * D;
            tconv_tile256(sm, F.in[I_WIN] + (size_t)l * D * IN_COLS, IN_COLS, kt * 64, ntl * 256, IN_COLS, d, d + (size_t)128 * D, D, tid_);
        } else if (t < T_IN + T_OUT) {
            const int q = t - T_IN; const int l = q / 256, r = q % 256, kt = r / 8, ntl = r % 8;
            bf16_t* d = (bf16_t*)(F.ws + WS_WOUT) + ((size_t)l * D + ntl * 256) * D;
            tconv_tile256(sm, F.in[I_WOUT] + (size_t)l * D * D, D, kt * 64, ntl * 256, D, d, d + (size_t)128 * D, D, tid_);
        } else if (t < T_IN + T_OUT + 2 * T_G) {
            int q = t - T_IN - T_OUT; const int sgu = q / T_G; q %= T_G;
            const int le = q / 128, r = q % 128, kt = r / 4, ntl = r % 4;
            const int n0 = ntl * 256;
            bf16_t* d = (bf16_t*)(F.ws + WS_WGU) + ((size_t)le * 2048 + 256 * (n0 >> 7) + 128 * sgu) * D;
            tconv_tile256(sm, F.in[sgu ? I_MU : I_MG] + (size_t)le * D * DEXP, DEXP, kt * 64, n0, DEXP, d, d + (size_t)256 * D, D, tid_);
        } else {
            conv_down_tile(F, t - T_IN - T_OUT - 2 * T_G, tid_);
        }
    }
    for (int e = F.bid * 512 + tid_; e < 2 * 48 * 2048; e += F.G * 512) {
        const int l = e / (48 * 2048), c = (e / 2048) % 48, k = e % 2048;
        float v = 0.f;
        if (c < 4) v = F.in[I_RGW][((size_t)l * D + k) * 4 + c]; else if (c < 36) v = F.in[I_REW][((size_t)l * D + k) * 32 + (c - 4)];
        ((float*)(F.ws + WS_WRT))[e] = v * F.in[I_NFFN][(size_t)l * D + k];
    }
    for (int e = F.bid * 512 + tid_; e < 2 * 294912; e += F.G * 512) {
        const int l = e / 294912; int r = e % 294912;
        bf16_t* sw = (bf16_t*)(F.ws + WS_SW + (size_t)l * SW_LAYER);
        int K, n, k, base;
        if (r < 49152) { base = SW_W2T / 2; K = 96; } else if (r < 98304) { r -= 49152; base = SW_A2T / 2; K = 96; } else if (r < 229376) { r -= 98304; base = SW_G2T / 2; K = 256; }
        else if (r < 262144) { r -= 229376; base = SW_WAT / 2; K = 64; } else { r -= 262144; base = SW_WXT / 2; K = 64; }
        { const int j = r & 7, ln = (r >> 3) & 63, blk = r >> 9, KS = K / 32, nt = blk / KS, ks = blk % KS; n = nt * 16 + (ln & 15); k = ks * 32 + (ln >> 4) * 8 + j; }
        float v;
        if (base == (int)(SW_W2T / 2)) v = F.in[I_WW2][((size_t)l * 96 + k) * GW + n];
        else if (base == (int)(SW_A2T / 2)) v = F.in[I_WA2][((size_t)l * 96 + k) * GW + n];
        else if (base == (int)(SW_G2T / 2)) v = F.in[I_WG2][((size_t)l * 256 + k) * GW + n];
        else if (base == (int)(SW_WAT / 2)) v = F.in[I_RWA][(((size_t)l * 8 + (n >> 6)) * 64 + k) * 64 + (n & 63)];
        else v = F.in[I_RWX][(((size_t)l * 8 + (n >> 6)) * 64 + k) * 64 + (n & 63)];
        sw[base + r] = f2bf(v);
    }
}

__device__ __forceinline__ void phase_norm1(const Frame& F, int mode, const float* __restrict__ w) {
    const int tid_ = opaque_tid(); const int lane_ = tid_ & 63; const int wave_ = __builtin_amdgcn_readfirstlane(tid_ >> 6); (void)lane_; (void)wave_;
    const int gw = F.bid * 8 + wave_, nw = F.G * 8;
    const int* tokslot = (const int*)(F.tab + TAB_TOKSLOT);
    for (int t = gw; t < NTOK; t += nw) {
        float4 v[8];
        const float* src = (mode == 0) ? F.in[I_X] : F.h;
#pragma unroll
        for (int j = 0; j < 8; ++j) v[j] = *(const float4*)(src + (size_t)t * D + 4 * (lane_ + 64 * j));
        if (mode != 0) {
            const int s0 = tokslot[2 * t], s1 = tokslot[2 * t + 1];
#pragma unroll
            for (int j = 0; j < 8; ++j) {
                const u32x2 pa = *(const u32x2*)(F.Y + (size_t)s0 * D + 4 * (lane_ + 64 * j));
                const u32x2 pb = *(const u32x2*)(F.Y + (size_t)s1 * D + 4 * (lane_ + 64 * j));
                v[j].x += __uint_as_float(pa.x << 16) + __uint_as_float(pb.x << 16); v[j].y += __uint_as_float(pa.x & 0xffff0000u) + __uint_as_float(pb.x & 0xffff0000u);
                v[j].z += __uint_as_float(pa.y << 16) + __uint_as_float(pb.y << 16); v[j].w += __uint_as_float(pa.y & 0xffff0000u) + __uint_as_float(pb.y & 0xffff0000u);
            }
        }
        float ss = 0.f;
#pragma unroll
        for (int j = 0; j < 8; ++j) ss += v[j].x * v[j].x + v[j].y * v[j].y + v[j].z * v[j].z + v[j].w * v[j].w;
        ss = wave_sum(ss);
        const float rs = rsqrtf(ss * (1.0f / D) + NORM_EPS);
#pragma unroll
        for (int j = 0; j < 8; ++j) {
            const int c = 4 * (lane_ + 64 * j);
            const float4 wv = *(const float4*)(w + c);
            if (mode == 2) {
                float4 o; o.x = v[j].x * rs * wv.x; o.y = v[j].y * rs * wv.y; o.z = v[j].z * rs * wv.z; o.w = v[j].w * rs * wv.w;
                *(float4*)(F.h + (size_t)t * D + c) = o;
            } else {
                if (mode != 0) *(float4*)(F.h + (size_t)t * D + c) = v[j];
                u32x2 p; p.x = cvt_pk_bf16(v[j].x * rs * wv.x, v[j].y * rs * wv.y); p.y = cvt_pk_bf16(v[j].z * rs * wv.z, v[j].w * rs * wv.w);
                *(u32x2*)(F.U + (size_t)t * D + c) = p;
            }
        }
    }
}


template <int K>
__device__ __forceinline__ f32x4 mma16(const bf16_t* A, int lda, const bf16_t* Bt, int ldb, int lane, f32x4 acc);
__device__ __forceinline__ u32x4 pack8(const float (&v)[8]);
__device__ __forceinline__ float bflo(unsigned u) { return __uint_as_float(u << 16); }
__device__ __forceinline__ float bfhi(unsigned u) { return __uint_as_float(u & 0xffff0000u); }
__device__ __forceinline__ float bfel(const u32x4 r, int e) { const unsigned u = (e < 2) ? r.x : (e < 4) ? r.y : (e < 6) ? r.z : r.w; return (e & 1) ? bfhi(u) : bflo(u); }
__device__ __forceinline__ void pre_steps14(const Frame& F, int l, int ch) {
    const int tid = opaque_tid();
    bf16_t* XB = (bf16_t*)F.lds;
    bf16_t* AW = (bf16_t*)(F.lds + 66560);
    bf16_t* AA = (bf16_t*)(F.lds + 79872);
    bf16_t* AG = (bf16_t*)(F.lds + 93184);
    const size_t t0 = (size_t)ch * 64; const bool has_prev = (ch & 63) != 0;
    const bf16_t* Pb = F.P.p;
    const u32x4 zero4 = {0u, 0u, 0u, 0u};
    const int tsG = tid >> 6, tsW = tid / 56, j0W = 8 * (tid % 56);
    u32x4 rawG[11], rawW[9];
#pragma unroll
    for (int i = 0; i < 11; ++i) { const int tok = tsG * 8 - 3 + i; rawG[i] = (tok >= 0 || has_prev) ? *(const u32x4*)(Pb + (long)((long)t0 + tok) * PS + C_RG_X + 8 * (tid & 63)) : zero4; }
    if (tid < 448) {
#pragma unroll
        for (int i = 0; i < 9; ++i) { const int tok = tsW * 8 - 1 + i; rawW[i] = (tok >= 0 || has_prev) ? *(const u32x4*)(Pb + (long)((long)t0 + tok) * PS + C_RW + 1536 + j0W) : zero4; }
    }
    {
        const int c0 = 8 * (tid & 127), tq = tid >> 7;
        const float* scw = F.in[I_SCW] + (size_t)l * 4 * 1024 + c0; const float* scb = F.in[I_SCB] + (size_t)l * 1024 + c0;
        u32x4 raw[19];
#pragma unroll
        for (int i = 0; i < 19; ++i) { const int tok = tq * 16 - 3 + i; raw[i] = (tok >= 0 || has_prev) ? *(const u32x4*)(Pb + (long)((long)t0 + tok) * PS + C_SS_X + c0) : zero4; }
        float cw[4][8], cb[8];
#pragma unroll
        for (int k = 0; k < 4; ++k) { const f32x4 a = *(const f32x4*)(scw + k * 1024), b = *(const f32x4*)(scw + k * 1024 + 4);
#pragma unroll
            for (int e = 0; e < 4; ++e) { cw[k][e] = a[e]; cw[k][4 + e] = b[e]; } }
        { const f32x4 a = *(const f32x4*)(scb), b = *(const f32x4*)(scb + 4);
#pragma unroll
            for (int e = 0; e < 4; ++e) { cb[e] = a[e]; cb[4 + e] = b[e]; } }
#pragma unroll
        for (int t = 0; t < 16; ++t) {
            float o[8];
#pragma unroll
            for (int e = 0; e < 8; ++e) o[e] = silu_f(cb[e] + cw[3][e] * bfel(raw[t + 3], e) + cw[2][e] * bfel(raw[t + 2], e) + cw[1][e] * bfel(raw[t + 1], e) + cw[0][e] * bfel(raw[t], e));
            *(u32x4*)((bf16_t*)(F.Q + (t0 + tq * 16 + t) * QS) + c0) = pack8(o);
        }
    }
    {
        const int c0 = 8 * (tid & 63);
        const float* rcw = F.in[I_RCW] + (size_t)l * 4 * GW + c0; const float* rcb = F.in[I_RCB] + (size_t)l * GW + c0;
        float cw[4][8], cb[8];
#pragma unroll
        for (int k = 0; k < 4; ++k) { const f32x4 a = *(const f32x4*)(rcw + k * GW), b = *(const f32x4*)(rcw + k * GW + 4);
#pragma unroll
            for (int e = 0; e < 4; ++e) { cw[k][e] = a[e]; cw[k][4 + e] = b[e]; } }
        { const f32x4 a = *(const f32x4*)(rcb), b = *(const f32x4*)(rcb + 4);
#pragma unroll
            for (int e = 0; e < 4; ++e) { cb[e] = a[e]; cb[4 + e] = b[e]; } }
#pragma unroll
        for (int t = 0; t < 8; ++t) {
            float o[8];
#pragma unroll
            for (int e = 0; e < 8; ++e) o[e] = cb[e] + cw[3][e] * bfel(rawG[t + 3], e) + cw[2][e] * bfel(rawG[t + 2], e) + cw[1][e] * bfel(rawG[t + 1], e) + cw[0][e] * bfel(rawG[t], e);
            *(u32x4*)(XB + (tsG * 8 + t) * 520 + c0) = pack8(o);
        }
    }
    if (tid < 448) {
        const int ts = tsW, j0 = j0W;
        const float* mu = F.in[I_WMU] + (size_t)l * RW_COLS + 1536 + j0;
        float m8[8];
        { const f32x4 a = *(const f32x4*)(mu), b = *(const f32x4*)(mu + 4);
#pragma unroll
            for (int e = 0; e < 4; ++e) { m8[e] = a[e]; m8[4 + e] = b[e]; } }
#pragma unroll
        for (int t = 0; t < 8; ++t) {
            float o[8];
#pragma unroll
            for (int e = 0; e < 8; ++e) { const float cur = bfel(rawW[t + 1], e), prev = bfel(rawW[t], e); const float v = cur + (prev - cur) * m8[e]; o[e] = (j0 < 96) ? ftanh(v) : (j0 < 192) ? v : sigmoid_f(v); }
            const int tt = ts * 8 + t;
            bf16_t* dst = (j0 < 96) ? AW + tt * 104 + j0 : (j0 < 192) ? AA + tt * 104 + (j0 - 96) : AG + tt * 264 + (j0 - 192);
            *(u32x4*)dst = pack8(o);
        }
    }
}
template <int KS>
__device__ __forceinline__ f32x4 mma16f(const bf16_t* A, int lda, const bf16_t* Bf, int lane, f32x4 acc) {
    const bf16_t* ap = A + (lane & 15) * lda + (lane >> 4) * 8; const bf16_t* bp = Bf + lane * 8;
#pragma unroll
    for (int ks = 0; ks < KS; ++ks) { const bf16x8 a = *(const bf16x8*)(ap + ks * 32); const bf16x8 b = *(const bf16x8*)(bp + ks * 512); acc = __builtin_amdgcn_mfma_f32_16x16x32_bf16(a, b, acc, 0, 0, 0); }
    return acc;
}
template <int KS>
__device__ __forceinline__ f32x4 mma16p(const bf16_t* A, int lda, const bf16x8* f, int lane, f32x4 acc) {
    const bf16_t* ap = A + (lane & 15) * lda + (lane >> 4) * 8;
#pragma unroll
    for (int ks = 0; ks < KS; ++ks) { const bf16x8 a = *(const bf16x8*)(ap + ks * 32); acc = __builtin_amdgcn_mfma_f32_16x16x32_bf16(a, f[ks], acc, 0, 0, 0); }
    return acc;
}
__device__ __forceinline__ void store_pair(float* base, int q, int cl, int jj, float va, float vb) {
    const auto sw = __builtin_amdgcn_permlane32_swap(__float_as_uint(va), __float_as_uint(vb), false, false);
    const bool lo = q < 2; const int qq = q & 1, ch = lo ? cl : 16 + cl;
    base[(size_t)(4 * qq + jj) * QS + ch] = __uint_as_float(sw[0]);
    base[(size_t)(4 * (qq + 2) + jj) * QS + ch] = __uint_as_float(sw[1]);
}
__device__ __forceinline__ void pre_5a(const Frame& F, int l, int ch) {
    const int j = opaque_tid(); const int lane = j & 63; const int w = __builtin_amdgcn_readfirstlane(j >> 6);
    bf16_t* XB = (bf16_t*)F.lds;
    bf16_t* AW = (bf16_t*)(F.lds + 66560);
    bf16_t* AA = (bf16_t*)(F.lds + 79872);
    bf16_t* AG = (bf16_t*)(F.lds + 93184);
    const bf16_t* sw = (const bf16_t*)(F.ws + WS_SW + (size_t)l * SW_LAYER);
    const bf16_t* W2T = sw + SW_W2T / 2; const bf16_t* A2T = sw + SW_A2T / 2; const bf16_t* G2T = sw + SW_G2T / 2; const bf16_t* WAT = sw + SW_WAT / 2; const bf16_t* WXT = sw + SW_WXT / 2;
    float lb = 0.f;
    if (l > 0) { const float p0 = F.in[I_HGLB][j], p1 = F.in[I_HGLB][GW + j]; const float m = fmaxf(p0, p1); const float e0 = fexp(p0 - m), e1 = fexp(p1 - m); lb = e1 / (e0 + e1); }
    const float* scw = F.in[I_SCW] + (size_t)l * 4 * 1024; const float* scb = F.in[I_SCB] + (size_t)l * 1024;
    const float* rcw = F.in[I_RCW] + (size_t)l * 4 * GW; const float* rcb = F.in[I_RCB] + (size_t)l * GW;
    const float* mu = F.in[I_WMU] + (size_t)l * RW_COLS;
        const size_t t0 = (size_t)ch * 64;
        const f32x4 z4 = (f32x4){0.f, 0.f, 0.f, 0.f};
        const int cl = lane & 15, rq = 4 * (lane >> 4);
#ifndef SKIP_5A
        {
            int l5 = l; asm volatile("" : "+s"(l5));
            float ba[4], bx[4], spl[4];
#pragma unroll
            for (int n = 0; n < 4; ++n) { const int c = w * 64 + n * 16 + cl; ba[n] = F.in[I_RBA][l5 * GW + c]; bx[n] = F.in[I_RBX][l5 * GW + c]; spl[n] = softplus_f(-F.in[I_RLAM][l5 * GW + c]); }
#pragma unroll
            for (int m = 0; m < 4; ++m)
#pragma unroll
                for (int np = 0; np < 2; ++np) {
                    float av[2][4], uv[2][4];
#pragma unroll
                    for (int h2 = 0; h2 < 2; ++h2) {
                        const int n = 2 * np + h2, c = w * 64 + n * 16 + cl;
                        const f32x4 ra = mma16f<2>(XB + m * 16 * 520 + w * 64, 520, WAT + ((w * 4 + n) * 2) * 512, lane, z4);
                        const f32x4 ri = mma16f<2>(XB + m * 16 * 520 + w * 64, 520, WXT + ((w * 4 + n) * 2) * 512, lane, z4);
#pragma unroll
                        for (int jj = 0; jj < 4; ++jj) {
                            const int t = m * 16 + rq + jj;
                            const float r = sigmoid_f(ra[jj] + ba[n]), ii = sigmoid_f(ri[jj] + bx[n]);
                            const float la = -8.0f * r * spl[n]; av[h2][jj] = fexp(la);
                            uv[h2][jj] = __builtin_amdgcn_sqrtf(1.0f - fexp(2.0f * la)) * (ii * bf2f(XB[t * 520 + c]));
                        }
                    }
                    float* qb = F.Q + (t0 + m * 16) * QS + w * 64 + np * 32;
#pragma unroll
                    for (int jj = 0; jj < 4; ++jj) { store_pair(qb + Q_RGA, lane >> 4, cl, jj, av[0][jj], av[1][jj]); store_pair(qb + Q_RGU, lane >> 4, cl, jj, uv[0][jj], uv[1][jj]); }
                }
        }
#endif
}
__device__ __forceinline__ void pre_5b(const Frame& F, int l, int ch) {
    const int j = opaque_tid(); const int lane = j & 63; const int w = __builtin_amdgcn_readfirstlane(j >> 6);
    bf16_t* XB = (bf16_t*)F.lds;
    bf16_t* AW = (bf16_t*)(F.lds + 66560);
    bf16_t* AA = (bf16_t*)(F.lds + 79872);
    bf16_t* AG = (bf16_t*)(F.lds + 93184);
    const bf16_t* sw = (const bf16_t*)(F.ws + WS_SW + (size_t)l * SW_LAYER);
    const bf16_t* W2T = sw + SW_W2T / 2; const bf16_t* A2T = sw + SW_A2T / 2; const bf16_t* G2T = sw + SW_G2T / 2; const bf16_t* WAT = sw + SW_WAT / 2; const bf16_t* WXT = sw + SW_WXT / 2;
    float lb = 0.f;
    if (l > 0) { const float p0 = F.in[I_HGLB][j], p1 = F.in[I_HGLB][GW + j]; const float m = fmaxf(p0, p1); const float e0 = fexp(p0 - m), e1 = fexp(p1 - m); lb = e1 / (e0 + e1); }
    const float* scw = F.in[I_SCW] + (size_t)l * 4 * 1024; const float* scb = F.in[I_SCB] + (size_t)l * 1024;
    const float* rcw = F.in[I_RCW] + (size_t)l * 4 * GW; const float* rcb = F.in[I_RCB] + (size_t)l * GW;
    const float* mu = F.in[I_WMU] + (size_t)l * RW_COLS;
        const size_t t0 = (size_t)ch * 64;
        const f32x4 z4 = (f32x4){0.f, 0.f, 0.f, 0.f};
        const int cl = lane & 15, rq = 4 * (lane >> 4);
#ifndef SKIP_5B
        {
            int l5 = l; asm volatile("" : "+s"(l5));
            const float* mu5 = F.in[I_WMU] + (size_t)l5 * RW_COLS;
            float kkc[4], mk[4];
#pragma unroll
            for (int n = 0; n < 4; ++n) { const int c = w * 64 + n * 16 + cl; kkc[n] = F.in[I_WKK][l5 * GW + c]; mk[n] = mu5[512 + c]; }
#define PRE5B_LOADW(dst, n_) do { const bf16_t* b2_ = W2T + ((w * 4 + (n_)) * 3) * 512 + lane * 8; \
        _Pragma("unroll") for (int ks_ = 0; ks_ < 3; ++ks_) dst[ks_] = *(const bf16x8*)(b2_ + ks_ * 512); } while (0)
#define PRE5B_LOADA(dst, n_) do { const bf16_t* ba_ = A2T + ((w * 4 + (n_)) * 3) * 512 + lane * 8; \
        _Pragma("unroll") for (int ks_ = 0; ks_ < 3; ++ks_) dst[ks_] = *(const bf16x8*)(ba_ + ks_ * 512); } while (0)
#define PRE5B_LOADG(dst, n_) do { const bf16_t* bg_ = G2T + ((w * 4 + (n_)) * 8) * 512 + lane * 8; \
        _Pragma("unroll") for (int ks_ = 0; ks_ < 8; ++ks_) dst[ks_] = *(const bf16x8*)(bg_ + ks_ * 512); } while (0)
            for (int m = 0; m < 4; ++m) {
                {
                    bf16_t* stg = (bf16_t*)F.lds + w * 4096;
                    const size_t trow0 = t0 + m * 16;
                    const bool hp0 = ((trow0 & (SEQ - 1)) != 0);
#pragma unroll
                    for (int it = 0; it < 7; ++it) {
                        const int seg = it * 8 + (lane >> 3);
                        if (seg < 51) {
                            const int row = seg / 3, grp = seg - row * 3;
                            u32x4 v = {0u, 0u, 0u, 0u};
                            if (row > 0 || hp0) v = *(const u32x4*)(F.P.p + (long)((long)trow0 - 1 + row) * PS + C_RW + grp * 512 + w * 64 + (lane & 7) * 8);
                            *(u32x4*)(stg + row * 196 + grp * 64 + (lane & 7) * 8) = v;
                        }
                    }
                }
                const bf16_t* spb = (const bf16_t*)F.lds + w * 4096 + rq * 196 + cl;
                bf16x8 wa0[3]; PRE5B_LOADW(wa0, 0);
                float inv[4];
                {
                    float ssq[4] = {0.f, 0.f, 0.f, 0.f};
#pragma unroll
                    for (int n = 0; n < 4; ++n) { float kp = bf2f(spb[n * 16 + 64]);
#pragma unroll
                        for (int jj = 0; jj < 4; ++jj) { const float kc = bf2f(spb[(jj + 1) * 196 + n * 16 + 64]); const float x = (kc + (kp - kc) * mk[n]) * kkc[n]; ssq[jj] += x * x; kp = kc; } }
#pragma unroll
                    for (int jj = 0; jj < 4; ++jj) inv[jj] = frcp(fmaxf(__builtin_amdgcn_sqrtf(row16_sum(ssq[jj])), 1e-12f));
                }
#define PRE5B_TILE(n, wac, wan, more) do { const int c = w * 64 + (n) * 16 + cl; bf16x8 fa[3], fg[8]; PRE5B_LOADA(fa, n); PRE5B_LOADG(fg, n); \
        const f32x4 ws = mma16p<3>(AW + m * 16 * 104, 104, wac, lane, z4); \
        if (more) PRE5B_LOADW(wan, (n) + 1); \
        const f32x4 as = mma16p<3>(AA + m * 16 * 104, 104, fa, lane, z4); \
        __builtin_amdgcn_sched_barrier(0); \
        f32x4 gs = mma16p<4>(AG + m * 16 * 264, 264, fg, lane, z4); \
        __builtin_amdgcn_sched_barrier(0); \
        gs = mma16p<4>(AG + m * 16 * 264 + 128, 264, fg + 4, lane, gs); \
        __builtin_amdgcn_sched_barrier(0); \
        const float w0n = F.in[I_WW0][l5 * GW + c], a0n = F.in[I_WA0][l5 * GW + c], kan = F.in[I_WKA][l5 * GW + c]; \
        const bf16_t* spk = (const bf16_t*)F.lds + w * 4096 + rq * 196 + 64 + (n) * 16 + cl; float kprev = bf2f(spk[0]); \
        _Pragma("unroll") for (int jj = 0; jj < 4; ++jj) { \
            const float kcur = bf2f(spk[(jj + 1) * 196]); const float k0v = kcur + (kprev - kcur) * mk[n]; kprev = kcur; \
            const float wlog = -softplus_f(-(w0n + ws[jj])) - 0.5f; const float decay = fexp(-fexp(wlog)); const float a = sigmoid_f(a0n + as[jj]); \
            const float kk = k0v * kkc[n] * inv[jj]; const float k = k0v * (1.0f + (a - 1.0f) * kan); \
            float* q = F.Q + (t0 + m * 16 + rq + jj) * QS; \
            q[Q_W + c] = decay; q[Q_K + c] = k; q[Q_KKA + c] = kk * a; q[Q_G + c] = gs[jj]; } } while (0)
                {
                    bf16x8 wa1[3];
                    PRE5B_TILE(0, wa0, wa1, true);
                    PRE5B_TILE(1, wa1, wa0, true);
                    PRE5B_TILE(2, wa0, wa1, true);
                    PRE5B_TILE(3, wa1, wa0, false);
                }
#undef PRE5B_TILE
            }
#undef PRE5B_LOADW
#undef PRE5B_LOADA
#undef PRE5B_LOADG
        }
#endif
}
__device__ __forceinline__ void phase_pre(const Frame& F, int l) {
    for (int ch = F.bid; ch < NTOK / 64; ch += F.G) { pre_steps14(F, l, ch); __syncthreads(); pre_5a(F, l, ch); pre_5b(F, l, ch); __syncthreads(); }
}


template <int K>
__device__ __forceinline__ f32x4 mma16(const bf16_t* A, int lda, const bf16_t* Bt, int ldb, int lane, f32x4 acc) {
    const int r = lane & 15, kq = (lane >> 4) * 8;
    const bf16_t* ap = A + r * lda + kq; const bf16_t* bp = Bt + r * ldb + kq;
#pragma unroll
    for (int k0 = 0; k0 < K; k0 += 32) {
        const bf16x8 a = *(const bf16x8*)(ap + k0); const bf16x8 b = *(const bf16x8*)(bp + k0);
        acc = __builtin_amdgcn_mfma_f32_16x16x32_bf16(a, b, acc, 0, 0, 0);
    }
    return acc;
}
__device__ __forceinline__ float wave_scan_incl(float v, int lane) {
#pragma unroll
    for (int o = 1; o < 64; o <<= 1) { const float u = __shfl_up(v, o); if (lane >= o) v += u; }
    return v;
}

__device__ __forceinline__ void rg_local(const Frame& F, int u, int tid) {
    const int b = u >> 6, c = u & 63; const size_t t0 = (size_t)b * SEQ + c * 64;
    float* rgc = (float*)(F.ws + WS_R4 + R4_RGC);
    float ap = 1.f, h = 0.f;
#pragma unroll 1
    for (int tb = 0; tb < 64; tb += 32) {
        float a[32], uu[32];
#pragma unroll
        for (int i = 0; i < 32; ++i) { a[i] = F.Q[(t0 + tb + i) * QS + Q_RGA + tid]; uu[i] = F.Q[(t0 + tb + i) * QS + Q_RGU + tid]; }
#pragma unroll
        for (int i = 0; i < 32; ++i) { h = a[i] * h + uu[i]; ap *= a[i]; }
    }
    rgc[((size_t)u * 512 + tid) * 2] = ap; rgc[((size_t)u * 512 + tid) * 2 + 1] = h;
}
__device__ __forceinline__ void rg_scan(const Frame& F, int e) {
    const int b = e >> 9, j = e & 511;
    float* rgc = (float*)(F.ws + WS_R4 + R4_RGC);
    float h = 0.f;
    for (int c = 0; c < 64; ++c) { float* p = rgc + ((size_t)(b * 64 + c) * 512 + j) * 2; const float ap = p[0], he = p[1]; p[1] = h; h = ap * h + he; }
}
__device__ __forceinline__ void rg_out(const Frame& F, int u, int tid) {
    const int b = u >> 6, c = u & 63; const size_t t0 = (size_t)b * SEQ + c * 64;
    const float* rgc = (const float*)(F.ws + WS_R4 + R4_RGC);
    float h = rgc[((size_t)u * 512 + tid) * 2 + 1];
#pragma unroll 1
    for (int tb = 0; tb < 64; tb += 32) {
        float a[32], uu[32], gt[32];
#pragma unroll
        for (int i = 0; i < 32; ++i) { a[i] = F.Q[(t0 + tb + i) * QS + Q_RGA + tid]; uu[i] = F.Q[(t0 + tb + i) * QS + Q_RGU + tid]; gt[i] = F.P[(t0 + tb + i) * PS + C_RG_G + tid]; }
#pragma unroll
        for (int i = 0; i < 32; ++i) { h = a[i] * h + uu[i]; F.MIX[(t0 + tb + i) * D + 1024 + tid] = f2bf(h * gelu_tanh_f(gt[i])); }
    }
}

__device__ __forceinline__ void ssd_acum(const Frame& F, int l, size_t t0, int g, float* acum, int tid) {
    const int lane = tid & 63, w = tid >> 6;
    if (w < 4) {
        const int head = 4 * g + w;
        const float A = -fexp(F.in[I_SALOG][l * 8 + head]);
        const float dtv = softplus_f(F.P[(t0 + lane) * PS + C_SS_DT + head] + F.in[I_SDTB][l * 8 + head]);
        acum[256 + w * 64 + lane] = dtv;
        acum[w * 64 + lane] = wave_scan_incl(dtv * A, lane);
    }
}
__device__ __forceinline__ void ssd_local(const Frame& F, int l, int u, int tid) {
    const int g = u & 1, c = (u >> 1) & 63, b = u >> 7; const size_t t0 = (size_t)b * SEQ + c * 64;
    const int lane = tid & 63, w = __builtin_amdgcn_readfirstlane(tid >> 6);
    float* acum = (float*)F.lds;
    bf16_t* BmT = (bf16_t*)(F.lds + 2048);
    bf16_t* XW = (bf16_t*)(F.lds + 2048 + 18432);
    ssd_acum(F, l, t0, g, acum, tid);
    LDS_BARRIER();
    if (tid < 256) {
        const int hh = tid >> 6, p = tid & 63, head = 4 * g + hh;
        const float aend = acum[hh * 64 + 63];
#pragma unroll
        for (int l8 = 0; l8 < 8; ++l8) {
            float v[8];
#pragma unroll
            for (int i = 0; i < 8; ++i) { const int tt = l8 * 8 + i; const float x = bf2f(((const bf16_t*)(F.Q + (t0 + tt) * QS))[head * 64 + p]); const float dtv = acum[256 + hh * 64 + tt];
                v[i] = x * dtv * fexp(aend - acum[hh * 64 + tt]); }
            u32x4 pk; pk.x = cvt_pk_bf16(v[0], v[1]); pk.y = cvt_pk_bf16(v[2], v[3]); pk.z = cvt_pk_bf16(v[4], v[5]); pk.w = cvt_pk_bf16(v[6], v[7]);
            *(u32x4*)(XW + (hh * 64 + p) * 72 + l8 * 8) = pk;
        }
    } else {
        const int n = tid & 127, lh = (tid - 256) >> 7;
#pragma unroll
        for (int l8 = 0; l8 < 4; ++l8) {
            float v[8];
#pragma unroll
            for (int i = 0; i < 8; ++i) { const int tt = lh * 32 + l8 * 8 + i; v[i] = bf2f(((const bf16_t*)(F.Q + (t0 + tt) * QS))[512 + g * 128 + n]); }
            u32x4 pk; pk.x = cvt_pk_bf16(v[0], v[1]); pk.y = cvt_pk_bf16(v[2], v[3]); pk.z = cvt_pk_bf16(v[4], v[5]); pk.w = cvt_pk_bf16(v[6], v[7]);
            *(u32x4*)(BmT + n * 72 + lh * 32 + l8 * 8) = pk;
        }
    }
    LDS_BARRIER();
    {
        const int hh = w >> 1, head = 4 * g + hh;
        bf16_t* dst = (bf16_t*)(F.ws + WS_R4 + R4_SSS) + ((size_t)(b * 8 + head) * 64 + c) * 8192;
#pragma unroll
        for (int pi = 0; pi < 4; ++pi)
#pragma unroll
            for (int nn = 0; nn < 4; ++nn) {
                const int ni = (w & 1) * 4 + nn;
                const f32x4 acc = mma16<64>(BmT + ni * 16 * 72, 72, XW + (hh * 64 + pi * 16) * 72, 72, lane, (f32x4){0.f, 0.f, 0.f, 0.f});
                u32x2 pk; pk.x = cvt_pk_bf16(acc[0], acc[1]); pk.y = cvt_pk_bf16(acc[2], acc[3]);
                *(u32x2*)(dst + (pi * 16 + (lane & 15)) * 128 + ni * 16 + 4 * (lane >> 4)) = pk;
            }
        if (tid < 4) ((float*)(F.ws + WS_R4 + R4_SSD))[(size_t)(b * 8 + 4 * g + tid) * 64 + c] = fexp(acum[tid * 64 + 63]);
    }
    LDS_BARRIER();
}
__device__ __forceinline__ void ssd_scan(const Frame& F, int e) {
    const int bh = e >> 13, r = e & 8191;
    bf16_t* st = (bf16_t*)(F.ws + WS_R4 + R4_SSS) + (size_t)bh * 64 * 8192 + r; const float* dec = (const float*)(F.ws + WS_R4 + R4_SSD) + bh * 64;
    float h = 0.f;
    for (int c0 = 0; c0 < 64; c0 += 16) {
        float tmp[16], dd[16];
#pragma unroll
        for (int i = 0; i < 16; ++i) { tmp[i] = bf2f(st[(size_t)(c0 + i) * 8192]); dd[i] = dec[c0 + i]; }
#pragma unroll
        for (int i = 0; i < 16; ++i) { st[(size_t)(c0 + i) * 8192] = f2bf(h); h = h * dd[i] + tmp[i]; }
    }
}
__device__ __forceinline__ void ssd_out(const Frame& F, int l, int u, int tid) {
    const int g = u & 1, c = (u >> 1) & 63, b = u >> 7; const size_t t0 = (size_t)b * SEQ + c * 64;
    const int lane = tid & 63, w = __builtin_amdgcn_readfirstlane(tid >> 6);
    float* acum = (float*)F.lds;
    bf16_t* Cm = (bf16_t*)(F.lds + 2048);
    bf16_t* Bm = (bf16_t*)(F.lds + 19456);
    bf16_t* XT = (bf16_t*)(F.lds + 36864);
    bf16_t* PV = (bf16_t*)(F.lds + 46080);
    bf16_t* Mh = (bf16_t*)(F.lds + 63488);
    bf16_t* XS = (bf16_t*)(F.lds + 72704);
    ssd_acum(F, l, t0, g, acum, tid);
    const int row8 = tid >> 3, seg8 = tid & 7;
    {
        const bf16_t* qrow = (const bf16_t*)(F.Q + (t0 + row8) * QS);
#pragma unroll
        for (int hf = 0; hf < 2; ++hf) {
            *(u32x4*)(Bm + row8 * 136 + (seg8 + 8 * hf) * 8) = *(const u32x4*)(qrow + 512 + g * 128 + (seg8 + 8 * hf) * 8);
            *(u32x4*)(Cm + row8 * 136 + (seg8 + 8 * hf) * 8) = *(const u32x4*)(qrow + 768 + g * 128 + (seg8 + 8 * hf) * 8);
        }
#pragma unroll
        for (int it = 0; it < 4; ++it) *(u32x4*)(XS + row8 * 264 + (seg8 + 8 * it) * 8) = *(const u32x4*)(qrow + g * 256 + (seg8 + 8 * it) * 8);
    }
    u32x4 pv[2];
    { const bf16_t* src = (const bf16_t*)(F.ws + WS_R4 + R4_SSS) + ((size_t)(b * 8 + 4 * g) * 64 + c) * 8192 + row8 * 128;
      pv[0] = *(const u32x4*)(src + seg8 * 8); pv[1] = *(const u32x4*)(src + (seg8 + 8) * 8); }
    LDS_BARRIER();
    const int ti = w >> 1, sj0 = 2 * (w & 1);
    f32x4 cb[2];
#pragma unroll
    for (int q = 0; q < 2; ++q) cb[q] = mma16<128>(Cm + ti * 16 * 136, 136, Bm + (sj0 + q) * 16 * 136, 136, lane, (f32x4){0.f, 0.f, 0.f, 0.f});
    for (int hh = 0; hh < 4; ++hh) {
        const int head = 4 * g + hh;
#pragma unroll
        for (int q = 0; q < 2; ++q)
#pragma unroll
            for (int j = 0; j < 4; ++j) {
                const int lrow = ti * 16 + 4 * (lane >> 4) + j, sidx = (sj0 + q) * 16 + (lane & 15);
                const float v = (sidx <= lrow) ? cb[q][j] * fexp(acum[hh * 64 + lrow] - acum[hh * 64 + sidx]) : 0.f;
                Mh[lrow * 72 + sidx] = f2bf(v);
            }
        {
            const int p = tid & 63, sq = tid >> 6;
            float v[8];
#pragma unroll
            for (int i = 0; i < 8; ++i) { const int sidx = sq * 8 + i; v[i] = bf2f(XS[sidx * 264 + hh * 64 + p]) * acum[256 + hh * 64 + sidx]; }
            *(u32x4*)(XT + p * 72 + sq * 8) = pack8(v);
        }
        *(u32x4*)(PV + row8 * 136 + seg8 * 8) = pv[0]; *(u32x4*)(PV + row8 * 136 + (seg8 + 8) * 8) = pv[1];
        if (hh < 3) { const bf16_t* src = (const bf16_t*)(F.ws + WS_R4 + R4_SSS) + ((size_t)(b * 8 + head + 1) * 64 + c) * 8192 + row8 * 128;
            pv[0] = *(const u32x4*)(src + seg8 * 8); pv[1] = *(const u32x4*)(src + (seg8 + 8) * 8); }
        LDS_BARRIER();
        const float Dk = F.in[I_SD][l * 8 + head];
#pragma unroll
        for (int q = 0; q < 2; ++q) {
            const int pj = sj0 + q;
            const f32x4 a1 = mma16<64>(Mh + ti * 16 * 72, 72, XT + pj * 16 * 72, 72, lane, (f32x4){0.f, 0.f, 0.f, 0.f});
            const f32x4 a2 = mma16<128>(Cm + ti * 16 * 136, 136, PV + pj * 16 * 136, 136, lane, (f32x4){0.f, 0.f, 0.f, 0.f});
#pragma unroll
            for (int j = 0; j < 4; ++j) {
                const int lrow = ti * 16 + 4 * (lane >> 4) + j, p = pj * 16 + (lane & 15);
                const float xs = bf2f(XS[lrow * 264 + hh * 64 + p]);
                F.O[(t0 + lrow) * D + 512 + head * 64 + p] = a1[j] + fexp(acum[hh * 64 + lrow]) * a2[j] + Dk * xs;
            }
        }
        LDS_BARRIER();
    }
}


struct HgIn { float fr[16], q[16], v[16]; u32x4 sp[4]; };
__device__ __forceinline__ void hg_load(const Frame& F, int u, int tid, HgIn& x, bool out_phase) {
    const int h = u & 3, c = (u >> 2) & 63, b = u >> 8; const size_t t0 = (size_t)b * SEQ + c * 64;
    const int k = tid & 127, tq = tid >> 7;
#pragma unroll
    for (int i = 0; i < 16; ++i) { const BfPtr p = F.P + (t0 + tq * 16 + i) * PS + h * 128 + k; x.fr[i] = p[C_HG_F]; x.v[i] = p[C_HG_I]; if (out_phase) x.q[i] = p[C_HG_Q]; }
    if (out_phase) {
        const bf16_t* src = (const bf16_t*)(F.ws + WS_R4 + R4_HGS) + ((size_t)(b * 4 + h) * 64 + c) * 16384 + (tid >> 2) * 128;
#pragma unroll
        for (int i8 = 0; i8 < 4; ++i8) x.sp[i8] = *(const u32x4*)(src + (i8 * 4 + (tid & 3)) * 8);
    }
}
__device__ __forceinline__ void hg_cumlog(const Frame& F, int l, int h, float* gt, float (&freg)[16], float (&bown)[16], int tid, const HgIn& x) {
    const int k = tid & 127, tq = tid >> 7;
    float lb = 0.f;
    if (l > 0) { const float p0 = F.in[I_HGLB][h * 128 + k], p1 = F.in[I_HGLB][GW + h * 128 + k]; const float m = fmaxf(p0, p1); const float e0 = fexp(p0 - m), e1 = fexp(p1 - m); lb = e1 * frcp(e0 + e1); }
    float run = 0.f;
#pragma unroll
    for (int i = 0; i < 16; ++i) { const float f = lb + (1.0f - lb) * sigmoid_f(x.fr[i]); freg[i] = f; run += flog(f); bown[i] = run; }
    gt[tq * 128 + k] = run;
    LDS_BARRIER();
    float off = 0.f;
#pragma unroll
    for (int g2 = 0; g2 < 3; ++g2) off += (g2 < tq) ? gt[g2 * 128 + k] : 0.f;
#pragma unroll
    for (int i = 0; i < 16; ++i) bown[i] += off;
}
__device__ __forceinline__ void hg_local(const Frame& F, int l, int u, int tid, const HgIn& x) {
    const int h = u & 3, c = (u >> 2) & 63, b = u >> 8;
    const int lane = tid & 63, w = __builtin_amdgcn_readfirstlane(tid >> 6);
    float* gt = (float*)F.lds;
    bf16_t* kdT = (bf16_t*)(F.lds + 32768);
    bf16_t* vT = (bf16_t*)(F.lds + 51200);
    float freg[16], bown[16];
    hg_cumlog(F, l, h, gt, freg, bown, tid, x);
    {
        const int k = tid & 127, tq = tid >> 7;
        const float bend = gt[k] + gt[128 + k] + gt[256 + k] + gt[384 + k];
        float kd[16];
#pragma unroll
        for (int i = 0; i < 16; ++i) kd[i] = (1.0f - freg[i]) * fexp(bend - bown[i]);
        u32x4 p0, p1;
        p0.x = cvt_pk_bf16(kd[0], kd[1]); p0.y = cvt_pk_bf16(kd[2], kd[3]); p0.z = cvt_pk_bf16(kd[4], kd[5]); p0.w = cvt_pk_bf16(kd[6], kd[7]);
        p1.x = cvt_pk_bf16(kd[8], kd[9]); p1.y = cvt_pk_bf16(kd[10], kd[11]); p1.z = cvt_pk_bf16(kd[12], kd[13]); p1.w = cvt_pk_bf16(kd[14], kd[15]);
        *(u32x4*)(kdT + k * 72 + tq * 16) = p0; *(u32x4*)(kdT + k * 72 + tq * 16 + 8) = p1;
        p0.x = cvt_pk_bf16(x.v[0], x.v[1]); p0.y = cvt_pk_bf16(x.v[2], x.v[3]); p0.z = cvt_pk_bf16(x.v[4], x.v[5]); p0.w = cvt_pk_bf16(x.v[6], x.v[7]);
        p1.x = cvt_pk_bf16(x.v[8], x.v[9]); p1.y = cvt_pk_bf16(x.v[10], x.v[11]); p1.z = cvt_pk_bf16(x.v[12], x.v[13]); p1.w = cvt_pk_bf16(x.v[14], x.v[15]);
        *(u32x4*)(vT + k * 72 + tq * 16) = p0; *(u32x4*)(vT + k * 72 + tq * 16 + 8) = p1;
        if (tq == 0) ((float*)(F.ws + WS_R4 + R4_HGD))[((size_t)(b * 4 + h) * 64 + c) * 128 + k] = fexp(bend);
    }
    LDS_BARRIER();
    {
        bf16_t* dst = (bf16_t*)(F.ws + WS_R4 + R4_HGS) + ((size_t)(b * 4 + h) * 64 + c) * 16384;
#pragma unroll
        for (int ki = 0; ki < 8; ++ki) {
            const f32x4 acc = mma16<64>(kdT + ki * 16 * 72, 72, vT + w * 16 * 72, 72, lane, (f32x4){0.f, 0.f, 0.f, 0.f});
            u32x2 pk; pk.x = cvt_pk_bf16(acc[0], acc[1]); pk.y = cvt_pk_bf16(acc[2], acc[3]);
            *(u32x2*)(dst + (w * 16 + (lane & 15)) * 128 + ki * 16 + 4 * (lane >> 4)) = pk;
        }
    }
    LDS_BARRIER();
}
__device__ __forceinline__ void hg_scan(const Frame& F, int e) {
    const int bh = e >> 14, r = e & 16383, k = r & 127;
    bf16_t* st = (bf16_t*)(F.ws + WS_R4 + R4_HGS) + (size_t)bh * 64 * 16384 + r; const float* dec = (const float*)(F.ws + WS_R4 + R4_HGD) + (size_t)bh * 64 * 128 + k;
    float h = 0.f;
    for (int c0 = 0; c0 < 64; c0 += 16) {
        float tmp[16], dd[16];
#pragma unroll
        for (int i = 0; i < 16; ++i) { tmp[i] = bf2f(st[(size_t)(c0 + i) * 16384]); dd[i] = dec[(c0 + i) * 128]; }
#pragma unroll
        for (int i = 0; i < 16; ++i) { st[(size_t)(c0 + i) * 16384] = f2bf(h); h = h * dd[i] + tmp[i]; }
    }
}
__device__ __forceinline__ void hg_out(const Frame& F, int l, int u, int tid, const HgIn& x) {
    const int h = u & 3, c = (u >> 2) & 63, b = u >> 8; const size_t t0 = (size_t)b * SEQ + c * 64;
    const int lane = tid & 63, w = __builtin_amdgcn_readfirstlane(tid >> 6);
    float* gt = (float*)F.lds;
    bf16_t* Sc = (bf16_t*)F.lds;
    bf16_t* qh = (bf16_t*)(F.lds + 32768);
    bf16_t* kh = (bf16_t*)(F.lds + 50176);
    bf16_t* vT = (bf16_t*)(F.lds + 67584);
    bf16_t* Sp = (bf16_t*)(F.lds + 86016);
    float freg[16], bown[16];
    hg_cumlog(F, l, h, gt, freg, bown, tid, x);
    {
        const int k = tid & 127, tq = tid >> 7;
        const float m = gt[k] + gt[128 + k];
#pragma unroll
        for (int i = 0; i < 16; ++i) {
            const int t = tq * 16 + i; const float bb = bown[i];
            qh[t * 136 + k] = f2bf(silu_f(x.q[i]) * fexp(bb - m)); kh[t * 136 + k] = f2bf((1.0f - freg[i]) * fexp(m - bb));
        }
        u32x4 p0, p1;
        p0.x = cvt_pk_bf16(x.v[0], x.v[1]); p0.y = cvt_pk_bf16(x.v[2], x.v[3]); p0.z = cvt_pk_bf16(x.v[4], x.v[5]); p0.w = cvt_pk_bf16(x.v[6], x.v[7]);
        p1.x = cvt_pk_bf16(x.v[8], x.v[9]); p1.y = cvt_pk_bf16(x.v[10], x.v[11]); p1.z = cvt_pk_bf16(x.v[12], x.v[13]); p1.w = cvt_pk_bf16(x.v[14], x.v[15]);
        *(u32x4*)(vT + k * 72 + tq * 16) = p0; *(u32x4*)(vT + k * 72 + tq * 16 + 8) = p1;
        const int v = tid >> 2;
#pragma unroll
        for (int i8 = 0; i8 < 4; ++i8) {
            const u32x4 raw = x.sp[i8]; const int kq = (i8 * 4 + (tid & 3)) * 8 - i8 * 8;
            float mm[8];
#pragma unroll
            for (int e = 0; e < 8; ++e) mm[e] = gt[kq + i8 * 8 + e] + gt[128 + kq + i8 * 8 + e];
            u32x4 pk; pk.x = cvt_pk_bf16(__uint_as_float(raw.x << 16) * fexp(mm[0]), __uint_as_float(raw.x & 0xffff0000u) * fexp(mm[1])); pk.y = cvt_pk_bf16(__uint_as_float(raw.y << 16) * fexp(mm[2]), __uint_as_float(raw.y & 0xffff0000u) * fexp(mm[3]));
            pk.z = cvt_pk_bf16(__uint_as_float(raw.z << 16) * fexp(mm[4]), __uint_as_float(raw.z & 0xffff0000u) * fexp(mm[5])); pk.w = cvt_pk_bf16(__uint_as_float(raw.w << 16) * fexp(mm[6]), __uint_as_float(raw.w & 0xffff0000u) * fexp(mm[7]));
            *(u32x4*)(Sp + v * 136 + kq + i8 * 8) = pk;
        }
    }
    LDS_BARRIER();
    const int ti = w >> 1;
    {
        f32x4 sc[2];
#pragma unroll
        for (int q = 0; q < 2; ++q) sc[q] = mma16<128>(qh + ti * 16 * 136, 136, kh + (2 * (w & 1) + q) * 16 * 136, 136, lane, (f32x4){0.f, 0.f, 0.f, 0.f});
#pragma unroll
        for (int q = 0; q < 2; ++q)
#pragma unroll
            for (int j = 0; j < 4; ++j) {
                const int t = ti * 16 + 4 * (lane >> 4) + j, sidx = (2 * (w & 1) + q) * 16 + (lane & 15);
                Sc[t * 72 + sidx] = f2bf(sidx <= t ? sc[q][j] : 0.f);
            }
    }
    LDS_BARRIER();
#pragma unroll
    for (int q = 0; q < 4; ++q) {
        const int vj = (w & 1) * 4 + q;
        f32x4 acc = mma16<64>(Sc + ti * 16 * 72, 72, vT + vj * 16 * 72, 72, lane, (f32x4){0.f, 0.f, 0.f, 0.f});
        acc = mma16<128>(qh + ti * 16 * 136, 136, Sp + vj * 16 * 136, 136, lane, acc);
#pragma unroll
        for (int j = 0; j < 4; ++j) F.O[(t0 + ti * 16 + 4 * (lane >> 4) + j) * D + h * 128 + vj * 16 + (lane & 15)] = acc[j];
    }
    LDS_BARRIER();
}


__device__ __forceinline__ u32x2 pack4(const f32x4 v) { u32x2 p; p.x = cvt_pk_bf16(v[0], v[1]); p.y = cvt_pk_bf16(v[2], v[3]); return p; }
__device__ __forceinline__ f32x4 unpack4(const u32x2 p) { f32x4 v; v[0] = __uint_as_float(p.x << 16); v[1] = __uint_as_float(p.x & 0xffff0000u); v[2] = __uint_as_float(p.y << 16); v[3] = __uint_as_float(p.y & 0xffff0000u); return v; }
__device__ __forceinline__ u32x4 pack8(const float (&v)[8]) { u32x4 p; p.x = cvt_pk_bf16(v[0], v[1]); p.y = cvt_pk_bf16(v[2], v[3]); p.z = cvt_pk_bf16(v[4], v[5]); p.w = cvt_pk_bf16(v[6], v[7]); return p; }

struct RwRaw { float w[8], kka[8], k[8]; bf16_t pr[9], pk[9], pv[9]; };
struct RwIn { float w[8], kk[8], r[8], kka[8], k[8], v[8]; };
__device__ __forceinline__ void rw_load(const Frame& F, int b, int c, int h, int tid, RwRaw& x) {
    const size_t t0 = (size_t)b * SEQ + c * 64; const int k = tid & 63, ig = tid >> 6;
#pragma unroll
    for (int ii = 0; ii < 8; ++ii) { const float* q = F.Q + (t0 + ig * 8 + ii) * QS + h * 64 + k; x.w[ii] = q[Q_W]; x.kka[ii] = q[Q_KKA]; x.k[ii] = q[Q_K]; }
    const bool first = (ig == 0) && (c == 0);
#pragma unroll
    for (int j = 0; j < 9; ++j) { const bf16_t* p = F.P.p + (long)((long)t0 + ig * 8 - 1 + j) * PS + C_RW + h * 64 + k;
        const bool z = first && (j == 0); x.pr[j] = z ? (bf16_t)0 : p[0]; x.pk[j] = z ? (bf16_t)0 : p[512]; x.pv[j] = z ? (bf16_t)0 : p[1024]; }
}
__device__ __forceinline__ void rw_finish(const Frame& F, int l, int h, int tid, const RwRaw& a, RwIn& x) {
    const int k = tid & 63; const float* mu = F.in[I_WMU] + (size_t)l * RW_COLS + h * 64 + k;
    const float mr = mu[0], mkk = mu[512], mv = mu[1024], kkc = F.in[I_WKK][l * GW + h * 64 + k];
#pragma unroll
    for (int ii = 0; ii < 8; ++ii) {
        const float rc = bf2f(a.pr[ii + 1]), rp = bf2f(a.pr[ii]), kc = bf2f(a.pk[ii + 1]), kp = bf2f(a.pk[ii]), vc = bf2f(a.pv[ii + 1]), vp = bf2f(a.pv[ii]);
        x.r[ii] = rc + (rp - rc) * mr; x.v[ii] = vc + (vp - vc) * mv;
        const float kx = (kc + (kp - kc) * mkk) * kkc; const float ss = wave_sum(kx * kx);
        x.kk[ii] = kx * frcp(fmaxf(__builtin_amdgcn_sqrtf(ss), 1e-12f));
        x.w[ii] = a.w[ii]; x.kka[ii] = a.kka[ii]; x.k[ii] = a.k[ii];
    }
}
__device__ __forceinline__ void rw_prep(const Frame& F, int l, int b, int c, int h, int tid, const RwIn& x) {
    const int ru = (b * 64 + c) * 8 + h;
    unsigned char* rec = F.ws + WS_U + (size_t)ru * RW_REC;
    float* aabT = (float*)(F.ws + WS_RWAAB) + (size_t)ru * 4096;
    const int lane = tid & 63, w = __builtin_amdgcn_readfirstlane(tid >> 6);
    float* cumL = (float*)F.lds;
    bf16_t* Ar = (bf16_t*)(F.lds + 16640);
    bf16_t* Rr = Ar + 64 * 72; bf16_t* Br = Rr + 64 * 72; bf16_t* Kr = Br + 64 * 72; bf16_t* KrT = Kr + 64 * 72; bf16_t* vT = KrT + 64 * 72; bf16_t* AakT = vT + 64 * 72; bf16_t* ArkT = AakT + 64 * 72;
    const int k = tid & 63, ig = tid >> 6;
    {
        const float rkc = F.in[I_WRK][l * GW + h * 64 + k]; float* bon = (float*)(F.ws + WS_BON) + ((size_t)b * SEQ + c * 64 + ig * 8) * 8 + h;
#pragma unroll
        for (int ii = 0; ii < 8; ++ii) { const float sv = wave_sum(x.r[ii] * x.k[ii] * rkc); if (k == 0) bon[ii * 8] = sv; }
    }
    float pre[8];
    { float run = 0.f;
#pragma unroll
      for (int ii = 0; ii < 8; ++ii) { run += flog(x.w[ii]); pre[ii] = run; }
      cumL[ig * 64 + k] = run; }
    LDS_BARRIER();
    float off = 0.f, tot = 0.f;
#pragma unroll
    for (int g2 = 0; g2 < 8; ++g2) { const float gv = cumL[g2 * 64 + k]; off += (g2 < ig) ? gv : 0.f; tot += gv; }
    {
        float brv[8], krv[8], vvv[8];
#pragma unroll
        for (int ii = 0; ii < 8; ++ii) {
            const int i = ig * 8 + ii;
            const float cu = off + pre[ii]; const float cux = (ii > 0) ? off + pre[ii - 1] : off;
            const float e_in = fexp(cu), e_ex = fexp(cux), e_neg = fexp(-cu);
            const float ar = -x.kk[ii] * e_ex, rr = x.r[ii] * e_in; brv[ii] = x.kka[ii] * e_neg; krv[ii] = x.k[ii] * e_neg; vvv[ii] = x.v[ii];
            const bf16_t arb = f2bf(ar), rrb = f2bf(rr);
            Ar[i * 72 + k] = arb; Rr[i * 72 + k] = rrb; Br[i * 72 + k] = f2bf(brv[ii]); Kr[i * 72 + k] = f2bf(krv[ii]);
            ((bf16_t*)(rec + RO_AR))[i * 64 + k] = arb; ((bf16_t*)(rec + RO_RR))[i * 64 + k] = rrb;
        }
        *(u32x4*)(KrT + k * 72 + ig * 8) = pack8(krv); *(u32x4*)(vT + k * 72 + ig * 8) = pack8(vvv);
        *(u32x4*)((bf16_t*)(rec + RO_BRT) + k * 64 + ig * 8) = pack8(brv);
        if (ig == 0) ((float*)(F.ws + WS_RWGC))[ru * 64 + k] = fexp(tot);
    }
    LDS_BARRIER();
    const int ri = w >> 1, cj0 = 2 * (w & 1);
    const f32x4 z4 = (f32x4){0.f, 0.f, 0.f, 0.f};
#pragma unroll
    for (int q = 0; q < 2; ++q) {
        const int cj = cj0 + q;
        f32x4 aab = mma16<64>(Br + ri * 16 * 72, 72, Ar + cj * 16 * 72, 72, lane, z4);
        f32x4 aak = mma16<64>(Kr + ri * 16 * 72, 72, Ar + cj * 16 * 72, 72, lane, z4);
        f32x4 arb = mma16<64>(Br + ri * 16 * 72, 72, Rr + cj * 16 * 72, 72, lane, z4);
        f32x4 ark = mma16<64>(Kr + ri * 16 * 72, 72, Rr + cj * 16 * 72, 72, lane, z4);
        const int i0 = ri * 16 + 4 * (lane >> 4), t = cj * 16 + (lane & 15);
#pragma unroll
        for (int j = 0; j < 4; ++j) { const bool st = (i0 + j) < t, inc = (i0 + j) <= t; aab[j] = st ? aab[j] : 0.f; aak[j] = st ? aak[j] : 0.f; arb[j] = inc ? arb[j] : 0.f; ark[j] = inc ? ark[j] : 0.f; }
        *(f32x4*)(aabT + t * 64 + i0) = aab;
        *(u32x2*)(AakT + t * 72 + i0) = pack4(aak);
        *(u32x2*)((bf16_t*)(rec + RO_ARBT) + t * 64 + i0) = pack4(arb);
        *(u32x2*)(ArkT + t * 72 + i0) = pack4(ark);
    }
    LDS_BARRIER();
#pragma unroll
    for (int q = 0; q < 2; ++q) {
        const int cj = cj0 + q, tile = ri * 4 + cj;
        const f32x4 xl = mma16<64>(AakT + ri * 16 * 72, 72, vT + cj * 16 * 72, 72, lane, z4);
        const f32x4 lt = mma16<64>(KrT + ri * 16 * 72, 72, vT + cj * 16 * 72, 72, lane, z4);
        const f32x4 yl = mma16<64>(ArkT + ri * 16 * 72, 72, vT + cj * 16 * 72, 72, lane, z4);
        *(u32x2*)(rec + RO_XL + tile * 512 + lane * 8) = pack4(xl);
        *(u32x2*)(rec + RO_LT + tile * 512 + lane * 8) = pack4(lt);
        *(u32x2*)(rec + RO_YL + tile * 512 + lane * 8) = pack4(yl);
    }
    LDS_BARRIER();
}

template <int t> __device__ __forceinline__ void tsolve_step(float (&T)[64], const LAS float* A, int lane) {
    if constexpr (t < 64) {
        float acc = (lane == t) ? 1.0f : 0.0f;
        const LAS float* row = A + t * 64;
        if constexpr (t > 0) asm("" : "+v"(row) : "v"(T[t - 1]));
        const LAS f32x4* row4 = (const LAS f32x4*)row;
#pragma unroll
        for (int i4 = 0; i4 < t / 4; ++i4) { const f32x4 v = row4[i4]; acc += T[4 * i4] * v[0]; acc += T[4 * i4 + 1] * v[1]; acc += T[4 * i4 + 2] * v[2]; acc += T[4 * i4 + 3] * v[3]; }
#pragma unroll
        for (int i = (t / 4) * 4; i < t; ++i) acc += T[i] * row[i];
        T[t] = acc;
        tsolve_step<t + 1>(T, A, lane);
    }
}
__device__ __forceinline__ void rw_tsolve(const Frame& F, int ru, int w, int lane) {
    LAS float* A = (LAS float*)((LAS unsigned char*)F.lds + w * 16384);
    const float* src = (const float*)(F.ws + WS_RWAAB) + (size_t)ru * 4096;
#pragma unroll
    for (int q = 0; q < 16; ++q) *(LAS f32x4*)(A + (q * 64 + lane) * 4) = *(const f32x4*)(src + (q * 64 + lane) * 4);
    float T[64];
    tsolve_step<0>(T, A, lane);
    bf16_t* Tl = (bf16_t*)(F.lds + w * 16384);
#pragma unroll
    for (int i8 = 0; i8 < 8; ++i8) { float v[8];
#pragma unroll
        for (int e = 0; e < 8; ++e) v[e] = T[i8 * 8 + e];
        *(u32x4*)(Tl + lane * 72 + i8 * 8) = pack8(v); }
    unsigned char* rec = F.ws + WS_U + (size_t)ru * RW_REC;
#pragma unroll 1
    for (int which = 0; which < 2; ++which) {
        bf16_t* M = (bf16_t*)(rec + (which ? RO_BRT : RO_ARBT));
#pragma unroll 1
        for (int tt = 0; tt < 4; ++tt) {
            bf16x8 bfr[2];
#pragma unroll
            for (int s2 = 0; s2 < 2; ++s2) bfr[s2] = *(const bf16x8*)(M + (tt * 16 + (lane & 15)) * 64 + (lane >> 4) * 8 + s2 * 32);
            f32x4 acc[4];
#pragma unroll
            for (int jt = 0; jt < 4; ++jt) {
                acc[jt] = (f32x4){0.f, 0.f, 0.f, 0.f};
#pragma unroll
                for (int s2 = 0; s2 < 2; ++s2) { const bf16x8 a = *(const bf16x8*)(Tl + (jt * 16 + (lane & 15)) * 72 + (lane >> 4) * 8 + s2 * 32); acc[jt] = __builtin_amdgcn_mfma_f32_16x16x32_bf16(a, bfr[s2], acc[jt], 0, 0, 0); }
            }
#pragma unroll
            for (int jt = 0; jt < 4; ++jt) *(u32x2*)(M + (tt * 16 + (lane & 15)) * 64 + jt * 16 + 4 * (lane >> 4)) = pack4(acc[jt]);
        }
    }
}

__device__ __forceinline__ f32x4 mma16r(const bf16x8 (&a)[2], const bf16_t* Bt, int ldb, int lane, f32x4 acc) {
    const bf16_t* bp = Bt + (lane & 15) * ldb + (lane >> 4) * 8;
#pragma unroll
    for (int s2 = 0; s2 < 2; ++s2) { const bf16x8 b = *(const bf16x8*)(bp + s2 * 32); acc = __builtin_amdgcn_mfma_f32_16x16x32_bf16(a[s2], b, acc, 0, 0, 0); }
    return acc;
}
struct RwStage { u32x4 a[4]; u32x2 dXl, dLt, dYl; f32x4 gc; };
__device__ __forceinline__ void rw_stage_load(const Frame& F, int b, int h, int cc, int tid, int tile, int lane, int r4, RwStage& S) {
    const int ru = (b * 64 + cc) * 8 + h; const unsigned char* rec = F.ws + WS_U + (size_t)ru * RW_REC;
#pragma unroll
    for (int m = 0; m < 4; ++m) S.a[m] = *(const u32x4*)(rec + m * 8192 + tid * 16);
    S.dXl = *(const u32x2*)(rec + RO_XL + tile * 512 + lane * 8); S.dLt = *(const u32x2*)(rec + RO_LT + tile * 512 + lane * 8); S.dYl = *(const u32x2*)(rec + RO_YL + tile * 512 + lane * 8);
    S.gc = *(const f32x4*)((const float*)(F.ws + WS_RWGC) + ru * 64 + r4);
}
static_assert(RO_AR == 0 && RO_RR == 8192 && RO_BRT == 16384 && RO_ARBT == 24576 && RO_TT == 32768, "record layout");
__device__ __forceinline__ void rw_stage_park(const RwStage& S, bf16_t* img, int tid) {
#pragma unroll
    for (int m = 0; m < 4; ++m) *(u32x4*)(img + m * 4608 + (tid >> 3) * 72 + (tid & 7) * 8) = S.a[m];
}
__device__ __forceinline__ f32x4 mma16l(const bf16_t* A, const bf16_t* Bt, int lane, f32x4 acc) { return mma16<64>(A, 72, Bt, 72, lane, acc); }
__device__ __forceinline__ void rw_seq(const Frame& F, int job, int tid) {
    const int bh = job >> 1, vh = job & 1, b = bh >> 3, h = bh & 7;
    const int lane = tid & 63, w = __builtin_amdgcn_readfirstlane(tid >> 6), ri = w >> 1, cjl = (w & 1), cj = 2 * vh + cjl;
    bf16_t* S0 = (bf16_t*)F.lds; bf16_t* Xb = S0 + 32 * 72; bf16_t* Ub = Xb + 32 * 72;
    bf16_t* IMG = (bf16_t*)(F.lds + 16384);
    for (int i = tid; i < 32 * 72 / 2; i += 512) ((unsigned*)S0)[i] = 0u;
    f32x4 st = (f32x4){0.f, 0.f, 0.f, 0.f};
    const int vcol = lane & 15, r4 = ri * 16 + 4 * (lane >> 4), tile = ri * 4 + cj;
    RwStage s0, s1, s2;
    rw_stage_load(F, b, h, 0, tid, tile, lane, r4, s0); rw_stage_load(F, b, h, 1, tid, tile, lane, r4, s1); rw_stage_load(F, b, h, 2, tid, tile, lane, r4, s2);
    rw_stage_park(s0, IMG, tid);
    __syncthreads();
    const size_t tb = (size_t)b * SEQ;
#define RW_STEP(cc, S, SN) do { const bf16_t* im = IMG + ((cc) & 1) * 23040 + ri * 16 * 72; \
        const f32x4 xl = unpack4(S.dXl), lt = unpack4(S.dLt); f32x4 y = unpack4(S.dYl); const f32x4 gcc = S.gc; \
        { const f32x4 x = mma16l(im + 0 * 4608, S0 + cjl * 16 * 72, lane, xl); y = mma16l(im + 1 * 4608, S0 + cjl * 16 * 72, lane, y); \
          *(u32x2*)(Xb + (cjl * 16 + vcol) * 72 + r4) = pack4(x); } \
        LDS_BARRIER(); \
        { y = mma16l(im + 3 * 4608, Xb + cjl * 16 * 72, lane, y);                   \
          _Pragma("unroll") for (int j = 0; j < 4; ++j) F.O[(tb + (size_t)(cc) * 64 + r4 + j) * D + 1536 + h * 64 + cj * 16 + vcol] = y[j]; \
          st = mma16l(im + 2 * 4608, Xb + cjl * 16 * 72, lane, st);                 \
          _Pragma("unroll") for (int j = 0; j < 4; ++j) st[j] = (st[j] + lt[j]) * gcc[j]; \
          *(u32x2*)(S0 + (cjl * 16 + vcol) * 72 + r4) = pack4(st); } \
        if ((cc) + 1 < 64) rw_stage_park(SN, IMG + (((cc) + 1) & 1) * 23040, tid); \
        LDS_BARRIER(); \
        if ((cc) + 3 < 64) rw_stage_load(F, b, h, (cc) + 3, tid, tile, lane, r4, S); } while (0)
#pragma unroll 1
    for (int c = 0; c < 64; c += 3) {
        RW_STEP(c, s0, s1);
        if (c + 1 < 64) RW_STEP(c + 1, s1, s2);
        if (c + 2 < 64) RW_STEP(c + 2, s2, s0);
    }
#undef RW_STEP
}

constexpr int NU_HG = 1024, NU_SSD = 512, NU_RG = 256;
__device__ __forceinline__ void hg_scan4(const Frame& F, int e4) {
    const int bh = e4 >> 12, r = (e4 & 4095) * 4, k = r & 127;
    bf16_t* st = (bf16_t*)(F.ws + WS_R4 + R4_HGS) + (size_t)bh * 64 * 16384 + r; const float* dec = (const float*)(F.ws + WS_R4 + R4_HGD) + (size_t)bh * 64 * 128 + k;
    f32x4 h = (f32x4){0.f, 0.f, 0.f, 0.f};
#pragma unroll 1
    for (int c0 = 0; c0 < 64; c0 += 16) {
        u32x2 tmp[16]; f32x4 dd[16];
#pragma unroll
        for (int i = 0; i < 16; ++i) { tmp[i] = *(const u32x2*)(st + (size_t)(c0 + i) * 16384); dd[i] = *(const f32x4*)(dec + (c0 + i) * 128); }
#pragma unroll
        for (int i = 0; i < 16; ++i) { *(u32x2*)(st + (size_t)(c0 + i) * 16384) = pack4(h); h = h * dd[i] + unpack4(tmp[i]); }
    }
}
__device__ __forceinline__ void ssd_scan8(const Frame& F, int e8) {
    const int bh = e8 >> 10, r = (e8 & 1023) * 8;
    bf16_t* st = (bf16_t*)(F.ws + WS_R4 + R4_SSS) + (size_t)bh * 64 * 8192 + r; const float* dec = (const float*)(F.ws + WS_R4 + R4_SSD) + bh * 64;
    float h[8];
#pragma unroll
    for (int j = 0; j < 8; ++j) h[j] = 0.f;
#pragma unroll 1
    for (int c0 = 0; c0 < 64; c0 += 16) {
        u32x4 tmp[16]; float dd[16];
#pragma unroll
        for (int i = 0; i < 16; ++i) { tmp[i] = *(const u32x4*)(st + (size_t)(c0 + i) * 8192); dd[i] = dec[c0 + i]; }
#pragma unroll
        for (int i = 0; i < 16; ++i) {
            *(u32x4*)(st + (size_t)(c0 + i) * 8192) = pack8(h);
#pragma unroll
            for (int j = 0; j < 8; ++j) h[j] = h[j] * dd[i] + bfel(tmp[i], j);
        }
    }
}
__device__ __forceinline__ void rg_scan2(const Frame& F, int e) {
    const int b = e >> 9, j = e & 511;
    float* rgc = (float*)(F.ws + WS_R4 + R4_RGC);
    float h = 0.f;
#pragma unroll 1
    for (int c0 = 0; c0 < 64; c0 += 32) {
        float2 pe[32];
#pragma unroll
        for (int i = 0; i < 32; ++i) pe[i] = *(const float2*)(rgc + ((size_t)(b * 64 + c0 + i) * 512 + j) * 2);
#pragma unroll
        for (int i = 0; i < 32; ++i) { rgc[((size_t)(b * 64 + c0 + i) * 512 + j) * 2 + 1] = h; h = pe[i].x * h + pe[i].y; }
    }
}
__device__ __forceinline__ void phase_m2(const Frame& F, int l) {
    const int tid = opaque_tid();
#ifndef SKIP_RWSEQ
    if (F.bid < 64) { rw_seq(F, F.bid, tid); return; }
#endif
    const int gt = (F.bid - 64) * 512 + tid, nthr = (F.G - 64) * 512;
    constexpr int N_HG = 16 * 4096, N_SS = 32 * 1024, N_RG = 2048;
    for (int it = gt; it < N_RG + N_HG + N_SS; it += nthr) {
        if (it < N_RG) rg_scan2(F, it); else if (it < N_RG + N_HG) hg_scan4(F, it - N_RG); else ssd_scan8(F, it - N_RG - N_HG);
    }
    __syncthreads();
    for (int i = F.bid - 64; i < DEFER_TILES / 2; i += F.G - 64) conv_down_tile(F, 64 * 16 * 8 - DEFER_TILES + l * (DEFER_TILES / 2) + i, tid);
}


__device__ __forceinline__ void phase_front(const Frame& F, int l) {
    for (int ch = F.bid; ch < NTOK / 64; ch += F.G) {
        pre_steps14(F, l, ch); LDS_BARRIER(); pre_5a(F, l, ch); LDS_BARRIER(); pre_5b(F, l, ch); __syncthreads();
        const int tid = opaque_tid();
        { RwRaw nx; rw_load(F, ch >> 6, ch & 63, 0, tid, nx);
#pragma unroll 1
          for (int hh = 0; hh < 8; ++hh) { RwIn cu; rw_finish(F, l, hh, tid, nx, cu); if (hh < 7) rw_load(F, ch >> 6, ch & 63, hh + 1, tid, nx); rw_prep(F, l, ch >> 6, ch & 63, hh, tid, cu); } }
        __syncthreads();
        { const int w = __builtin_amdgcn_readfirstlane(tid >> 6); rw_tsolve(F, ch * 8 + w, w, tid & 63); }
        LDS_BARRIER();
        { HgIn nx; hg_load(F, ch * 4, tid, nx, false);
#pragma unroll 1
          for (int h = 0; h < 4; ++h) { const HgIn cu = nx; if (h < 3) hg_load(F, ch * 4 + h + 1, tid, nx, false); hg_local(F, l, ch * 4 + h, tid, cu); } }
        for (int g = 0; g < 2; ++g) ssd_local(F, l, ch * 2 + g, tid);
        rg_local(F, ch, tid);
        __syncthreads();
    }
}
__device__ __forceinline__ void phase_c3_chunk(const Frame& F, int l, int ch);
__device__ __forceinline__ void phase_back(const Frame& F, int l) {
    for (int ch = F.bid; ch < NTOK / 64; ch += F.G) {
        const int tid = opaque_tid();
        { HgIn nx; hg_load(F, ch * 4, tid, nx, true);
#pragma unroll 1
          for (int h = 0; h < 4; ++h) { const HgIn cu = nx; if (h < 3) hg_load(F, ch * 4 + h + 1, tid, nx, true); hg_out(F, l, ch * 4 + h, tid, cu); } }
        for (int g = 0; g < 2; ++g) ssd_out(F, l, ch * 2 + g, tid);
        rg_out(F, ch, tid);
        __syncthreads();
        phase_c3_chunk(F, l, ch);
        __syncthreads();
    }
}

struct C3In { float o[32], pg[8], pz[8], qv[8], qg[8], bon[8]; };
__device__ __forceinline__ void c3_load(const Frame& F, int l, int t, int lane, C3In& x) {
    const float* o = F.O + (size_t)t * D; const BfPtr p = F.P + (size_t)t * PS; const float* q = F.Q + (size_t)t * QS;
#pragma unroll
    for (int j = 0; j < 32; ++j) if (j < 16 || j >= 24) x.o[j] = o[lane + 64 * j];
#pragma unroll
    for (int j = 0; j < 8; ++j) { const int c = lane + 64 * j; x.pg[j] = p[C_HG_G + c]; x.pz[j] = p[C_SS_Z + c]; { const float vc = p[C_RW + 1024 + c], vp = ((t & (SEQ - 1)) != 0) ? p[C_RW + 1024 + c - (long)PS] : 0.f; x.qv[j] = vc + (vp - vc) * F.in[I_WMU][(size_t)l * RW_COLS + 1024 + c]; } x.qg[j] = q[Q_G + c]; x.bon[j] = ((const float*)(F.ws + WS_BON))[(size_t)t * 8 + j]; }
}
__device__ __forceinline__ void c3_unpack(u32x2 p, float (&f)[4]) { f[0] = __uint_as_float(p.x << 16); f[1] = __uint_as_float(p.x & 0xffff0000u); f[2] = __uint_as_float(p.y << 16); f[3] = __uint_as_float(p.y & 0xffff0000u); }
__device__ __forceinline__ void phase_c3_chunk(const Frame& F, int l, int ch) {
    const int tid_ = opaque_tid(); const int lane = tid_ & 63; const int wave_ = __builtin_amdgcn_readfirstlane(tid_ >> 6);
    const int t0 = ch * 64 + wave_ * 8, c0 = 4 * lane;
    const bf16_t* P = F.Pw;
    const float* hgw = F.in[I_HGNW] + l * GW; const float* snw = F.in[I_SNW] + l * GW;
    const float* lnw = F.in[I_WLNW] + l * GW; const float* lnb = F.in[I_WLNB] + l * GW; const float* mu = F.in[I_WMU] + (size_t)l * RW_COLS + 1024;
    const float* BON = (const float*)(F.ws + WS_BON);
    f32x4 oA[8][2]; u32x2 gA[8][2]; f32x4 wA[2];
    f32x4 oB[8][2]; u32x2 zB[8][2]; f32x4 wB[2];
#pragma unroll
    for (int i = 0; i < 8; ++i)
#pragma unroll
        for (int jj = 0; jj < 2; ++jj) { oA[i][jj] = *(const f32x4*)(F.O + (size_t)(t0 + i) * D + c0 + 256 * jj); gA[i][jj] = *(const u32x2*)(P + (size_t)(t0 + i) * PS + C_HG_G + c0 + 256 * jj); }
#pragma unroll
    for (int jj = 0; jj < 2; ++jj) wA[jj] = *(const f32x4*)(hgw + c0 + 256 * jj);
#pragma unroll
    for (int i = 0; i < 8; ++i)
#pragma unroll
        for (int jj = 0; jj < 2; ++jj) { oB[i][jj] = *(const f32x4*)(F.O + (size_t)(t0 + i) * D + 512 + c0 + 256 * jj); zB[i][jj] = *(const u32x2*)(P + (size_t)(t0 + i) * PS + C_SS_Z + c0 + 256 * jj); }
#pragma unroll
    for (int jj = 0; jj < 2; ++jj) wB[jj] = *(const f32x4*)(snw + c0 + 256 * jj);
#pragma unroll
    for (int i = 0; i < 8; ++i)
#pragma unroll
        for (int jj = 0; jj < 2; ++jj) {
            const f32x4 ov = oA[i][jj];
            float ss = row16_sum(ov[0] * ov[0] + ov[1] * ov[1] + ov[2] * ov[2] + ov[3] * ov[3]); ss += __shfl_xor(ss, 16);
            const float rs = rsqrtf(ss * (1.0f / 128.0f) + NORM_EPS);
            float gf[4]; c3_unpack(gA[i][jj], gf);
            u32x2 pk; pk.x = cvt_pk_bf16(ov[0] * rs * wA[jj][0] * silu_f(gf[0]), ov[1] * rs * wA[jj][1] * silu_f(gf[1])); pk.y = cvt_pk_bf16(ov[2] * rs * wA[jj][2] * silu_f(gf[2]), ov[3] * rs * wA[jj][3] * silu_f(gf[3]));
            *(u32x2*)(F.MIX + (size_t)(t0 + i) * D + c0 + 256 * jj) = pk;
        }
    f32x4 w4[2], b4[2], m4[2];
#pragma unroll
    for (int jj = 0; jj < 2; ++jj) { w4[jj] = *(const f32x4*)(lnw + c0 + 256 * jj); b4[jj] = *(const f32x4*)(lnb + c0 + 256 * jj); m4[jj] = *(const f32x4*)(mu + c0 + 256 * jj); }
    f32x4 oR[2][4][2], qR[2][4][2]; u32x2 vcR[2][4][2], vpR[2][4][2]; float bonR[2][4][2];
#define C3_LOAD_RW(hb) do { _Pragma("unroll") for (int i = 0; i < 4; ++i) { const int t = t0 + 4 * (hb) + i; const bool first = (t & (SEQ - 1)) == 0; \
        _Pragma("unroll") for (int jj = 0; jj < 2; ++jj) { \
            oR[hb][i][jj] = *(const f32x4*)(F.O + (size_t)t * D + 1536 + c0 + 256 * jj); qR[hb][i][jj] = *(const f32x4*)(F.Q + (size_t)t * QS + Q_G + c0 + 256 * jj); \
            const bf16_t* pv = P + (size_t)t * PS + C_RW + 1024 + c0 + 256 * jj; vcR[hb][i][jj] = *(const u32x2*)pv; \
            vpR[hb][i][jj] = (u32x2){0u, 0u}; if (!first) vpR[hb][i][jj] = *(const u32x2*)(pv - PS); \
            bonR[hb][i][jj] = BON[(size_t)t * 8 + (lane >> 4) + 4 * jj]; } } } while (0)
#define C3_MATH_RW(hb) do { _Pragma("unroll") for (int i = 0; i < 4; ++i) _Pragma("unroll") for (int jj = 0; jj < 2; ++jj) { \
        const f32x4 y = oR[hb][i][jj]; const float mean = row16_sum(y[0] + y[1] + y[2] + y[3]) * (1.0f / 64.0f); \
        float d[4]; _Pragma("unroll") for (int k = 0; k < 4; ++k) d[k] = y[k] - mean; \
        const float var = row16_sum(d[0] * d[0] + d[1] * d[1] + d[2] * d[2] + d[3] * d[3]) * (1.0f / 64.0f); const float rstd = rsqrtf(var + 64e-5f); \
        float vcf[4], vpf[4], out[4]; c3_unpack(vcR[hb][i][jj], vcf); c3_unpack(vpR[hb][i][jj], vpf); \
        _Pragma("unroll") for (int k = 0; k < 4; ++k) { const float vv = vcf[k] + (vpf[k] - vcf[k]) * m4[jj][k]; out[k] = (d[k] * rstd * w4[jj][k] + b4[jj][k] + bonR[hb][i][jj] * vv) * qR[hb][i][jj][k]; } \
        u32x2 pk; pk.x = cvt_pk_bf16(out[0], out[1]); pk.y = cvt_pk_bf16(out[2], out[3]); \
        *(u32x2*)(F.MIX + (size_t)(t0 + 4 * (hb) + i) * D + 1536 + c0 + 256 * jj) = pk; } } while (0)
#pragma unroll
    for (int i = 0; i < 8; ++i)
#pragma unroll
        for (int jj = 0; jj < 2; ++jj) {
            float zf[4]; c3_unpack(zB[i][jj], zf);
            float v[4];
#pragma unroll
            for (int k = 0; k < 4; ++k) v[k] = oB[i][jj][k] * silu_f(zf[k]);
            const float ss = wave_sum(v[0] * v[0] + v[1] * v[1] + v[2] * v[2] + v[3] * v[3]);
            const float rs = rsqrtf(ss * (1.0f / 256.0f) + NORM_EPS);
            u32x2 pk; pk.x = cvt_pk_bf16(v[0] * rs * wB[jj][0], v[1] * rs * wB[jj][1]); pk.y = cvt_pk_bf16(v[2] * rs * wB[jj][2], v[3] * rs * wB[jj][3]);
            *(u32x2*)(F.MIX + (size_t)(t0 + i) * D + 512 + c0 + 256 * jj) = pk;
        }
    C3_LOAD_RW(0);
    C3_MATH_RW(0);
    C3_LOAD_RW(1);
    C3_MATH_RW(1);
#undef C3_LOAD_RW
#undef C3_MATH_RW
}


__device__ __forceinline__ void phase_router2(const Frame& F, int l) {
    const int tid = opaque_tid(); const int lane = tid & 63, w = __builtin_amdgcn_readfirstlane(tid >> 6);
    const int r = lane & 15, q = lane >> 4;
    const float* WRT = (const float*)(F.ws + WS_WRT) + (size_t)l * 48 * 2048;
    const float* nw = F.in[I_NFFN] + (size_t)l * D;
    const float* bg = F.in[I_RGB] + l * 4; const float* be = F.in[I_REB] + l * 32;
    unsigned* cnt = F.ctl + CW_CNT + l * 32;
    unsigned* route = (unsigned*)(F.tab + TAB_ROUTE);
    float* Lg = (float*)F.lds + w * (16 * 48);
    for (int tile = w * F.G + F.bid; tile < NTOK / 16; tile += 8 * F.G) {
        const size_t t0 = (size_t)tile * 16;
        f32x4 acc[3]; acc[0] = (f32x4){0.f, 0.f, 0.f, 0.f}; acc[1] = acc[0]; acc[2] = acc[0];
        float ss = 0.f;
        const float* hp = F.h + (t0 + r) * D + 4 * q; const float* bp = WRT + (size_t)r * 2048 + 4 * q;
#pragma unroll 4
        for (int kg = 0; kg < 128; ++kg) {
            const f32x4 a4 = *(const f32x4*)(hp + kg * 16);
            ss += a4[0] * a4[0] + a4[1] * a4[1] + a4[2] * a4[2] + a4[3] * a4[3];
#pragma unroll
            for (int n = 0; n < 3; ++n) {
                const f32x4 b4 = *(const f32x4*)(bp + (size_t)n * 16 * 2048 + kg * 16);
#pragma unroll
                for (int s2 = 0; s2 < 4; ++s2) acc[n] = __builtin_amdgcn_mfma_f32_16x16x4f32(a4[s2], b4[s2], acc[n], 0, 0, 0);
            }
        }
        ss += __shfl_xor(ss, 16); ss += __shfl_xor(ss, 32);
        const float rs = rsqrtf(ss * (1.0f / D) + NORM_EPS);
#pragma unroll
        for (int j = 0; j < 4; ++j) {
            const float rj = __shfl(rs, 4 * q + j);
#pragma unroll
            for (int n = 0; n < 3; ++n) Lg[(4 * q + j) * 48 + n * 16 + r] = acc[n][j] * rj;
        }
        if (lane < 16) {
            const float* lg = Lg + lane * 48; const int t = (int)t0 + lane;
            float gl[4];
#pragma unroll
            for (int i = 0; i < 4; ++i) gl[i] = lg[i] + bg[i];
            int gi = 0; float gm = gl[0];
#pragma unroll
            for (int i = 1; i < 4; ++i) if (gl[i] > gm) { gm = gl[i]; gi = i; }
            float gsum = 0.f;
#pragma unroll
            for (int i = 0; i < 4; ++i) gsum += fexp(gl[i] - gm);
            const float gtop = 1.0f / gsum;
            float el[8];
#pragma unroll
            for (int i = 0; i < 8; ++i) el[i] = lg[4 + gi * 8 + i] + be[gi * 8 + i];
            int j1 = 0; float m1 = el[0];
#pragma unroll
            for (int i = 1; i < 8; ++i) if (el[i] > m1) { m1 = el[i]; j1 = i; }
            int j2 = -1; float m2 = -INFINITY;
#pragma unroll
            for (int i = 0; i < 8; ++i) if (i != j1 && el[i] > m2) { m2 = el[i]; j2 = i; }
            if (j2 < 0) { j2 = (j1 == 0) ? 1 : 0; m2 = m1; }
            const float e2 = fexp(m2 - m1);
            const float g1 = gtop / (1.0f + e2), g2 = gtop * e2 / (1.0f + e2);
            const int x1 = gi * 8 + j1, x2 = gi * 8 + j2;
            const unsigned p1 = atomicAdd(&cnt[x1], 1u), p2 = atomicAdd(&cnt[x2], 1u);
            u32x4 a; a.x = (unsigned)x1; a.y = (unsigned)x2; a.z = p1; a.w = p2;
            *(u32x4*)(route + (size_t)t * 8) = a;
            route[(size_t)t * 8 + 4] = __float_as_uint(g1); route[(size_t)t * 8 + 5] = __float_as_uint(g2);
        }
#pragma unroll 1
        for (int r4b = 0; r4b < 16; r4b += 4) {
            f32x4 v[4][8];
#pragma unroll
            for (int ri = 0; ri < 4; ++ri)
#pragma unroll
                for (int jj = 0; jj < 8; ++jj) v[ri][jj] = *(const f32x4*)(F.h + (t0 + r4b + ri) * D + 4 * (lane + 64 * jj));
#pragma unroll
            for (int ri = 0; ri < 4; ++ri) {
                const float rj = __shfl(rs, r4b + ri);
                bf16_t* urow = F.U + (t0 + r4b + ri) * D;
#pragma unroll
                for (int jj = 0; jj < 8; ++jj) {
                    const int c = 4 * (lane + 64 * jj);
                    const f32x4 wv = *(const f32x4*)(nw + c);
                    u32x2 pk; pk.x = cvt_pk_bf16(v[ri][jj][0] * rj * wv[0], v[ri][jj][1] * rj * wv[1]); pk.y = cvt_pk_bf16(v[ri][jj][2] * rj * wv[2], v[ri][jj][3] * rj * wv[3]);
                    *(u32x2*)(urow + c) = pk;
                }
            }
        }
    }
}


__device__ __forceinline__ void phase_router3(const Frame& F, int l) {
    const int tid = opaque_tid(); const int lane = tid & 63, w = __builtin_amdgcn_readfirstlane(tid >> 6);
    const int r = lane & 15, q = lane >> 4;
    const float* WRT = (const float*)(F.ws + WS_WRT) + (size_t)l * 48 * 2048;
    const float* nw = F.in[I_NFFN] + (size_t)l * D;
    const float* bg = F.in[I_RGB] + l * 4; const float* be = F.in[I_REB] + l * 32;
    unsigned* cnt = F.ctl + CW_CNT + l * 32;
    unsigned* route = (unsigned*)(F.tab + TAB_ROUTE);
    float* As = (float*)F.lds; float* Bs = As + 64 * 260; float* Cs = Bs + 48 * 260;
    float* Lg = As;
    const int tile = w & 3, kh = w >> 2;
    const int lr = tid >> 6, lc = (tid & 63) * 4;
    for (int g = F.bid; g < NTOK / 64; g += F.G) {
        const size_t t0 = (size_t)g * 64;
        f32x4 va[8], vb[6], vn;
        vn = *(const f32x4*)(nw + lc);
#pragma unroll
        for (int it = 0; it < 8; ++it) va[it] = *(const f32x4*)(F.h + (t0 + lr + 8 * it) * D + lc);
#pragma unroll
        for (int it = 0; it < 6; ++it) vb[it] = *(const f32x4*)(WRT + (size_t)(lr + 8 * it) * 2048 + lc);
        f32x4 acc[3]; acc[0] = (f32x4){0.f, 0.f, 0.f, 0.f}; acc[1] = acc[0]; acc[2] = acc[0];
        float ss = 0.f;
#pragma unroll 1
        for (int s = 0; s < 8; ++s) {
            LDS_BARRIER();
#pragma unroll
            for (int it = 0; it < 8; ++it) *(f32x4*)(As + (lr + 8 * it) * 260 + lc) = va[it];
#pragma unroll
            for (int it = 0; it < 6; ++it) *(f32x4*)(Bs + (lr + 8 * it) * 260 + lc) = vb[it];
            LDS_BARRIER();
#pragma unroll
            for (int it = 0; it < 8; ++it) {
                u32x2 pk; pk.x = cvt_pk_bf16(va[it][0] * vn[0], va[it][1] * vn[1]); pk.y = cvt_pk_bf16(va[it][2] * vn[2], va[it][3] * vn[3]);
                *(u32x2*)(F.U + (t0 + lr + 8 * it) * D + 256 * s + lc) = pk;
            }
            if (s < 7) {
                const int c0 = 256 * (s + 1) + lc;
                vn = *(const f32x4*)(nw + c0);
#pragma unroll
                for (int it = 0; it < 8; ++it) va[it] = *(const f32x4*)(F.h + (t0 + lr + 8 * it) * D + c0);
#pragma unroll
                for (int it = 0; it < 6; ++it) vb[it] = *(const f32x4*)(WRT + (size_t)(lr + 8 * it) * 2048 + c0);
            }
            const float* ap = As + (16 * tile + r) * 260 + 4 * q + kh * 128; const float* bp = Bs + r * 260 + 4 * q + kh * 128;
#pragma unroll
            for (int kg = 0; kg < 8; ++kg) {
                const f32x4 a4 = *(const f32x4*)(ap + 16 * kg);
                ss += a4[0] * a4[0] + a4[1] * a4[1] + a4[2] * a4[2] + a4[3] * a4[3];
#pragma unroll
                for (int n = 0; n < 3; ++n) {
                    const f32x4 b4 = *(const f32x4*)(bp + n * 16 * 260 + 16 * kg);
#pragma unroll
                    for (int s2 = 0; s2 < 4; ++s2) acc[n] = __builtin_amdgcn_mfma_f32_16x16x4f32(a4[s2], b4[s2], acc[n], 0, 0, 0);
                }
            }
        }
        if (kh == 1) {
            float* c = Cs + (tile * 64 + lane) * 13;
#pragma unroll
            for (int n = 0; n < 3; ++n)
#pragma unroll
                for (int j = 0; j < 4; ++j) c[n * 4 + j] = acc[n][j];
            c[12] = ss;
        }
        LDS_BARRIER();
        if (kh == 0) {
            const float* c = Cs + (tile * 64 + lane) * 13;
#pragma unroll
            for (int n = 0; n < 3; ++n)
#pragma unroll
                for (int j = 0; j < 4; ++j) acc[n][j] += c[n * 4 + j];
            ss += c[12];
            ss += __shfl_xor(ss, 16); ss += __shfl_xor(ss, 32);
            const float rs = rsqrtf(ss * (1.0f / D) + NORM_EPS);
#pragma unroll
            for (int j = 0; j < 4; ++j) {
                const float rj = __shfl(rs, 4 * q + j);
#pragma unroll
                for (int n = 0; n < 3; ++n) Lg[(16 * tile + 4 * q + j) * 48 + n * 16 + r] = acc[n][j] * rj;
            }
            if (lane < 16) {
                const float* lg = Lg + (16 * tile + lane) * 48; const int t = (int)t0 + 16 * tile + lane;
                float gl[4];
#pragma unroll
                for (int i = 0; i < 4; ++i) gl[i] = lg[i] + bg[i];
                int gi = 0; float gm = gl[0];
#pragma unroll
                for (int i = 1; i < 4; ++i) if (gl[i] > gm) { gm = gl[i]; gi = i; }
                float gsum = 0.f;
#pragma unroll
                for (int i = 0; i < 4; ++i) gsum += fexp(gl[i] - gm);
                const float gtop = 1.0f / gsum;
                float el[8];
#pragma unroll
                for (int i = 0; i < 8; ++i) el[i] = lg[4 + gi * 8 + i] + be[gi * 8 + i];
                int j1 = 0; float m1 = el[0];
#pragma unroll
                for (int i = 1; i < 8; ++i) if (el[i] > m1) { m1 = el[i]; j1 = i; }
                int j2 = -1; float m2 = -INFINITY;
#pragma unroll
                for (int i = 0; i < 8; ++i) if (i != j1 && el[i] > m2) { m2 = el[i]; j2 = i; }
                if (j2 < 0) { j2 = (j1 == 0) ? 1 : 0; m2 = m1; }
                const float e2 = fexp(m2 - m1);
                const float g1 = gtop / (1.0f + e2), g2 = gtop * e2 / (1.0f + e2);
                const int x1 = gi * 8 + j1, x2 = gi * 8 + j2;
                const unsigned p1 = atomicAdd(&cnt[x1], 1u), p2 = atomicAdd(&cnt[x2], 1u);
                u32x4 a; a.x = (unsigned)x1; a.y = (unsigned)x2; a.z = p1; a.w = p2;
                *(u32x4*)(route + (size_t)t * 8) = a;
                route[(size_t)t * 8 + 4] = __float_as_uint(g1); route[(size_t)t * 8 + 5] = __float_as_uint(g2); route[(size_t)t * 8 + 6] = __float_as_uint(rs);
            }
        }
    }
}

__device__ __forceinline__ void phase_tables(const Frame& F, int l) {
    const int tid = opaque_tid(); const int lane = tid & 63;
    int* pst = (int*)F.lds;
    const unsigned* cnt = F.ctl + CW_CNT + l * 32;
    int* slot_tok = (int*)(F.tab + TAB_SLOTTOK);
    if (tid < 32) pst[32 + tid] = (int)__hip_atomic_load(&cnt[tid], __ATOMIC_RELAXED, __HIP_MEMORY_SCOPE_AGENT);
    __syncthreads();
    if (tid == 0) {
        int* tile_exp = (int*)(F.tab + TAB_TILEEXP); int* ntiles = (int*)(F.tab + TAB_NTILES);
        int off = 0, nt = 0;
        for (int e = 0; e < NEXP; ++e) {
            pst[e] = off; const int tiles = (pst[32 + e] + 255) >> 8;
            if (F.bid == 0) for (int i = 0; i < tiles && nt < MAXTILE; ++i) tile_exp[nt + i] = e;
            nt += tiles; off += tiles * 256;
        }
        if (F.bid == 0) *ntiles = nt < MAXTILE ? nt : MAXTILE;
    }
    __syncthreads();
    if (F.bid == 0) {
        for (int e = 0; e < NEXP; ++e) { const int c = pst[32 + e], beg = pst[e] + c, end = pst[e] + (((c + 255) >> 8) << 8); for (int sidx = beg + tid; sidx < end; sidx += 512) if (sidx < MAXSLOT) { slot_tok[sidx] = 0; ((float*)(F.ws + WS_SLOTRS))[sidx] = 0.f; } }
    }
    const unsigned* route = (const unsigned*)(F.tab + TAB_ROUTE);
    int* tokslot = (int*)(F.tab + TAB_TOKSLOT); float* slotgate = (float*)(F.tab + TAB_SLOTGATE); float* slotrs = (float*)(F.ws + WS_SLOTRS);
    for (int t = F.bid * 512 + tid; t < NTOK; t += F.G * 512) {
        const u32x4 a = *(const u32x4*)(route + (size_t)t * 8);
        int s0 = pst[a.x & 31u] + (int)a.z, s1 = pst[a.y & 31u] + (int)a.w;
        s0 = min(max(s0, 0), MAXSLOT - 1); s1 = min(max(s1, 0), MAXSLOT - 1);
        tokslot[2 * t] = s0; tokslot[2 * t + 1] = s1; slot_tok[s0] = t; slot_tok[s1] = t;
        slotgate[s0] = __uint_as_float(route[(size_t)t * 8 + 4]); slotgate[s1] = __uint_as_float(route[(size_t)t * 8 + 5]);
        const float rsv = __uint_as_float(route[(size_t)t * 8 + 6]); slotrs[s0] = rsv; slotrs[s1] = rsv;
    }
    (void)lane;
}

__device__ __forceinline__ void phase_offsets(const Frame& F, int l) {
    const int tid_ = opaque_tid(); const int lane_ = tid_ & 63; const int wave_ = __builtin_amdgcn_readfirstlane(tid_ >> 6); (void)lane_; (void)wave_;
    if (F.bid == 0 && tid_ == 0) {
        const unsigned* cnt = F.ctl + CW_CNT + l * 32;
        int* padstart = (int*)(F.tab + TAB_PADSTART); int* tile_exp = (int*)(F.tab + TAB_TILEEXP); int* ntiles = (int*)(F.tab + TAB_NTILES);
        int off = 0, nt = 0;
        for (int e = 0; e < NEXP; ++e) {
            const int c = (int)__hip_atomic_load(&cnt[e], __ATOMIC_RELAXED, __HIP_MEMORY_SCOPE_AGENT);
            padstart[e] = off;
            const int tiles = (c + 255) >> 8;
            for (int i = 0; i < tiles && nt < MAXTILE; ++i) tile_exp[nt++] = e;
            off += tiles * 256;
        }
        *ntiles = nt;
    }
}

__device__ __forceinline__ void phase_scatter(const Frame& F) {
    const int tid_ = opaque_tid(); const int lane_ = tid_ & 63; const int wave_ = __builtin_amdgcn_readfirstlane(tid_ >> 6); (void)lane_; (void)wave_;
    const int gw = F.bid * 8 + wave_, nw = F.G * 8, lane = lane_;
    const unsigned* route = (const unsigned*)(F.tab + TAB_ROUTE); const int* padstart = (const int*)(F.tab + TAB_PADSTART);
    int* tokslot = (int*)(F.tab + TAB_TOKSLOT); float* slotgate = (float*)(F.tab + TAB_SLOTGATE);
    for (int t = gw; t < NTOK; t += nw) {
        const u32x4 a = *(const u32x4*)(route + (size_t)t * 8);
        int s0 = padstart[a.x & 31u] + (int)a.z, s1 = padstart[a.y & 31u] + (int)a.w;
        s0 = min(max(s0, 0), MAXSLOT - 1); s1 = min(max(s1, 0), MAXSLOT - 1);
        if (lane == 0) { tokslot[2 * t] = s0; tokslot[2 * t + 1] = s1; slotgate[s0] = __uint_as_float(route[(size_t)t * 8 + 4]); slotgate[s1] = __uint_as_float(route[(size_t)t * 8 + 5]); }
        const u32x4* src = (const u32x4*)(F.U + (size_t)t * D);
        u32x4* d0 = (u32x4*)(F.XPERM + (size_t)s0 * D); u32x4* d1 = (u32x4*)(F.XPERM + (size_t)s1 * D);
#pragma unroll
        for (int i = 0; i < 4; ++i) { const u32x4 x = src[lane + 64 * i]; d0[lane + 64 * i] = x; d1[lane + 64 * i] = x; }
    }
}

constexpr int PH_PER_LAYER = 10, N_PHASES = 1 + DEPTH * PH_PER_LAYER;

__global__ void __launch_bounds__(512, 2) mega(Args args) {
    extern __shared__ __attribute__((aligned(16))) unsigned char lds[];
    Frame F;
    F.in = args.in; F.h = args.out; F.ws = args.ws; F.lds = lds;
    F.G = gridDim.x; F.bid = blockIdx.x;
    F.ctl = (unsigned*)(args.ws + WS_CTL); F.tab = args.ws + WS_TAB;
    F.P = BfPtr{(const bf16_t*)(args.ws + WS_R1)}; F.Pw = (bf16_t*)(args.ws + WS_R1); F.Y = (bf16_t*)(args.ws + WS_R1); F.HID = (bf16_t*)(args.ws + WS_R1 + R1_HID);
    F.Q = (float*)(args.ws + WS_R2); F.XPERM = (bf16_t*)(args.ws + WS_R2); F.O = (float*)(args.ws + WS_R3);
    F.U = (bf16_t*)(args.ws + WS_U); F.MIX = (bf16_t*)(args.ws + WS_MIX);
    LAS unsigned char* ldsl = (LAS unsigned char*)lds;
    volatile LAS unsigned* misc = (volatile LAS unsigned*)(ldsl + LDS_MISC);
    if (threadIdx.x < 16) misc[threadIdx.x] = 0u;
    __syncthreads();
    const int lo = args.ph_lo, hi = args.ph_hi;
    XcdBarrier bar; bar.bar = F.ctl + CW_BAR; bar.x = 0; bar.st = misc;
    if (hi - lo > 1) bar = xcd_barrier_post(F.ctl + CW_BAR, misc);
#define IN(k) (lo <= (k) && (k) < hi)

    int ph = 0;
#ifndef PROBE_GROUP
#define PROBE_GROUP 0
#endif
#define PHASE_BEGIN if (IN(ph)) {
#define PHASE_BEGIN_R(g) if (IN(ph)) { for (int rep_ = 0; rep_ < 1 + (PROBE_GROUP == (g)); ++rep_) {
#define PHASE_END_R } PHASE_END
#define PHASE_END } if (IN(ph) && IN(ph + 1)) xcd_barrier(bar); ++ph;
    PHASE_BEGIN_R(1) phase_prologue(F); __syncthreads(); phase_norm1(F, 0, F.in[I_NMIX]); PHASE_END_R
    for (int l = 0; l < DEPTH; ++l) {
        if (l > 0) { PHASE_BEGIN phase_norm1(F, 1, F.in[I_NMIX] + (size_t)l * D); PHASE_END }
        PHASE_BEGIN_R(2)
            pg8::Gemm g{F.U, (const bf16_t*)(F.ws + WS_WIN) + (size_t)l * PS * D, D, 0, nullptr};
            pg8::StaticOrder S; S.init(NTOK, PS, F.G, F.bid);
            pg8::EpiBf E{F.Pw, PS};
            pg8::gemm_phase(ldsl, g, S, E);
            { const int rem = S.nwg % F.G;
              if (rem > 0 && F.bid >= rem) { __syncthreads(); const int tid_ = opaque_tid();
                  for (int i = F.bid - rem; i < DEFER_GEMM / 2; i += F.G - rem) conv_down_tile(F, 64 * 16 * 8 - DEFER_TILES - DEFER_GEMM + l * (DEFER_GEMM / 2) + i, tid_); }
              else if (rem == 0) { __syncthreads(); const int tid_ = opaque_tid();
                  for (int i = F.bid; i < DEFER_GEMM / 2; i += F.G) conv_down_tile(F, 64 * 16 * 8 - DEFER_TILES - DEFER_GEMM + l * (DEFER_GEMM / 2) + i, tid_); } }
        PHASE_END_R
        PHASE_BEGIN_R(4) phase_front(F, l); PHASE_END_R
        PHASE_BEGIN phase_m2(F, l); PHASE_END
        PHASE_BEGIN_R(6) phase_back(F, l); PHASE_END_R
        PHASE_BEGIN
            pg8::Gemm g{F.MIX, (const bf16_t*)(F.ws + WS_WOUT) + (size_t)l * D * D, D, 0, nullptr};
            pg8::StaticOrder S; S.init(NTOK, D, F.G, F.bid);
            pg8::EpiRes E{l == 0 ? F.in[I_X] : F.h, F.h, D};
            pg8::gemm_phase(ldsl, g, S, E);
        PHASE_END
        PHASE_BEGIN phase_router3(F, l); PHASE_END
        PHASE_BEGIN phase_tables(F, l); PHASE_END
        PHASE_BEGIN_R(2)
            pg8::Gemm g{F.U, (const bf16_t*)(F.ws + WS_WGU) + (size_t)l * NEXP * 2048 * 2048, D, (size_t)2048 * 2048 * 2, (const int*)(F.tab + TAB_SLOTTOK)};
            pg8::MoeOrder S{*(const int*)(F.tab + TAB_NTILES), (const int*)(F.tab + TAB_TILEEXP), 8, F.G, F.bid};
            pg8::EpiGU E{F.HID, (const float*)(F.ws + WS_SLOTRS)};
            pg8::gemm_phase<pg8::EpiGU, pg8::MoeOrder, true>(ldsl, g, S, E);
        PHASE_END_R
        PHASE_BEGIN_R(2)
            pg8::Gemm g{F.HID, (const bf16_t*)(F.ws + WS_WD) + (size_t)l * NEXP * 2048 * 1024, DEXP, (size_t)2048 * 1024 * 2, nullptr};
            pg8::MoeOrder S{*(const int*)(F.tab + TAB_NTILES), (const int*)(F.tab + TAB_TILEEXP), 8, F.G, F.bid};
            pg8::EpiDown E{F.Y, (const float*)(F.tab + TAB_SLOTGATE)};
            pg8::gemm_phase(ldsl, g, S, E);
        PHASE_END_R
    }
    PHASE_BEGIN phase_norm1(F, 2, F.in[I_NFIN]); PHASE_END
#undef PHASE_BEGIN
#undef PHASE_END
#undef IN
}

extern "C" void kernel_launch(void* const* d_in, const int* in_sizes, int n_in, void* d_out, int out_size, void* d_ws, size_t ws_size, hipStream_t stream) {
    static int grid = 0;
    if (grid == 0) {
        if (n_in != NIN || out_size != NTOK * D || ws_size < WS_END) { fprintf(stderr, "kernel_launch: unexpected shapes (n_in %d, out %d, ws %zu < %zu)\n", n_in, out_size, ws_size, (size_t)WS_END); grid = -1; return; }
        int dev = 0, cus = 0;
        if (hipGetDevice(&dev) != hipSuccess || hipDeviceGetAttribute(&cus, hipDeviceAttributeMultiprocessorCount, dev) != hipSuccess) { grid = -1; return; }
        if (hipFuncSetAttribute((const void*)mega, hipFuncAttributeMaxDynamicSharedMemorySize, LDS_BYTES) != hipSuccess) { fprintf(stderr, "kernel_launch: hipFuncSetAttribute failed\n"); grid = -1; return; }
        int per_cu = 0;
        if (hipOccupancyMaxActiveBlocksPerMultiprocessor(&per_cu, (const void*)mega, 512, LDS_BYTES) != hipSuccess || per_cu < 1) fprintf(stderr, "kernel_launch: occupancy query says %d\n", per_cu);
        (void)hipGetLastError();
        grid = cus;
    }
    if (grid < 0) return;
    (void)hipMemsetAsync((char*)d_ws + WS_CTL, 0, CTL_BYTES, stream);
    Args a{};
    for (int i = 0; i < NIN; ++i) a.in[i] = (const float*)d_in[i];
    a.out = (float*)d_out; a.ws = (unsigned char*)d_ws;
#if MK_MULTI
    for (int p = 0; p < N_PHASES; ++p) { a.ph_lo = p; a.ph_hi = p + 1; hipLaunchKernelGGL(mega, dim3(grid), dim3(512), LDS_BYTES, stream, a); }
#else
    a.ph_lo = 0; a.ph_hi = N_PHASES;
    hipLaunchKernelGGL(mega, dim3(grid), dim3(512), LDS_BYTES, stream, a);
#endif
}
```

```cpp
#include <hip/hip_runtime.h>
#include <stdint.h>
#include <stdio.h>

#ifndef MK_MULTI
#define MK_MULTI 0
#endif

#define LAS __attribute__((address_space(3)))
#define LDS_BARRIER() do { asm volatile("s_waitcnt lgkmcnt(0)" ::: "memory"); __builtin_amdgcn_s_barrier(); asm volatile("" ::: "memory"); } while (0)
typedef unsigned short bf16_t;
typedef short bf16x8 __attribute__((ext_vector_type(8)));
typedef float f32x4 __attribute__((ext_vector_type(4)));
typedef unsigned u32x4 __attribute__((ext_vector_type(4)));
typedef unsigned u32x2 __attribute__((ext_vector_type(2)));

constexpr int D = 2048, SEQ = 4096, NTOK = 16384, DEPTH = 2, GW = 512;
constexpr int IN_COLS = 6600, PS = 6656;
constexpr int C_HG_Q = 0, C_HG_F = 512, C_HG_I = 1024, C_HG_G = 1536;
constexpr int C_SS_Z = 2048, C_SS_X = 2560, C_SS_DT = 3584;
constexpr int C_RG_G = 3592, C_RG_X = 4104;
constexpr int C_RW = 4616;
constexpr int RW_COLS = 1984;
constexpr int QS = 5120;
constexpr int Q_RGA = 512, Q_RGU = 1024, Q_R = 1536, Q_W = 2048, Q_K = 2560, Q_V = 3072, Q_KK = 3584, Q_KKA = 4096, Q_G = 4608;
constexpr int NEXP = 32, DEXP = 1024;
constexpr int MAXSLOT = 40960, MAXTILE = 160;
constexpr float NORM_EPS = 1e-6f;

constexpr size_t al256(size_t x) { return (x + 255) & ~(size_t)255; }
constexpr size_t WS_CTL = 0;
constexpr size_t CTL_BYTES = 65536;
constexpr size_t WS_TAB = WS_CTL + CTL_BYTES;
constexpr size_t TAB_ROUTE = 0;
constexpr size_t TAB_TOKSLOT = TAB_ROUTE + (size_t)NTOK * 32;
constexpr size_t TAB_SLOTGATE = TAB_TOKSLOT + (size_t)NTOK * 8;
constexpr size_t TAB_PADSTART = TAB_SLOTGATE + (size_t)MAXSLOT * 4;
constexpr size_t TAB_TILEEXP = TAB_PADSTART + 256;
constexpr size_t TAB_NTILES = TAB_TILEEXP + 1024;
constexpr size_t TAB_SLOTTOK = TAB_NTILES + 256;
constexpr size_t TAB_BYTES = al256(TAB_SLOTTOK + (size_t)MAXSLOT * 4);
constexpr size_t WS_WIN = al256(WS_TAB + TAB_BYTES);
constexpr size_t WS_WOUT = WS_WIN + (size_t)2 * PS * D * 2;
constexpr size_t WS_WGU = WS_WOUT + (size_t)2 * D * D * 2;
constexpr size_t WS_WD = WS_WGU + (size_t)2 * NEXP * 2048 * 2048 * 2;
constexpr size_t WS_U = WS_WD + (size_t)2 * NEXP * 2048 * 1024 * 2;
constexpr size_t WS_MIX = WS_U + (size_t)NTOK * D * 2;
constexpr size_t WS_R1 = WS_MIX + (size_t)NTOK * D * 2;
constexpr size_t R1_HID = (size_t)MAXSLOT * D * 2;
constexpr size_t R1_BYTES = R1_HID + (size_t)MAXSLOT * DEXP * 2;
static_assert((size_t)NTOK * PS * 2 <= R1_BYTES, "R1 alias");
constexpr size_t WS_R2 = WS_R1 + R1_BYTES;
constexpr size_t R2_BYTES = (size_t)NTOK * QS * 4;
static_assert((size_t)MAXSLOT * D * 2 <= R2_BYTES, "R2 alias");
constexpr size_t WS_R3 = WS_R2 + R2_BYTES;
constexpr size_t WS_R4 = WS_R3 + (size_t)NTOK * D * 4;
constexpr size_t R4_HGS = 0;
constexpr size_t R4_SSS = R4_HGS + (size_t)16 * 64 * 16384 * 4;
constexpr size_t R4_HGD = R4_SSS + (size_t)32 * 64 * 8192 * 4;
constexpr size_t R4_SSD = R4_HGD + (size_t)16 * 64 * 128 * 4;
constexpr size_t R4_RGC = R4_SSD + (size_t)32 * 64 * 4;
constexpr size_t WS_RWAAB = al256(WS_R4 + R4_RGC + (size_t)4 * 64 * 512 * 2 * 4);
constexpr size_t WS_RWGC = WS_RWAAB + (size_t)2048 * 4096 * 4;
constexpr size_t WS_SW = WS_RWGC + (size_t)2048 * 64 * 4;
constexpr size_t SW_W2T = 0, SW_A2T = SW_W2T + 512 * 96 * 2, SW_G2T = SW_A2T + 512 * 96 * 2, SW_WAT = SW_G2T + 512 * 256 * 2, SW_WXT = SW_WAT + 8 * 64 * 64 * 2, SW_LAYER = SW_WXT + 8 * 64 * 64 * 2;
constexpr size_t WS_WRT = al256(WS_SW + 2 * SW_LAYER);
constexpr size_t WS_BON = al256(WS_WRT + (size_t)2 * 48 * 2048 * 4);
constexpr size_t WS_SLOTRS = al256(WS_BON + (size_t)NTOK * 8 * 4);
constexpr size_t WS_END = WS_SLOTRS + (size_t)MAXSLOT * 4;
constexpr size_t RW_REC = 65536;
constexpr int RO_AR = 0, RO_RR = 8192, RO_BRT = 16384, RO_ARBT = 24576, RO_TT = 32768, RO_XL = 40960, RO_LT = 49152, RO_YL = 57344;
static_assert(WS_MIX == WS_U + (size_t)NTOK * D * 2 && (size_t)2048 * RW_REC <= (size_t)2 * NTOK * D * 2, "RW record region");

constexpr int CW_BAR = 0;
constexpr int CW_CNT = 4096;

typedef __bf16 bf16v2 __attribute__((ext_vector_type(2)));
typedef float f32x2 __attribute__((ext_vector_type(2)));
__device__ __forceinline__ unsigned cvt_pk_bf16(float lo, float hi) { const f32x2 v = {lo, hi}; const bf16v2 b = __builtin_convertvector(v, bf16v2); return __builtin_bit_cast(unsigned, b); }
__device__ __forceinline__ bf16_t f2bf(float f) { return (bf16_t)(cvt_pk_bf16(f, 0.0f) & 0xffffu); }
#define DPP_ADD(v, ctrl, rmask, bc) ((v) + __uint_as_float(__builtin_amdgcn_update_dpp(0u, __float_as_uint(v), (ctrl), (rmask), 0xf, (bc))))
__device__ __forceinline__ float row16_sum(float v) {
    v = DPP_ADD(v, 0xB1, 0xf, true); v = DPP_ADD(v, 0x4E, 0xf, true); v = DPP_ADD(v, 0x141, 0xf, true); v = DPP_ADD(v, 0x140, 0xf, true);
    return v;
}
__device__ __forceinline__ float wave_sum(float v) {
    v = row16_sum(v);
    v = DPP_ADD(v, 0x142, 0xa, false);
    v = DPP_ADD(v, 0x143, 0xc, false);
    return __int_as_float(__builtin_amdgcn_readlane(__float_as_int(v), 63));
}
__device__ __forceinline__ float fexp(float x) { return __expf(x); }
__device__ __forceinline__ float flog(float x) { return __logf(x); }
__device__ __forceinline__ float frcp(float x) { return __builtin_amdgcn_rcpf(x); }
__device__ __forceinline__ float sigmoid_f(float x) { return frcp(1.0f + fexp(-x)); }
__device__ __forceinline__ float silu_f(float x) { return x * sigmoid_f(x); }
__device__ __forceinline__ float softplus_f(float x) { return fmaxf(x, 0.f) + flog(1.0f + fexp(-fabsf(x))); }
__device__ __forceinline__ float ftanh(float x) { const float e = fexp(-2.0f * fabsf(x)); const float t = (1.0f - e) * frcp(1.0f + e); return x < 0.f ? -t : t; }
__device__ __forceinline__ float gelu_tanh_f(float x) { const float u = 0.7978845608028654f * (x + 0.044715f * x * x * x); return 0.5f * x * (1.0f + ftanh(u)); }

__device__ __forceinline__ int opaque_tid() { int t = threadIdx.x; asm volatile("" : "+v"(t)); return t; }

#define XB_TMO      128
#define XB_XCNT(j)  (256  + 64 * (j))
#define XB_XSUB(j)  (1280 + 64 * (j))
#define XB_XGEN(j)  (2304 + 64 * (j))
#define XB_TOP      3328
#define XB_TOPGEN   3392
#define XCD_BAR_WORDS 3456
#define XB_SPIN_CAP (1u << 18)
__device__ __forceinline__ unsigned xb_ld(unsigned* p)              { return __hip_atomic_load(p, __ATOMIC_RELAXED, __HIP_MEMORY_SCOPE_AGENT); }
__device__ __forceinline__ unsigned xb_add(unsigned* p, unsigned v) { return __hip_atomic_fetch_add(p, v, __ATOMIC_RELAXED, __HIP_MEMORY_SCOPE_AGENT); }
__device__ __forceinline__ unsigned xb_xcc_id() { return (unsigned)__builtin_amdgcn_s_getreg((3 << 11) | 20) & 0xFu; }
#define XB_SPIN(cond, bar) do { unsigned _sp = 0; while (cond) { __builtin_amdgcn_s_sleep(1); \
    if ((++_sp & 255u) == 0u) { if (xb_ld(&(bar)[XB_TMO])) break; if (_sp > XB_SPIN_CAP) { atomicAdd(&(bar)[XB_TMO], 1u); break; } } } } while (0)
struct XcdBarrier { unsigned* bar; unsigned x; volatile LAS unsigned* st; };
__device__ __forceinline__ XcdBarrier xcd_barrier_post(unsigned* bar, volatile LAS unsigned* st) {
    XcdBarrier b; b.bar = bar; b.x = xb_xcc_id(); b.st = st;
    if (threadIdx.x == 0) (void)xb_add(&bar[XB_XCNT(b.x)], 1u);
    return b;
}
__device__ __forceinline__ void xcd_barrier_complete(unsigned* bar, unsigned x, unsigned& nloc, unsigned& nx) {
    const unsigned G = gridDim.x * gridDim.y * gridDim.z;
    unsigned sum, cnt, mine, sp = 0u;
    for (;;) {
        sum = 0u; cnt = 0u; mine = 0u;
#pragma unroll
        for (unsigned j = 0; j < 16; ++j) { const unsigned c = xb_ld(&bar[XB_XCNT(j)]); sum += c; cnt += (c > 0u) ? 1u : 0u; mine = (j == x) ? c : mine; }
        if (sum == G) break;
        __builtin_amdgcn_s_sleep(1);
        if ((++sp & 255u) == 0u) { if (xb_ld(&bar[XB_TMO])) break; if (sp > XB_SPIN_CAP) { atomicAdd(&bar[XB_TMO], 1u); break; } }
    }
    nloc = mine > 0u ? mine : 1u; nx = cnt > 0u ? cnt : 1u;
}
__device__ __forceinline__ void xcd_barrier(const XcdBarrier& b) {
    asm volatile("s_waitcnt vmcnt(0)" ::: "memory");
    __syncthreads();
    if (threadIdx.x == 0) {
        unsigned* bar = b.bar;
        __builtin_amdgcn_s_waitcnt(0);
        unsigned nloc = b.st[0], nx = b.st[1];
        if (nloc == 0u) { xcd_barrier_complete(bar, b.x, nloc, nx); b.st[0] = nloc; b.st[1] = nx; }
        const unsigned old = xb_add(&bar[XB_XSUB(b.x)], 1u);
        const unsigned gen = old / nloc;
        if (old + 1u == (gen + 1u) * nloc) {
            __builtin_amdgcn_fence(__ATOMIC_RELEASE, "agent");
            asm volatile("s_waitcnt vmcnt(0)" ::: "memory");
            const unsigned og = xb_add(&bar[XB_TOP], 1u);
            const unsigned tg = og / nx;
            if (og + 1u == (tg + 1u) * nx) xb_add(&bar[XB_TOPGEN], 1u);
            else XB_SPIN(xb_ld(&bar[XB_TOPGEN]) == tg, bar);
            __builtin_amdgcn_fence(__ATOMIC_ACQUIRE, "agent");
            xb_add(&bar[XB_XGEN(b.x)], 1u);
            asm volatile("s_waitcnt vmcnt(0)" ::: "memory");
        } else {
            XB_SPIN(xb_ld(&bar[XB_XGEN(b.x)]) == gen, bar);
            __builtin_amdgcn_fence(__ATOMIC_ACQUIRE, "agent");
            asm volatile("s_waitcnt vmcnt(0)" ::: "memory");
        }
    }
    __syncthreads();
}

namespace pg8 {
constexpr int BM = 256, BK = 64, HALF = 128, HTB = HALF * BK * 2, STAGE_BYTES = 8 * HTB, NXCD = 8;
__host__ __device__ __forceinline__ int lds_byte(int r, int c) { const int st = (r >> 4) * 2 + (c >> 5), rr = r & 15, cc = c & 31, ob = rr * 64 + cc * 2; return st * 1024 + (ob ^ (((ob >> 9) & 1) << 5)); }
__host__ __device__ __forceinline__ void stage_rc(int b, int& R, int& C) { const int st = b / 1024, sb = b % 1024, swz = sb ^ (((sb >> 9) & 1) << 5); R = (st >> 1) * 16 + swz / 64; C = (st & 1) * 32 + (swz % 64) / 2; }

struct Unit { int pm, pn, e; };
struct Gemm { const bf16_t* A; const bf16_t* Bt; int K; size_t ebytes; const int* rowmap; };

struct StaticOrder {
    int nM, nN, nwg, G, c, WGM;
    __device__ void init(int M, int N, int G_, int c_, int wgm = 4) { nM = M / BM; nN = N / BM; nwg = nM * nN; G = G_; c = c_; WGM = wgm; }
    __device__ bool next(int i, Unit& u) const {
        const long L = (long)i * G + c; if (L >= nwg) return false;
        int wgid = (int)L; { const int q = nwg / NXCD, r = nwg % NXCD, xcd = wgid % NXCD, off = wgid / NXCD; wgid = (xcd < r ? xcd * (q + 1) : r * (q + 1) + (xcd - r) * q) + off; }
        const int nig = WGM * nN, gid = wgid / nig, fm = gid * WGM, gsz = (nM - fm) < WGM ? (nM - fm) : WGM;
        u.pm = fm + ((wgid % nig) % gsz); u.pn = (wgid % nig) / gsz; u.e = 0; return true;
    }
};
struct MoeOrder {
    int nt; const int* tile_exp; int nN, G, c;
    __device__ bool next(int i, Unit& u) const {
        int t, pn;
        if ((G & 255) == 0 && nN == 8) { const int x = c & 7, idx = c >> 3, per = G >> 8;
            const int grp = idx >> 5;
            t = 4 * ((i * per + grp) * 8 + x) + ((idx & 31) >> 3); pn = idx & 7; (void)per; }
        else { const long L = (long)i * G + c; t = (int)(L / nN); pn = (int)(L % nN); }
        const bool ok = t < nt;
        u.pm = ok ? t : 0; u.pn = ok ? pn : 0; u.e = tile_exp[u.pm]; return ok;
    }
};

struct EpiBf {
    bf16_t* C; int ldc;
    __device__ __forceinline__ void operator()(const f32x4 (&acc)[2][2][4][2], const Unit& u, int wr, int wc, int fr, int fq) const {
        const int row0 = u.pm * BM + wr * 64 + fr, col0 = u.pn * BM + wc * 32 + 8 * (fq >> 1) + 16 * (fq & 1);
#pragma unroll
        for (int ai = 0; ai < 2; ++ai)
#pragma unroll
            for (int m = 0; m < 4; ++m) { bf16_t* rowp = C + (size_t)(row0 + ai * HALF + m * 16) * ldc + col0;
#pragma unroll
                for (int bj = 0; bj < 2; ++bj) {
                    const f32x4 v0 = acc[ai][bj][m][0], v1 = acc[ai][bj][m][1];
                    const auto sx = __builtin_amdgcn_permlane16_swap(cvt_pk_bf16(v0[0], v0[1]), cvt_pk_bf16(v1[0], v1[1]), false, false);
                    const auto sy = __builtin_amdgcn_permlane16_swap(cvt_pk_bf16(v0[2], v0[3]), cvt_pk_bf16(v1[2], v1[3]), false, false);
                    u32x4 w; w.x = sx[0]; w.y = sy[0]; w.z = sx[1]; w.w = sy[1];
                    *(u32x4*)(rowp + bj * HALF) = w; } }
    }
};
struct EpiRes {
    const float* Hsrc; float* H; int ldc;
    __device__ __forceinline__ void operator()(const f32x4 (&acc)[2][2][4][2], const Unit& u, int wr, int wc, int fr, int fq) const {
        const int row0 = u.pm * BM + wr * 64 + fr, col0 = u.pn * BM + wc * 32 + 4 * fq;
#pragma unroll
        for (int ai = 0; ai < 2; ++ai) {
            f32x4 r[4][2][2];
#pragma unroll
            for (int m = 0; m < 4; ++m) { const size_t off = (size_t)(row0 + ai * HALF + m * 16) * ldc + col0;
#pragma unroll
                for (int bj = 0; bj < 2; ++bj)
#pragma unroll
                    for (int n = 0; n < 2; ++n) r[m][bj][n] = *(const f32x4*)(Hsrc + off + bj * HALF + n * 16); }
#pragma unroll
            for (int m = 0; m < 4; ++m) { const size_t off = (size_t)(row0 + ai * HALF + m * 16) * ldc + col0;
#pragma unroll
                for (int bj = 0; bj < 2; ++bj)
#pragma unroll
                    for (int n = 0; n < 2; ++n) *(f32x4*)(H + off + bj * HALF + n * 16) = r[m][bj][n] + acc[ai][bj][m][n]; }
        }
    }
};
struct EpiGU {
    bf16_t* Hid; const float* rs;
    __device__ __forceinline__ void operator()(const f32x4 (&acc)[2][2][4][2], const Unit& u, int wr, int wc, int fr, int fq) const {
        const int row0 = u.pm * BM + wr * 64 + fr, col0 = u.pn * HALF + wc * 32 + 8 * (fq >> 1) + 16 * (fq & 1);
        float sc[2][4];
#pragma unroll
        for (int ai = 0; ai < 2; ++ai)
#pragma unroll
            for (int m = 0; m < 4; ++m) sc[ai][m] = rs[row0 + ai * HALF + m * 16];
#pragma unroll
        for (int ai = 0; ai < 2; ++ai)
#pragma unroll
            for (int m = 0; m < 4; ++m) { bf16_t* rowp = Hid + (size_t)(row0 + ai * HALF + m * 16) * DEXP + col0;
                unsigned px[2], py[2];
#pragma unroll
                for (int n = 0; n < 2; ++n) { const f32x4 g = acc[ai][0][m][n] * sc[ai][m], uu = acc[ai][1][m][n] * sc[ai][m]; float h[4];
#pragma unroll
                    for (int j = 0; j < 4; ++j) h[j] = g[j] * __builtin_amdgcn_rcpf(1.0f + __expf(-g[j])) * uu[j];
                    px[n] = cvt_pk_bf16(h[0], h[1]); py[n] = cvt_pk_bf16(h[2], h[3]); }
                const auto sx = __builtin_amdgcn_permlane16_swap(px[0], px[1], false, false);
                const auto sy = __builtin_amdgcn_permlane16_swap(py[0], py[1], false, false);
                u32x4 w; w.x = sx[0]; w.y = sy[0]; w.z = sx[1]; w.w = sy[1];
                *(u32x4*)rowp = w; }
    }
};
struct EpiDown {
    bf16_t* Y; const float* gate;
    __device__ __forceinline__ void operator()(const f32x4 (&acc)[2][2][4][2], const Unit& u, int wr, int wc, int fr, int fq) const {
        const int row0 = u.pm * BM + wr * 64 + fr, col0 = u.pn * BM + wc * 32 + 8 * (fq >> 1) + 16 * (fq & 1);
#pragma unroll
        for (int ai = 0; ai < 2; ++ai)
#pragma unroll
            for (int m = 0; m < 4; ++m) { const int row = row0 + ai * HALF + m * 16; const float gt = gate[row]; bf16_t* rowp = Y + (size_t)row * D + col0;
#pragma unroll
                for (int bj = 0; bj < 2; ++bj) {
                    const f32x4 v0 = acc[ai][bj][m][0] * gt, v1 = acc[ai][bj][m][1] * gt;
                    const auto sx = __builtin_amdgcn_permlane16_swap(cvt_pk_bf16(v0[0], v0[1]), cvt_pk_bf16(v1[0], v1[1]), false, false);
                    const auto sy = __builtin_amdgcn_permlane16_swap(cvt_pk_bf16(v0[2], v0[3]), cvt_pk_bf16(v1[2], v1[3]), false, false);
                    u32x4 w; w.x = sx[0]; w.y = sy[0]; w.z = sx[1]; w.w = sy[1];
                    *(u32x4*)(rowp + bj * HALF) = w; } }
    }
};

template <class Epi, class Sched, bool GATHER = false, bool SP2 = true, bool ALIGN_EPI = true>
__device__ __forceinline__ void gemm_phase(LAS unsigned char* lds, const Gemm g, const Sched& S, const Epi& E) {
    const int tid = opaque_tid(), wid = __builtin_amdgcn_readfirstlane(tid >> 6), lane = tid & 63, wr = wid >> 2, wc = wid & 3, fr = lane & 15, fq = lane >> 4;
    const int K = g.K, nt = K / BK;
    unsigned voffA[2];
#pragma unroll
    for (int i = 0; i < 2; ++i) { int R, C; stage_rc(tid * 16 + i * 8192, R, C); voffA[i] = (unsigned)(R * K + C) * 2u; }
    unsigned gA[2][2], gN[2][2];
#define PG8_GLOAD(dst, pm_) do { if constexpr (GATHER) { int rm_[2][2]; \
        _Pragma("unroll") for (int _h = 0; _h < 2; ++_h) _Pragma("unroll") for (int _i = 0; _i < 2; ++_i) { int R_, C_; stage_rc(tid * 16 + _i * 8192, R_, C_); rm_[_h][_i] = g.rowmap[(pm_) * BM + _h * HALF + R_]; } \
        _Pragma("unroll") for (int _h = 0; _h < 2; ++_h) _Pragma("unroll") for (int _i = 0; _i < 2; ++_i) { int R_, C_; stage_rc(tid * 16 + _i * 8192, R_, C_); dst[_h][_i] = (unsigned)(rm_[_h][_i] * K + C_) * 2u; } } } while (0)
    const size_t kstep = (size_t)(BK * 2);
    const size_t hstep = (size_t)HALF * K * 2;
    const size_t tstep = 2 * hstep;
    const unsigned ldsw = (unsigned)wid * 1024u;
    const int aoff = lds_byte(wr * 64 + fr, fq * 8), boff = lds_byte(wc * 32 + fr, fq * 8);
#define PG8_SA(b, h) (((b) * 2 + (h)) * HTB)
#define PG8_SB(b, h) ((4 + (b) * 2 + (h)) * HTB)
#define PG8_STAGE(bufoff, gbase, voff) do { _Pragma("unroll") for (int _i = 0; _i < 2; ++_i) \
        __builtin_amdgcn_global_load_lds((const unsigned*)((const char*)(gbase) + (voff)[_i]), (LAS unsigned*)(lds + (bufoff) + ldsw + _i * 8192), 16, 0, 0); } while (0)
#define PG8_STAGE_A(bufoff, gbase, half, nextsel) do { if constexpr (GATHER) { unsigned _vo[2]; _Pragma("unroll") for (int _i = 0; _i < 2; ++_i) _vo[_i] = (nextsel) ? gN[half][_i] : gA[half][_i]; PG8_STAGE(bufoff, gbase, _vo); } \
        else { PG8_STAGE(bufoff, (gbase) + (half) * hstep, voffA); } } while (0)
#define PG8_LDA(dst, b, h) do { _Pragma("unroll") for (int m = 0; m < 4; ++m) _Pragma("unroll") for (int k = 0; k < 2; ++k) dst[m][k] = *(const LAS bf16x8*)(lds + PG8_SA(b, h) + aoff + m * 2048 + k * 1024); } while (0)
#define PG8_LDB(dst, b, h) do { _Pragma("unroll") for (int n = 0; n < 2; ++n) _Pragma("unroll") for (int k = 0; k < 2; ++k) dst[n][k] = *(const LAS bf16x8*)(lds + PG8_SB(b, h) + boff + n * 2048 + k * 1024); } while (0)
#define PG8_MMA(ai, bj, At, Bt) do { __builtin_amdgcn_s_setprio(1); _Pragma("unroll") for (int m = 0; m < 4; ++m) _Pragma("unroll") for (int n = 0; n < 2; ++n) _Pragma("unroll") for (int k = 0; k < 2; ++k) \
        acc[ai][bj][m][n] = __builtin_amdgcn_mfma_f32_16x16x32_bf16(Bt[n][k], At[m][k], acc[ai][bj][m][n], 0, 0, 0); __builtin_amdgcn_s_setprio(0); } while (0)
#define PG8_WAIT_V(n) asm volatile("s_waitcnt vmcnt(" #n ")" ::: "memory")
#define PG8_WAIT_L(n) asm volatile("s_waitcnt lgkmcnt(" #n ")" ::: "memory")
#define PG8_BAR __builtin_amdgcn_s_barrier()
#define PG8_SCHED __builtin_amdgcn_sched_barrier(0)
    Unit cur, nxt; int ui = 0;
    if (!S.next(0, cur)) return;
    f32x4 acc[2][2][4][2];
#pragma unroll
    for (int a = 0; a < 2; ++a)
#pragma unroll
        for (int b = 0; b < 2; ++b)
#pragma unroll
            for (int m = 0; m < 4; ++m)
#pragma unroll
                for (int n = 0; n < 2; ++n) acc[a][b][m][n] = (f32x4){0.f, 0.f, 0.f, 0.f};
    bf16x8 At[4][2], B0[2][2], B1[2][2];
    const char* cA = GATHER ? (const char*)g.A : (const char*)g.A + (size_t)cur.pm * tstep; const char* cB = (const char*)g.Bt + (size_t)cur.e * g.ebytes + (size_t)cur.pn * tstep;
    PG8_GLOAD(gA, cur.pm);
    if constexpr (SP2) {
        PG8_STAGE(PG8_SB(0, 0), cB, voffA); PG8_STAGE(PG8_SB(0, 1), cB + hstep, voffA); PG8_STAGE_A(PG8_SA(0, 0), cA, 0, false); PG8_STAGE_A(PG8_SA(0, 1), cA, 1, false);
        if (wr == 1) PG8_BAR;
        PG8_WAIT_V(2); PG8_BAR;
        PG8_STAGE(PG8_SB(1, 0), cB + kstep, voffA); PG8_STAGE_A(PG8_SA(1, 0), cA + kstep, 0, false); PG8_STAGE(PG8_SB(1, 1), cB + hstep + kstep, voffA);
        PG8_WAIT_V(6); PG8_BAR;
    } else {
    PG8_STAGE(PG8_SB(0, 0), cB, voffA); PG8_STAGE_A(PG8_SA(0, 0), cA, 0, false); PG8_STAGE(PG8_SB(0, 1), cB + hstep, voffA); PG8_STAGE_A(PG8_SA(0, 1), cA, 1, false);
    if (wr == 1) PG8_BAR;
    PG8_WAIT_V(4); PG8_BAR;
    PG8_STAGE(PG8_SB(1, 0), cB + kstep, voffA); PG8_STAGE_A(PG8_SA(1, 0), cA + kstep, 0, false); PG8_STAGE(PG8_SB(1, 1), cB + hstep + kstep, voffA);
    PG8_WAIT_V(6); PG8_BAR;
    }
    for (;;) {
        const bool has_next = S.next(ui + 1, nxt);
        const char* nA = GATHER ? cA : (has_next ? (const char*)g.A + (size_t)nxt.pm * tstep : cA); const char* nB = has_next ? (const char*)g.Bt + (size_t)nxt.e * g.ebytes + (size_t)nxt.pn * tstep : cB;
        PG8_GLOAD(gN, nxt.pm);
        for (int t = 0; t < nt; t += 2) {
            const bool last = (t == nt - 2);
            const char* a1 = cA + (size_t)(t + 1) * kstep;
            const char* a2 = last ? nA : cA + (size_t)(t + 2) * kstep; const char* b2 = last ? nB : cB + (size_t)(t + 2) * kstep;
            const char* a3 = a2 + kstep; const char* b3 = b2 + kstep;
            if constexpr (SP2) {
            PG8_LDB(B0, 0, 0); PG8_LDB(B1, 0, 1); PG8_SCHED; PG8_LDA(At, 0, 0); PG8_STAGE_A(PG8_SA(1, 1), a1, 1, false);
            PG8_WAIT_V(8); PG8_WAIT_L(0); PG8_BAR; PG8_MMA(0, 0, At, B0); PG8_MMA(0, 1, At, B1); PG8_BAR; PG8_SCHED;
            PG8_LDA(At, 0, 1); PG8_STAGE(PG8_SB(0, 0), b2, voffA); PG8_STAGE(PG8_SB(0, 1), b2 + hstep, voffA); PG8_STAGE_A(PG8_SA(0, 0), a2, 0, last);
            PG8_WAIT_V(8); PG8_WAIT_L(0); PG8_BAR; PG8_MMA(1, 0, At, B0); PG8_MMA(1, 1, At, B1); PG8_BAR; PG8_SCHED;
            PG8_LDB(B0, 1, 0); PG8_LDB(B1, 1, 1); PG8_SCHED; PG8_LDA(At, 1, 0); PG8_STAGE_A(PG8_SA(0, 1), a2, 1, last);
            PG8_WAIT_V(8); PG8_WAIT_L(0); PG8_BAR; PG8_MMA(0, 0, At, B0); PG8_MMA(0, 1, At, B1); PG8_BAR; PG8_SCHED;
            PG8_LDA(At, 1, 1); PG8_STAGE(PG8_SB(1, 0), b3, voffA); PG8_STAGE(PG8_SB(1, 1), b3 + hstep, voffA); PG8_STAGE_A(PG8_SA(1, 0), a3, 0, last);
            PG8_WAIT_V(8); PG8_WAIT_L(0); PG8_BAR; PG8_MMA(1, 0, At, B0); PG8_MMA(1, 1, At, B1); PG8_BAR; PG8_SCHED;
            } else {
            PG8_LDB(B0, 0, 0); PG8_SCHED; PG8_LDA(At, 0, 0); PG8_STAGE_A(PG8_SA(1, 1), a1, 1, false);
            PG8_WAIT_L(8); PG8_BAR; PG8_WAIT_L(0); PG8_MMA(0, 0, At, B0); PG8_BAR; PG8_SCHED;
            PG8_LDB(B1, 0, 1); PG8_STAGE(PG8_SB(0, 0), b2, voffA);
            PG8_BAR; PG8_WAIT_L(0); PG8_MMA(0, 1, At, B1); PG8_BAR;
            PG8_LDA(At, 0, 1); PG8_STAGE_A(PG8_SA(0, 0), a2, 0, last);
            PG8_BAR; PG8_WAIT_L(0); PG8_MMA(1, 0, At, B0); PG8_BAR; PG8_SCHED;
            PG8_STAGE(PG8_SB(0, 1), b2 + hstep, voffA);
            PG8_WAIT_V(6); PG8_BAR; PG8_MMA(1, 1, At, B1); PG8_BAR;
            PG8_LDB(B0, 1, 0); PG8_SCHED; PG8_LDA(At, 1, 0); PG8_STAGE_A(PG8_SA(0, 1), a2, 1, last);
            PG8_WAIT_L(8); PG8_BAR; PG8_WAIT_L(0); PG8_MMA(0, 0, At, B0); PG8_BAR; PG8_SCHED;
            PG8_LDB(B1, 1, 1); PG8_STAGE(PG8_SB(1, 0), b3, voffA);
            PG8_BAR; PG8_WAIT_L(0); PG8_MMA(0, 1, At, B1); PG8_BAR;
            PG8_LDA(At, 1, 1); PG8_STAGE_A(PG8_SA(1, 0), a3, 0, last);
            PG8_BAR; PG8_WAIT_L(0); PG8_MMA(1, 0, At, B0); PG8_BAR; PG8_SCHED;
            PG8_STAGE(PG8_SB(1, 1), b3 + hstep, voffA);
            PG8_WAIT_V(6); PG8_BAR; PG8_MMA(1, 1, At, B1); PG8_BAR;
            }
        }
        if constexpr (ALIGN_EPI) { if (wr == 0) PG8_BAR; }
        E(acc, cur, wr, wc, fr, fq);
        if (!has_next) break;
#pragma unroll
        for (int a = 0; a < 2; ++a)
#pragma unroll
            for (int b = 0; b < 2; ++b)
#pragma unroll
                for (int m = 0; m < 4; ++m)
#pragma unroll
                    for (int n = 0; n < 2; ++n) acc[a][b][m][n] = (f32x4){0.f, 0.f, 0.f, 0.f};
        cur = nxt; cA = nA; cB = nB; ++ui;
        if constexpr (GATHER) { _Pragma("unroll") for (int _h = 0; _h < 2; ++_h) _Pragma("unroll") for (int _i = 0; _i < 2; ++_i) gA[_h][_i] = gN[_h][_i]; }
        if constexpr (ALIGN_EPI) { if (wr == 1) PG8_BAR; }
    }
    PG8_WAIT_V(0);
    if constexpr (!ALIGN_EPI) { if (wr == 0) PG8_BAR; }
    PG8_BAR;
#undef PG8_SA
#undef PG8_SB
#undef PG8_STAGE
#undef PG8_STAGE_A
#undef PG8_GLOAD
#undef PG8_LDA
#undef PG8_LDB
#undef PG8_MMA
#undef PG8_WAIT_V
#undef PG8_WAIT_L
#undef PG8_BAR
#undef PG8_SCHED
}
}

constexpr int NIN = 39;
constexpr int LDS_STAGE = 131072;
constexpr int LDS_MISC = LDS_STAGE;
constexpr int LDS_BYTES = LDS_STAGE + 1024;
struct Args { const float* in[NIN]; float* out; unsigned char* ws; int ph_lo, ph_hi; };
enum { I_X = 0, I_WIN, I_WOUT, I_NMIX, I_NFFN, I_NFIN, I_HGLB, I_HGNW, I_SCW, I_SCB, I_SDTB, I_SALOG, I_SD, I_SNW, I_RCW, I_RCB, I_RWA, I_RBA, I_RWX, I_RBX, I_RLAM,
       I_WMU, I_WW0, I_WW2, I_WA0, I_WA2, I_WG2, I_WKK, I_WKA, I_WRK, I_WLNW, I_WLNB, I_RGW, I_RGB, I_REW, I_REB, I_MG, I_MU, I_MD };

__device__ __forceinline__ float bf2f(bf16_t x) { return __uint_as_float(((unsigned)x) << 16); }
struct BfPtr {
    const bf16_t* p;
    __device__ __forceinline__ float operator[](long i) const { return bf2f(p[i]); }
    __device__ __forceinline__ BfPtr operator+(long o) const { return BfPtr{p + o}; }
};
struct Frame {
    const float* const* in; float* h; unsigned char* ws; unsigned char* lds;
    int G, bid;
    BfPtr P; bf16_t* Pw; float* Q; float* O; bf16_t* U; bf16_t* MIX; bf16_t* XPERM; bf16_t* HID; bf16_t* Y;
    unsigned* ctl; unsigned char* tab;
};

__device__ __forceinline__ void tconv_tile256(float* sm, const float* __restrict__ src, int N, int k0, int n0, int nlim, bf16_t* dstA, bf16_t* dstB, int K, int tid) {
    {
        const int r = tid >> 6, c4 = (tid & 63) * 4; const int n = n0 + c4;
        f32x4 v[8];
#pragma unroll
        for (int it = 0; it < 8; ++it) { v[it] = (f32x4){0.f, 0.f, 0.f, 0.f}; if (n < nlim) v[it] = *(const f32x4*)(src + (size_t)(k0 + r + 8 * it) * N + n); }
#pragma unroll
        for (int it = 0; it < 8; ++it) *(f32x4*)(sm + (r + 8 * it) * 260 + c4) = v[it];
    }
    __syncthreads();
    {
        const int kq = (tid & 7) * 8;
#pragma unroll
        for (int ps = 0; ps < 4; ++ps) {
            const int n = (tid >> 3) + 64 * ps;
            float v[8];
#pragma unroll
            for (int i = 0; i < 8; ++i) v[i] = sm[(kq + i) * 260 + n];
            u32x4 w; w.x = cvt_pk_bf16(v[0], v[1]); w.y = cvt_pk_bf16(v[2], v[3]); w.z = cvt_pk_bf16(v[4], v[5]); w.w = cvt_pk_bf16(v[6], v[7]);
            bf16_t* dst = (n < 128) ? dstA + (size_t)n * K : dstB + (size_t)(n - 128) * K;
            *(u32x4*)(dst + k0 + kq) = w;
        }
    }
    __syncthreads();
}

constexpr int DEFER_TILES = 1152, DEFER_GEMM = 1536;
__device__ __forceinline__ void conv_down_tile(const Frame& F, int q, int tid_) {
    const int le = q / 128, r = q % 128, kt = r / 8, ntl = r % 8;
    bf16_t* d = (bf16_t*)(F.ws + WS_WD) + ((size_t)le * D + ntl * 256) * DEXP;
    tconv_tile256((float*)F.lds, F.in[I_MD] + (size_t)le * DEXP * D, D, kt * 64, ntl * 256, D, d, d + (size_t)128 * DEXP, DEXP, tid_);
}
__device__ __forceinline__ void phase_prologue(const Frame& F) {
    const int tid_ = opaque_tid();
    float* sm = (float*)F.lds;
    constexpr int T_IN = 2 * 32 * 26, T_OUT = 2 * 32 * 8, T_G = 64 * 32 * 4, T_D = 64 * 16 * 8;
    constexpr int T_ALL = T_IN + T_OUT + 2 * T_G + T_D;
    for (int t = F.bid; t < T_ALL - DEFER_TILES - DEFER_GEMM; t += F.G) {
        if (t < T_IN) {
            const int l = t / (32 * 26), r = t % (32 * 26), kt = r / 26, ntl = r % 26;
            bf16_t* d = (bf16_t*)(F.ws + WS_WIN) + ((size_t)l * PS + ntl * 256) * D;
            tconv_tile256(sm, F.in[I_WIN] + (size_t)l * D * IN_COLS, IN_COLS, kt * 64, ntl * 256, IN_COLS, d, d + (size_t)128 * D, D, tid_);
        } else if (t < T_IN + T_OUT) {
            const int q = t - T_IN; const int l = q / 256, r = q % 256, kt = r / 8, ntl = r % 8;
            bf16_t* d = (bf16_t*)(F.ws + WS_WOUT) + ((size_t)l * D + ntl * 256) * D;
            tconv_tile256(sm, F.in[I_WOUT] + (size_t)l * D * D, D, kt * 64, ntl * 256, D, d, d + (size_t)128 * D, D, tid_);
        } else if (t < T_IN + T_OUT + 2 * T_G) {
            int q = t - T_IN - T_OUT; const int sgu = q / T_G; q %= T_G;
            const int le = q / 128, r = q % 128, kt = r / 4, ntl = r % 4;
            const int n0 = ntl * 256;
            bf16_t* d = (bf16_t*)(F.ws + WS_WGU) + ((size_t)le * 2048 + 256 * (n0 >> 7) + 128 * sgu) * D;
            tconv_tile256(sm, F.in[sgu ? I_MU : I_MG] + (size_t)le * D * DEXP, DEXP, kt * 64, n0, DEXP, d, d + (size_t)256 * D, D, tid_);
        } else {
            conv_down_tile(F, t - T_IN - T_OUT - 2 * T_G, tid_);
        }
    }
    for (int e = F.bid * 512 + tid_; e < 2 * 48 * 2048; e += F.G * 512) {
        const int l = e / (48 * 2048), c = (e / 2048) % 48, k = e % 2048;
        float v = 0.f;
        if (c < 4) v = F.in[I_RGW][((size_t)l * D + k) * 4 + c]; else if (c < 36) v = F.in[I_REW][((size_t)l * D + k) * 32 + (c - 4)];
        ((float*)(F.ws + WS_WRT))[e] = v * F.in[I_NFFN][(size_t)l * D + k];
    }
    for (int e = F.bid * 512 + tid_; e < 2 * 294912; e += F.G * 512) {
        const int l = e / 294912; int r = e % 294912;
        bf16_t* sw = (bf16_t*)(F.ws + WS_SW + (size_t)l * SW_LAYER);
        int K, n, k, base;
        if (r < 49152) { base = SW_W2T / 2; K = 96; } else if (r < 98304) { r -= 49152; base = SW_A2T / 2; K = 96; } else if (r < 229376) { r -= 98304; base = SW_G2T / 2; K = 256; }
        else if (r < 262144) { r -= 229376; base = SW_WAT / 2; K = 64; } else { r -= 262144; base = SW_WXT / 2; K = 64; }
        { const int j = r & 7, ln = (r >> 3) & 63, blk = r >> 9, KS = K / 32, nt = blk / KS, ks = blk % KS; n = nt * 16 + (ln & 15); k = ks * 32 + (ln >> 4) * 8 + j; }
        float v;
        if (base == (int)(SW_W2T / 2)) v = F.in[I_WW2][((size_t)l * 96 + k) * GW + n];
        else if (base == (int)(SW_A2T / 2)) v = F.in[I_WA2][((size_t)l * 96 + k) * GW + n];
        else if (base == (int)(SW_G2T / 2)) v = F.in[I_WG2][((size_t)l * 256 + k) * GW + n];
        else if (base == (int)(SW_WAT / 2)) v = F.in[I_RWA][(((size_t)l * 8 + (n >> 6)) * 64 + k) * 64 + (n & 63)];
        else v = F.in[I_RWX][(((size_t)l * 8 + (n >> 6)) * 64 + k) * 64 + (n & 63)];
        sw[base + r] = f2bf(v);
    }
}

__device__ __forceinline__ void phase_norm1(const Frame& F, int mode, const float* __restrict__ w) {
    const int tid_ = opaque_tid(); const int lane_ = tid_ & 63; const int wave_ = __builtin_amdgcn_readfirstlane(tid_ >> 6); (void)lane_; (void)wave_;
    const int gw = F.bid * 8 + wave_, nw = F.G * 8;
    const int* tokslot = (const int*)(F.tab + TAB_TOKSLOT);
    for (int t = gw; t < NTOK; t += nw) {
        float4 v[8];
        const float* src = (mode == 0) ? F.in[I_X] : F.h;
#pragma unroll
        for (int j = 0; j < 8; ++j) v[j] = *(const float4*)(src + (size_t)t * D + 4 * (lane_ + 64 * j));
        if (mode != 0) {
            const int s0 = tokslot[2 * t], s1 = tokslot[2 * t + 1];
#pragma unroll
            for (int j = 0; j < 8; ++j) {
                const u32x2 pa = *(const u32x2*)(F.Y + (size_t)s0 * D + 4 * (lane_ + 64 * j));
                const u32x2 pb = *(const u32x2*)(F.Y + (size_t)s1 * D + 4 * (lane_ + 64 * j));
                v[j].x += __uint_as_float(pa.x << 16) + __uint_as_float(pb.x << 16); v[j].y += __uint_as_float(pa.x & 0xffff0000u) + __uint_as_float(pb.x & 0xffff0000u);
                v[j].z += __uint_as_float(pa.y << 16) + __uint_as_float(pb.y << 16); v[j].w += __uint_as_float(pa.y & 0xffff0000u) + __uint_as_float(pb.y & 0xffff0000u);
            }
        }
        float ss = 0.f;
#pragma unroll
        for (int j = 0; j < 8; ++j) ss += v[j].x * v[j].x + v[j].y * v[j].y + v[j].z * v[j].z + v[j].w * v[j].w;
        ss = wave_sum(ss);
        const float rs = rsqrtf(ss * (1.0f / D) + NORM_EPS);
#pragma unroll
        for (int j = 0; j < 8; ++j) {
            const int c = 4 * (lane_ + 64 * j);
            const float4 wv = *(const float4*)(w + c);
            if (mode == 2) {
                float4 o; o.x = v[j].x * rs * wv.x; o.y = v[j].y * rs * wv.y; o.z = v[j].z * rs * wv.z; o.w = v[j].w * rs * wv.w;
                *(float4*)(F.h + (size_t)t * D + c) = o;
            } else {
                if (mode != 0) *(float4*)(F.h + (size_t)t * D + c) = v[j];
                u32x2 p; p.x = cvt_pk_bf16(v[j].x * rs * wv.x, v[j].y * rs * wv.y); p.y = cvt_pk_bf16(v[j].z * rs * wv.z, v[j].w * rs * wv.w);
                *(u32x2*)(F.U + (size_t)t * D + c) = p;
            }
        }
    }
}


template <int K>
__device__ __forceinline__ f32x4 mma16(const bf16_t* A, int lda, const bf16_t* Bt, int ldb, int lane, f32x4 acc);
__device__ __forceinline__ u32x4 pack8(const float (&v)[8]);
__device__ __forceinline__ float bflo(unsigned u) { return __uint_as_float(u << 16); }
__device__ __forceinline__ float bfhi(unsigned u) { return __uint_as_float(u & 0xffff0000u); }
__device__ __forceinline__ float bfel(const u32x4 r, int e) { const unsigned u = (e < 2) ? r.x : (e < 4) ? r.y : (e < 6) ? r.z : r.w; return (e & 1) ? bfhi(u) : bflo(u); }
__device__ __forceinline__ void pre_steps14(const Frame& F, int l, int ch) {
    const int tid = opaque_tid();
    bf16_t* XB = (bf16_t*)F.lds;
    bf16_t* AW = (bf16_t*)(F.lds + 66560);
    bf16_t* AA = (bf16_t*)(F.lds + 79872);
    bf16_t* AG = (bf16_t*)(F.lds + 93184);
    const size_t t0 = (size_t)ch * 64; const bool has_prev = (ch & 63) != 0;
    const bf16_t* Pb = F.P.p;
    const u32x4 zero4 = {0u, 0u, 0u, 0u};
    const int tsG = tid >> 6, tsW = tid / 56, j0W = 8 * (tid % 56);
    u32x4 rawG[11], rawW[9];
#pragma unroll
    for (int i = 0; i < 11; ++i) { const int tok = tsG * 8 - 3 + i; rawG[i] = (tok >= 0 || has_prev) ? *(const u32x4*)(Pb + (long)((long)t0 + tok) * PS + C_RG_X + 8 * (tid & 63)) : zero4; }
    if (tid < 448) {
#pragma unroll
        for (int i = 0; i < 9; ++i) { const int tok = tsW * 8 - 1 + i; rawW[i] = (tok >= 0 || has_prev) ? *(const u32x4*)(Pb + (long)((long)t0 + tok) * PS + C_RW + 1536 + j0W) : zero4; }
    }
    {
        const int c0 = 8 * (tid & 127), tq = tid >> 7;
        const float* scw = F.in[I_SCW] + (size_t)l * 4 * 1024 + c0; const float* scb = F.in[I_SCB] + (size_t)l * 1024 + c0;
        u32x4 raw[19];
#pragma unroll
        for (int i = 0; i < 19; ++i) { const int tok = tq * 16 - 3 + i; raw[i] = (tok >= 0 || has_prev) ? *(const u32x4*)(Pb + (long)((long)t0 + tok) * PS + C_SS_X + c0) : zero4; }
        float cw[4][8], cb[8];
#pragma unroll
        for (int k = 0; k < 4; ++k) { const f32x4 a = *(const f32x4*)(scw + k * 1024), b = *(const f32x4*)(scw + k * 1024 + 4);
#pragma unroll
            for (int e = 0; e < 4; ++e) { cw[k][e] = a[e]; cw[k][4 + e] = b[e]; } }
        { const f32x4 a = *(const f32x4*)(scb), b = *(const f32x4*)(scb + 4);
#pragma unroll
            for (int e = 0; e < 4; ++e) { cb[e] = a[e]; cb[4 + e] = b[e]; } }
#pragma unroll
        for (int t = 0; t < 16; ++t) {
            float o[8];
#pragma unroll
            for (int e = 0; e < 8; ++e) o[e] = silu_f(cb[e] + cw[3][e] * bfel(raw[t + 3], e) + cw[2][e] * bfel(raw[t + 2], e) + cw[1][e] * bfel(raw[t + 1], e) + cw[0][e] * bfel(raw[t], e));
            *(u32x4*)((bf16_t*)(F.Q + (t0 + tq * 16 + t) * QS) + c0) = pack8(o);
        }
    }
    {
        const int c0 = 8 * (tid & 63);
        const float* rcw = F.in[I_RCW] + (size_t)l * 4 * GW + c0; const float* rcb = F.in[I_RCB] + (size_t)l * GW + c0;
        float cw[4][8], cb[8];
#pragma unroll
        for (int k = 0; k < 4; ++k) { const f32x4 a = *(const f32x4*)(rcw + k * GW), b = *(const f32x4*)(rcw + k * GW + 4);
#pragma unroll
            for (int e = 0; e < 4; ++e) { cw[k][e] = a[e]; cw[k][4 + e] = b[e]; } }
        { const f32x4 a = *(const f32x4*)(rcb), b = *(const f32x4*)(rcb + 4);
#pragma unroll
            for (int e = 0; e < 4; ++e) { cb[e] = a[e]; cb[4 + e] = b[e]; } }
#pragma unroll
        for (int t = 0; t < 8; ++t) {
            float o[8];
#pragma unroll
            for (int e = 0; e < 8; ++e) o[e] = cb[e] + cw[3][e] * bfel(rawG[t + 3], e) + cw[2][e] * bfel(rawG[t + 2], e) + cw[1][e] * bfel(rawG[t + 1], e) + cw[0][e] * bfel(rawG[t], e);
            *(u32x4*)(XB + (tsG * 8 + t) * 520 + c0) = pack8(o);
        }
    }
    if (tid < 448) {
        const int ts = tsW, j0 = j0W;
        const float* mu = F.in[I_WMU] + (size_t)l * RW_COLS + 1536 + j0;
        float m8[8];
        { const f32x4 a = *(const f32x4*)(mu), b = *(const f32x4*)(mu + 4);
#pragma unroll
            for (int e = 0; e < 4; ++e) { m8[e] = a[e]; m8[4 + e] = b[e]; } }
#pragma unroll
        for (int t = 0; t < 8; ++t) {
            float o[8];
#pragma unroll
            for (int e = 0; e < 8; ++e) { const float cur = bfel(rawW[t + 1], e), prev = bfel(rawW[t], e); const float v = cur + (prev - cur) * m8[e]; o[e] = (j0 < 96) ? ftanh(v) : (j0 < 192) ? v : sigmoid_f(v); }
            const int tt = ts * 8 + t;
            bf16_t* dst = (j0 < 96) ? AW + tt * 104 + j0 : (j0 < 192) ? AA + tt * 104 + (j0 - 96) : AG + tt * 264 + (j0 - 192);
            *(u32x4*)dst = pack8(o);
        }
    }
}
template <int KS>
__device__ __forceinline__ f32x4 mma16f(const bf16_t* A, int lda, const bf16_t* Bf, int lane, f32x4 acc) {
    const bf16_t* ap = A + (lane & 15) * lda + (lane >> 4) * 8; const bf16_t* bp = Bf + lane * 8;
#pragma unroll
    for (int ks = 0; ks < KS; ++ks) { const bf16x8 a = *(const bf16x8*)(ap + ks * 32); const bf16x8 b = *(const bf16x8*)(bp + ks * 512); acc = __builtin_amdgcn_mfma_f32_16x16x32_bf16(a, b, acc, 0, 0, 0); }
    return acc;
}
template <int KS>
__device__ __forceinline__ f32x4 mma16p(const bf16_t* A, int lda, const bf16x8* f, int lane, f32x4 acc) {
    const bf16_t* ap = A + (lane & 15) * lda + (lane >> 4) * 8;
#pragma unroll
    for (int ks = 0; ks < KS; ++ks) { const bf16x8 a = *(const bf16x8*)(ap + ks * 32); acc = __builtin_amdgcn_mfma_f32_16x16x32_bf16(a, f[ks], acc, 0, 0, 0); }
    return acc;
}
__device__ __forceinline__ void store_pair(float* base, int q, int cl, int jj, float va, float vb) {
    const auto sw = __builtin_amdgcn_permlane32_swap(__float_as_uint(va), __float_as_uint(vb), false, false);
    const bool lo = q < 2; const int qq = q & 1, ch = lo ? cl : 16 + cl;
    base[(size_t)(4 * qq + jj) * QS + ch] = __uint_as_float(sw[0]);
    base[(size_t)(4 * (qq + 2) + jj) * QS + ch] = __uint_as_float(sw[1]);
}
__device__ __forceinline__ void pre_5a(const Frame& F, int l, int ch) {
    const int j = opaque_tid(); const int lane = j & 63; const int w = __builtin_amdgcn_readfirstlane(j >> 6);
    bf16_t* XB = (bf16_t*)F.lds;
    bf16_t* AW = (bf16_t*)(F.lds + 66560);
    bf16_t* AA = (bf16_t*)(F.lds + 79872);
    bf16_t* AG = (bf16_t*)(F.lds + 93184);
    const bf16_t* sw = (const bf16_t*)(F.ws + WS_SW + (size_t)l * SW_LAYER);
    const bf16_t* W2T = sw + SW_W2T / 2; const bf16_t* A2T = sw + SW_A2T / 2; const bf16_t* G2T = sw + SW_G2T / 2; const bf16_t* WAT = sw + SW_WAT / 2; const bf16_t* WXT = sw + SW_WXT / 2;
    float lb = 0.f;
    if (l > 0) { const float p0 = F.in[I_HGLB][j], p1 = F.in[I_HGLB][GW + j]; const float m = fmaxf(p0, p1); const float e0 = fexp(p0 - m), e1 = fexp(p1 - m); lb = e1 / (e0 + e1); }
    const float* scw = F.in[I_SCW] + (size_t)l * 4 * 1024; const float* scb = F.in[I_SCB] + (size_t)l * 1024;
    const float* rcw = F.in[I_RCW] + (size_t)l * 4 * GW; const float* rcb = F.in[I_RCB] + (size_t)l * GW;
    const float* mu = F.in[I_WMU] + (size_t)l * RW_COLS;
        const size_t t0 = (size_t)ch * 64;
        const f32x4 z4 = (f32x4){0.f, 0.f, 0.f, 0.f};
        const int cl = lane & 15, rq = 4 * (lane >> 4);
#ifndef SKIP_5A
        {
            int l5 = l; asm volatile("" : "+s"(l5));
            float ba[4], bx[4], spl[4];
#pragma unroll
            for (int n = 0; n < 4; ++n) { const int c = w * 64 + n * 16 + cl; ba[n] = F.in[I_RBA][l5 * GW + c]; bx[n] = F.in[I_RBX][l5 * GW + c]; spl[n] = softplus_f(-F.in[I_RLAM][l5 * GW + c]); }
#pragma unroll
            for (int m = 0; m < 4; ++m)
#pragma unroll
                for (int np = 0; np < 2; ++np) {
                    float av[2][4], uv[2][4];
#pragma unroll
                    for (int h2 = 0; h2 < 2; ++h2) {
                        const int n = 2 * np + h2, c = w * 64 + n * 16 + cl;
                        const f32x4 ra = mma16f<2>(XB + m * 16 * 520 + w * 64, 520, WAT + ((w * 4 + n) * 2) * 512, lane, z4);
                        const f32x4 ri = mma16f<2>(XB + m * 16 * 520 + w * 64, 520, WXT + ((w * 4 + n) * 2) * 512, lane, z4);
#pragma unroll
                        for (int jj = 0; jj < 4; ++jj) {
                            const int t = m * 16 + rq + jj;
                            const float r = sigmoid_f(ra[jj] + ba[n]), ii = sigmoid_f(ri[jj] + bx[n]);
                            const float la = -8.0f * r * spl[n]; av[h2][jj] = fexp(la);
                            uv[h2][jj] = __builtin_amdgcn_sqrtf(1.0f - fexp(2.0f * la)) * (ii * bf2f(XB[t * 520 + c]));
                        }
                    }
                    float* qb = F.Q + (t0 + m * 16) * QS + w * 64 + np * 32;
#pragma unroll
                    for (int jj = 0; jj < 4; ++jj) { store_pair(qb + Q_RGA, lane >> 4, cl, jj, av[0][jj], av[1][jj]); store_pair(qb + Q_RGU, lane >> 4, cl, jj, uv[0][jj], uv[1][jj]); }
                }
        }
#endif
}
__device__ __forceinline__ void pre_5b(const Frame& F, int l, int ch) {
    const int j = opaque_tid(); const int lane = j & 63; const int w = __builtin_amdgcn_readfirstlane(j >> 6);
    bf16_t* XB = (bf16_t*)F.lds;
    bf16_t* AW = (bf16_t*)(F.lds + 66560);
    bf16_t* AA = (bf16_t*)(F.lds + 79872);
    bf16_t* AG = (bf16_t*)(F.lds + 93184);
    const bf16_t* sw = (const bf16_t*)(F.ws + WS_SW + (size_t)l * SW_LAYER);
    const bf16_t* W2T = sw + SW_W2T / 2; const bf16_t* A2T = sw + SW_A2T / 2; const bf16_t* G2T = sw + SW_G2T / 2; const bf16_t* WAT = sw + SW_WAT / 2; const bf16_t* WXT = sw + SW_WXT / 2;
    float lb = 0.f;
    if (l > 0) { const float p0 = F.in[I_HGLB][j], p1 = F.in[I_HGLB][GW + j]; const float m = fmaxf(p0, p1); const float e0 = fexp(p0 - m), e1 = fexp(p1 - m); lb = e1 / (e0 + e1); }
    const float* scw = F.in[I_SCW] + (size_t)l * 4 * 1024; const float* scb = F.in[I_SCB] + (size_t)l * 1024;
    const float* rcw = F.in[I_RCW] + (size_t)l * 4 * GW; const float* rcb = F.in[I_RCB] + (size_t)l * GW;
    const float* mu = F.in[I_WMU] + (size_t)l * RW_COLS;
        const size_t t0 = (size_t)ch * 64;
        const f32x4 z4 = (f32x4){0.f, 0.f, 0.f, 0.f};
        const int cl = lane & 15, rq = 4 * (lane >> 4);
#ifndef SKIP_5B
        {
            int l5 = l; asm volatile("" : "+s"(l5));
            const float* mu5 = F.in[I_WMU] + (size_t)l5 * RW_COLS;
            float kkc[4], mk[4];
#pragma unroll
            for (int n = 0; n < 4; ++n) { const int c = w * 64 + n * 16 + cl; kkc[n] = F.in[I_WKK][l5 * GW + c]; mk[n] = mu5[512 + c]; }
#define PRE5B_LOADW(dst, n_) do { const bf16_t* b2_ = W2T + ((w * 4 + (n_)) * 3) * 512 + lane * 8; \
        _Pragma("unroll") for (int ks_ = 0; ks_ < 3; ++ks_) dst[ks_] = *(const bf16x8*)(b2_ + ks_ * 512); } while (0)
#define PRE5B_LOADA(dst, n_) do { const bf16_t* ba_ = A2T + ((w * 4 + (n_)) * 3) * 512 + lane * 8; \
        _Pragma("unroll") for (int ks_ = 0; ks_ < 3; ++ks_) dst[ks_] = *(const bf16x8*)(ba_ + ks_ * 512); } while (0)
#define PRE5B_LOADG(dst, n_) do { const bf16_t* bg_ = G2T + ((w * 4 + (n_)) * 8) * 512 + lane * 8; \
        _Pragma("unroll") for (int ks_ = 0; ks_ < 8; ++ks_) dst[ks_] = *(const bf16x8*)(bg_ + ks_ * 512); } while (0)
            for (int m = 0; m < 4; ++m) {
                {
                    bf16_t* stg = (bf16_t*)F.lds + w * 4096;
                    const size_t trow0 = t0 + m * 16;
                    const bool hp0 = ((trow0 & (SEQ - 1)) != 0);
#pragma unroll
                    for (int it = 0; it < 7; ++it) {
                        const int seg = it * 8 + (lane >> 3);
                        if (seg < 51) {
                            const int row = seg / 3, grp = seg - row * 3;
                            u32x4 v = {0u, 0u, 0u, 0u};
                            if (row > 0 || hp0) v = *(const u32x4*)(F.P.p + (long)((long)trow0 - 1 + row) * PS + C_RW + grp * 512 + w * 64 + (lane & 7) * 8);
                            *(u32x4*)(stg + row * 196 + grp * 64 + (lane & 7) * 8) = v;
                        }
                    }
                }
                const bf16_t* spb = (const bf16_t*)F.lds + w * 4096 + rq * 196 + cl;
                bf16x8 wa0[3]; PRE5B_LOADW(wa0, 0);
                float inv[4];
                {
                    float ssq[4] = {0.f, 0.f, 0.f, 0.f};
#pragma unroll
                    for (int n = 0; n < 4; ++n) { float kp = bf2f(spb[n * 16 + 64]);
#pragma unroll
                        for (int jj = 0; jj < 4; ++jj) { const float kc = bf2f(spb[(jj + 1) * 196 + n * 16 + 64]); const float x = (kc + (kp - kc) * mk[n]) * kkc[n]; ssq[jj] += x * x; kp = kc; } }
#pragma unroll
                    for (int jj = 0; jj < 4; ++jj) inv[jj] = frcp(fmaxf(__builtin_amdgcn_sqrtf(row16_sum(ssq[jj])), 1e-12f));
                }
#define PRE5B_TILE(n, wac, wan, more) do { const int c = w * 64 + (n) * 16 + cl; bf16x8 fa[3], fg[8]; PRE5B_LOADA(fa, n); PRE5B_LOADG(fg, n); \
        const f32x4 ws = mma16p<3>(AW + m * 16 * 104, 104, wac, lane, z4); \
        if (more) PRE5B_LOADW(wan, (n) + 1); \
        const f32x4 as = mma16p<3>(AA + m * 16 * 104, 104, fa, lane, z4); \
        __builtin_amdgcn_sched_barrier(0); \
        f32x4 gs = mma16p<4>(AG + m * 16 * 264, 264, fg, lane, z4); \
        __builtin_amdgcn_sched_barrier(0); \
        gs = mma16p<4>(AG + m * 16 * 264 + 128, 264, fg + 4, lane, gs); \
        __builtin_amdgcn_sched_barrier(0); \
        const float w0n = F.in[I_WW0][l5 * GW + c], a0n = F.in[I_WA0][l5 * GW + c], kan = F.in[I_WKA][l5 * GW + c]; \
        const bf16_t* spk = (const bf16_t*)F.lds + w * 4096 + rq * 196 + 64 + (n) * 16 + cl; float kprev = bf2f(spk[0]); \
        _Pragma("unroll") for (int jj = 0; jj < 4; ++jj) { \
            const float kcur = bf2f(spk[(jj + 1) * 196]); const float k0v = kcur + (kprev - kcur) * mk[n]; kprev = kcur; \
            const float wlog = -softplus_f(-(w0n + ws[jj])) - 0.5f; const float decay = fexp(-fexp(wlog)); const float a = sigmoid_f(a0n + as[jj]); \
            const float kk = k0v * kkc[n] * inv[jj]; const float k = k0v * (1.0f + (a - 1.0f) * kan); \
            float* q = F.Q + (t0 + m * 16 + rq + jj) * QS; \
            q[Q_W + c] = decay; q[Q_K + c] = k; q[Q_KKA + c] = kk * a; q[Q_G + c] = gs[jj]; } } while (0)
                {
                    bf16x8 wa1[3];
                    PRE5B_TILE(0, wa0, wa1, true);
                    PRE5B_TILE(1, wa1, wa0, true);
                    PRE5B_TILE(2, wa0, wa1, true);
                    PRE5B_TILE(3, wa1, wa0, false);
                }
#undef PRE5B_TILE
            }
#undef PRE5B_LOADW
#undef PRE5B_LOADA
#undef PRE5B_LOADG
        }
#endif
}
__device__ __forceinline__ void phase_pre(const Frame& F, int l) {
    for (int ch = F.bid; ch < NTOK / 64; ch += F.G) { pre_steps14(F, l, ch); __syncthreads(); pre_5a(F, l, ch); pre_5b(F, l, ch); __syncthreads(); }
}


template <int K>
__device__ __forceinline__ f32x4 mma16(const bf16_t* A, int lda, const bf16_t* Bt, int ldb, int lane, f32x4 acc) {
    const int r = lane & 15, kq = (lane >> 4) * 8;
    const bf16_t* ap = A + r * lda + kq; const bf16_t* bp = Bt + r * ldb + kq;
#pragma unroll
    for (int k0 = 0; k0 < K; k0 += 32) {
        const bf16x8 a = *(const bf16x8*)(ap + k0); const bf16x8 b = *(const bf16x8*)(bp + k0);
        acc = __builtin_amdgcn_mfma_f32_16x16x32_bf16(a, b, acc, 0, 0, 0);
    }
    return acc;
}
__device__ __forceinline__ float wave_scan_incl(float v, int lane) {
#pragma unroll
    for (int o = 1; o < 64; o <<= 1) { const float u = __shfl_up(v, o); if (lane >= o) v += u; }
    return v;
}

__device__ __forceinline__ void rg_local(const Frame& F, int u, int tid) {
    const int b = u >> 6, c = u & 63; const size_t t0 = (size_t)b * SEQ + c * 64;
    float* rgc = (float*)(F.ws + WS_R4 + R4_RGC);
    float ap = 1.f, h = 0.f;
#pragma unroll 1
    for (int tb = 0; tb < 64; tb += 32) {
        float a[32], uu[32];
#pragma unroll
        for (int i = 0; i < 32; ++i) { a[i] = F.Q[(t0 + tb + i) * QS + Q_RGA + tid]; uu[i] = F.Q[(t0 + tb + i) * QS + Q_RGU + tid]; }
#pragma unroll
        for (int i = 0; i < 32; ++i) { h = a[i] * h + uu[i]; ap *= a[i]; }
    }
    rgc[((size_t)u * 512 + tid) * 2] = ap; rgc[((size_t)u * 512 + tid) * 2 + 1] = h;
}
__device__ __forceinline__ void rg_scan(const Frame& F, int e) {
    const int b = e >> 9, j = e & 511;
    float* rgc = (float*)(F.ws + WS_R4 + R4_RGC);
    float h = 0.f;
    for (int c = 0; c < 64; ++c) { float* p = rgc + ((size_t)(b * 64 + c) * 512 + j) * 2; const float ap = p[0], he = p[1]; p[1] = h; h = ap * h + he; }
}
__device__ __forceinline__ void rg_out(const Frame& F, int u, int tid) {
    const int b = u >> 6, c = u & 63; const size_t t0 = (size_t)b * SEQ + c * 64;
    const float* rgc = (const float*)(F.ws + WS_R4 + R4_RGC);
    float h = rgc[((size_t)u * 512 + tid) * 2 + 1];
#pragma unroll 1
    for (int tb = 0; tb < 64; tb += 32) {
        float a[32], uu[32], gt[32];
#pragma unroll
        for (int i = 0; i < 32; ++i) { a[i] = F.Q[(t0 + tb + i) * QS + Q_RGA + tid]; uu[i] = F.Q[(t0 + tb + i) * QS + Q_RGU + tid]; gt[i] = F.P[(t0 + tb + i) * PS + C_RG_G + tid]; }
#pragma unroll
        for (int i = 0; i < 32; ++i) { h = a[i] * h + uu[i]; F.MIX[(t0 + tb + i) * D + 1024 + tid] = f2bf(h * gelu_tanh_f(gt[i])); }
    }
}

__device__ __forceinline__ void ssd_acum(const Frame& F, int l, size_t t0, int g, float* acum, int tid) {
    const int lane = tid & 63, w = tid >> 6;
    if (w < 4) {
        const int head = 4 * g + w;
        const float A = -fexp(F.in[I_SALOG][l * 8 + head]);
        const float dtv = softplus_f(F.P[(t0 + lane) * PS + C_SS_DT + head] + F.in[I_SDTB][l * 8 + head]);
        acum[256 + w * 64 + lane] = dtv;
        acum[w * 64 + lane] = wave_scan_incl(dtv * A, lane);
    }
}
__device__ __forceinline__ void ssd_local(const Frame& F, int l, int u, int tid) {
    const int g = u & 1, c = (u >> 1) & 63, b = u >> 7; const size_t t0 = (size_t)b * SEQ + c * 64;
    const int lane = tid & 63, w = __builtin_amdgcn_readfirstlane(tid >> 6);
    float* acum = (float*)F.lds;
    bf16_t* BmT = (bf16_t*)(F.lds + 2048);
    bf16_t* XW = (bf16_t*)(F.lds + 2048 + 18432);
    ssd_acum(F, l, t0, g, acum, tid);
    LDS_BARRIER();
    if (tid < 256) {
        const int hh = tid >> 6, p = tid & 63, head = 4 * g + hh;
        const float aend = acum[hh * 64 + 63];
#pragma unroll
        for (int l8 = 0; l8 < 8; ++l8) {
            float v[8];
#pragma unroll
            for (int i = 0; i < 8; ++i) { const int tt = l8 * 8 + i; const float x = bf2f(((const bf16_t*)(F.Q + (t0 + tt) * QS))[head * 64 + p]); const float dtv = acum[256 + hh * 64 + tt];
                v[i] = x * dtv * fexp(aend - acum[hh * 64 + tt]); }
            u32x4 pk; pk.x = cvt_pk_bf16(v[0], v[1]); pk.y = cvt_pk_bf16(v[2], v[3]); pk.z = cvt_pk_bf16(v[4], v[5]); pk.w = cvt_pk_bf16(v[6], v[7]);
            *(u32x4*)(XW + (hh * 64 + p) * 72 + l8 * 8) = pk;
        }
    } else {
        const int n = tid & 127, lh = (tid - 256) >> 7;
#pragma unroll
        for (int l8 = 0; l8 < 4; ++l8) {
            float v[8];
#pragma unroll
            for (int i = 0; i < 8; ++i) { const int tt = lh * 32 + l8 * 8 + i; v[i] = bf2f(((const bf16_t*)(F.Q + (t0 + tt) * QS))[512 + g * 128 + n]); }
            u32x4 pk; pk.x = cvt_pk_bf16(v[0], v[1]); pk.y = cvt_pk_bf16(v[2], v[3]); pk.z = cvt_pk_bf16(v[4], v[5]); pk.w = cvt_pk_bf16(v[6], v[7]);
            *(u32x4*)(BmT + n * 72 + lh * 32 + l8 * 8) = pk;
        }
    }
    LDS_BARRIER();
    {
        const int hh = w >> 1, head = 4 * g + hh;
        bf16_t* dst = (bf16_t*)(F.ws + WS_R4 + R4_SSS) + ((size_t)(b * 8 + head) * 64 + c) * 8192;
#pragma unroll
        for (int pi = 0; pi < 4; ++pi)
#pragma unroll
            for (int nn = 0; nn < 4; ++nn) {
                const int ni = (w & 1) * 4 + nn;
                const f32x4 acc = mma16<64>(BmT + ni * 16 * 72, 72, XW + (hh * 64 + pi * 16) * 72, 72, lane, (f32x4){0.f, 0.f, 0.f, 0.f});
                u32x2 pk; pk.x = cvt_pk_bf16(acc[0], acc[1]); pk.y = cvt_pk_bf16(acc[2], acc[3]);
                *(u32x2*)(dst + (pi * 16 + (lane & 15)) * 128 + ni * 16 + 4 * (lane >> 4)) = pk;
            }
        if (tid < 4) ((float*)(F.ws + WS_R4 + R4_SSD))[(size_t)(b * 8 + 4 * g + tid) * 64 + c] = fexp(acum[tid * 64 + 63]);
    }
    LDS_BARRIER();
}
__device__ __forceinline__ void ssd_scan(const Frame& F, int e) {
    const int bh = e >> 13, r = e & 8191;
    bf16_t* st = (bf16_t*)(F.ws + WS_R4 + R4_SSS) + (size_t)bh * 64 * 8192 + r; const float* dec = (const float*)(F.ws + WS_R4 + R4_SSD) + bh * 64;
    float h = 0.f;
    for (int c0 = 0; c0 < 64; c0 += 16) {
        float tmp[16], dd[16];
#pragma unroll
        for (int i = 0; i < 16; ++i) { tmp[i] = bf2f(st[(size_t)(c0 + i) * 8192]); dd[i] = dec[c0 + i]; }
#pragma unroll
        for (int i = 0; i < 16; ++i) { st[(size_t)(c0 + i) * 8192] = f2bf(h); h = h * dd[i] + tmp[i]; }
    }
}
__device__ __forceinline__ void ssd_out(const Frame& F, int l, int u, int tid) {
    const int g = u & 1, c = (u >> 1) & 63, b = u >> 7; const size_t t0 = (size_t)b * SEQ + c * 64;
    const int lane = tid & 63, w = __builtin_amdgcn_readfirstlane(tid >> 6);
    float* acum = (float*)F.lds;
    bf16_t* Cm = (bf16_t*)(F.lds + 2048);
    bf16_t* Bm = (bf16_t*)(F.lds + 19456);
    bf16_t* XT = (bf16_t*)(F.lds + 36864);
    bf16_t* PV = (bf16_t*)(F.lds + 46080);
    bf16_t* Mh = (bf16_t*)(F.lds + 63488);
    bf16_t* XS = (bf16_t*)(F.lds + 72704);
    ssd_acum(F, l, t0, g, acum, tid);
    const int row8 = tid >> 3, seg8 = tid & 7;
    {
        const bf16_t* qrow = (const bf16_t*)(F.Q + (t0 + row8) * QS);
#pragma unroll
        for (int hf = 0; hf < 2; ++hf) {
            *(u32x4*)(Bm + row8 * 136 + (seg8 + 8 * hf) * 8) = *(const u32x4*)(qrow + 512 + g * 128 + (seg8 + 8 * hf) * 8);
            *(u32x4*)(Cm + row8 * 136 + (seg8 + 8 * hf) * 8) = *(const u32x4*)(qrow + 768 + g * 128 + (seg8 + 8 * hf) * 8);
        }
#pragma unroll
        for (int it = 0; it < 4; ++it) *(u32x4*)(XS + row8 * 264 + (seg8 + 8 * it) * 8) = *(const u32x4*)(qrow + g * 256 + (seg8 + 8 * it) * 8);
    }
    u32x4 pv[2];
    { const bf16_t* src = (const bf16_t*)(F.ws + WS_R4 + R4_SSS) + ((size_t)(b * 8 + 4 * g) * 64 + c) * 8192 + row8 * 128;
      pv[0] = *(const u32x4*)(src + seg8 * 8); pv[1] = *(const u32x4*)(src + (seg8 + 8) * 8); }
    LDS_BARRIER();
    const int ti = w >> 1, sj0 = 2 * (w & 1);
    f32x4 cb[2];
#pragma unroll
    for (int q = 0; q < 2; ++q) cb[q] = mma16<128>(Cm + ti * 16 * 136, 136, Bm + (sj0 + q) * 16 * 136, 136, lane, (f32x4){0.f, 0.f, 0.f, 0.f});
    for (int hh = 0; hh < 4; ++hh) {
        const int head = 4 * g + hh;
#pragma unroll
        for (int q = 0; q < 2; ++q)
#pragma unroll
            for (int j = 0; j < 4; ++j) {
                const int lrow = ti * 16 + 4 * (lane >> 4) + j, sidx = (sj0 + q) * 16 + (lane & 15);
                const float v = (sidx <= lrow) ? cb[q][j] * fexp(acum[hh * 64 + lrow] - acum[hh * 64 + sidx]) : 0.f;
                Mh[lrow * 72 + sidx] = f2bf(v);
            }
        {
            const int p = tid & 63, sq = tid >> 6;
            float v[8];
#pragma unroll
            for (int i = 0; i < 8; ++i) { const int sidx = sq * 8 + i; v[i] = bf2f(XS[sidx * 264 + hh * 64 + p]) * acum[256 + hh * 64 + sidx]; }
            *(u32x4*)(XT + p * 72 + sq * 8) = pack8(v);
        }
        *(u32x4*)(PV + row8 * 136 + seg8 * 8) = pv[0]; *(u32x4*)(PV + row8 * 136 + (seg8 + 8) * 8) = pv[1];
        if (hh < 3) { const bf16_t* src = (const bf16_t*)(F.ws + WS_R4 + R4_SSS) + ((size_t)(b * 8 + head + 1) * 64 + c) * 8192 + row8 * 128;
            pv[0] = *(const u32x4*)(src + seg8 * 8); pv[1] = *(const u32x4*)(src + (seg8 + 8) * 8); }
        LDS_BARRIER();
        const float Dk = F.in[I_SD][l * 8 + head];
#pragma unroll
        for (int q = 0; q < 2; ++q) {
            const int pj = sj0 + q;
            const f32x4 a1 = mma16<64>(Mh + ti * 16 * 72, 72, XT + pj * 16 * 72, 72, lane, (f32x4){0.f, 0.f, 0.f, 0.f});
            const f32x4 a2 = mma16<128>(Cm + ti * 16 * 136, 136, PV + pj * 16 * 136, 136, lane, (f32x4){0.f, 0.f, 0.f, 0.f});
#pragma unroll
            for (int j = 0; j < 4; ++j) {
                const int lrow = ti * 16 + 4 * (lane >> 4) + j, p = pj * 16 + (lane & 15);
                const float xs = bf2f(XS[lrow * 264 + hh * 64 + p]);
                F.O[(t0 + lrow) * D + 512 + head * 64 + p] = a1[j] + fexp(acum[hh * 64 + lrow]) * a2[j] + Dk * xs;
            }
        }
        LDS_BARRIER();
    }
}


struct HgIn { float fr[16], q[16], v[16]; u32x4 sp[4]; };
__device__ __forceinline__ void hg_load(const Frame& F, int u, int tid, HgIn& x, bool out_phase) {
    const int h = u & 3, c = (u >> 2) & 63, b = u >> 8; const size_t t0 = (size_t)b * SEQ + c * 64;
    const int k = tid & 127, tq = tid >> 7;
#pragma unroll
    for (int i = 0; i < 16; ++i) { const BfPtr p = F.P + (t0 + tq * 16 + i) * PS + h * 128 + k; x.fr[i] = p[C_HG_F]; x.v[i] = p[C_HG_I]; if (out_phase) x.q[i] = p[C_HG_Q]; }
    if (out_phase) {
        const bf16_t* src = (const bf16_t*)(F.ws + WS_R4 + R4_HGS) + ((size_t)(b * 4 + h) * 64 + c) * 16384 + (tid >> 2) * 128;
#pragma unroll
        for (int i8 = 0; i8 < 4; ++i8) x.sp[i8] = *(const u32x4*)(src + (i8 * 4 + (tid & 3)) * 8);
    }
}
__device__ __forceinline__ void hg_cumlog(const Frame& F, int l, int h, float* gt, float (&freg)[16], float (&bown)[16], int tid, const HgIn& x) {
    const int k = tid & 127, tq = tid >> 7;
    float lb = 0.f;
    if (l > 0) { const float p0 = F.in[I_HGLB][h * 128 + k], p1 = F.in[I_HGLB][GW + h * 128 + k]; const float m = fmaxf(p0, p1); const float e0 = fexp(p0 - m), e1 = fexp(p1 - m); lb = e1 * frcp(e0 + e1); }
    float run = 0.f;
#pragma unroll
    for (int i = 0; i < 16; ++i) { const float f = lb + (1.0f - lb) * sigmoid_f(x.fr[i]); freg[i] = f; run += flog(f); bown[i] = run; }
    gt[tq * 128 + k] = run;
    LDS_BARRIER();
    float off = 0.f;
#pragma unroll
    for (int g2 = 0; g2 < 3; ++g2) off += (g2 < tq) ? gt[g2 * 128 + k] : 0.f;
#pragma unroll
    for (int i = 0; i < 16; ++i) bown[i] += off;
}
__device__ __forceinline__ void hg_local(const Frame& F, int l, int u, int tid, const HgIn& x) {
    const int h = u & 3, c = (u >> 2) & 63, b = u >> 8;
    const int lane = tid & 63, w = __builtin_amdgcn_readfirstlane(tid >> 6);
    float* gt = (float*)F.lds;
    bf16_t* kdT = (bf16_t*)(F.lds + 32768);
    bf16_t* vT = (bf16_t*)(F.lds + 51200);
    float freg[16], bown[16];
    hg_cumlog(F, l, h, gt, freg, bown, tid, x);
    {
        const int k = tid & 127, tq = tid >> 7;
        const float bend = gt[k] + gt[128 + k] + gt[256 + k] + gt[384 + k];
        float kd[16];
#pragma unroll
        for (int i = 0; i < 16; ++i) kd[i] = (1.0f - freg[i]) * fexp(bend - bown[i]);
        u32x4 p0, p1;
        p0.x = cvt_pk_bf16(kd[0], kd[1]); p0.y = cvt_pk_bf16(kd[2], kd[3]); p0.z = cvt_pk_bf16(kd[4], kd[5]); p0.w = cvt_pk_bf16(kd[6], kd[7]);
        p1.x = cvt_pk_bf16(kd[8], kd[9]); p1.y = cvt_pk_bf16(kd[10], kd[11]); p1.z = cvt_pk_bf16(kd[12], kd[13]); p1.w = cvt_pk_bf16(kd[14], kd[15]);
        *(u32x4*)(kdT + k * 72 + tq * 16) = p0; *(u32x4*)(kdT + k * 72 + tq * 16 + 8) = p1;
        p0.x = cvt_pk_bf16(x.v[0], x.v[1]); p0.y = cvt_pk_bf16(x.v[2], x.v[3]); p0.z = cvt_pk_bf16(x.v[4], x.v[5]); p0.w = cvt_pk_bf16(x.v[6], x.v[7]);
        p1.x = cvt_pk_bf16(x.v[8], x.v[9]); p1.y = cvt_pk_bf16(x.v[10], x.v[11]); p1.z = cvt_pk_bf16(x.v[12], x.v[13]); p1.w = cvt_pk_bf16(x.v[14], x.v[15]);
        *(u32x4*)(vT + k * 72 + tq * 16) = p0; *(u32x4*)(vT + k * 72 + tq * 16 + 8) = p1;
        if (tq == 0) ((float*)(F.ws + WS_R4 + R4_HGD))[((size_t)(b * 4 + h) * 64 + c) * 128 + k] = fexp(bend);
    }
    LDS_BARRIER();
    {
        bf16_t* dst = (bf16_t*)(F.ws + WS_R4 + R4_HGS) + ((size_t)(b * 4 + h) * 64 + c) * 16384;
#pragma unroll
        for (int ki = 0; ki < 8; ++ki) {
            const f32x4 acc = mma16<64>(kdT + ki * 16 * 72, 72, vT + w * 16 * 72, 72, lane, (f32x4){0.f, 0.f, 0.f, 0.f});
            u32x2 pk; pk.x = cvt_pk_bf16(acc[0], acc[1]); pk.y = cvt_pk_bf16(acc[2], acc[3]);
            *(u32x2*)(dst + (w * 16 + (lane & 15)) * 128 + ki * 16 + 4 * (lane >> 4)) = pk;
        }
    }
    LDS_BARRIER();
}
__device__ __forceinline__ void hg_scan(const Frame& F, int e) {
    const int bh = e >> 14, r = e & 16383, k = r & 127;
    bf16_t* st = (bf16_t*)(F.ws + WS_R4 + R4_HGS) + (size_t)bh * 64 * 16384 + r; const float* dec = (const float*)(F.ws + WS_R4 + R4_HGD) + (size_t)bh * 64 * 128 + k;
    float h = 0.f;
    for (int c0 = 0; c0 < 64; c0 += 16) {
        float tmp[16], dd[16];
#pragma unroll
        for (int i = 0; i < 16; ++i) { tmp[i] = bf2f(st[(size_t)(c0 + i) * 16384]); dd[i] = dec[(c0 + i) * 128]; }
#pragma unroll
        for (int i = 0; i < 16; ++i) { st[(size_t)(c0 + i) * 16384] = f2bf(h); h = h * dd[i] + tmp[i]; }
    }
}
__device__ __forceinline__ void hg_out(const Frame& F, int l, int u, int tid, const HgIn& x) {
    const int h = u & 3, c = (u >> 2) & 63, b = u >> 8; const size_t t0 = (size_t)b * SEQ + c * 64;
    const int lane = tid & 63, w = __builtin_amdgcn_readfirstlane(tid >> 6);
    float* gt = (float*)F.lds;
    bf16_t* Sc = (bf16_t*)F.lds;
    bf16_t* qh = (bf16_t*)(F.lds + 32768);
    bf16_t* kh = (bf16_t*)(F.lds + 50176);
    bf16_t* vT = (bf16_t*)(F.lds + 67584);
    bf16_t* Sp = (bf16_t*)(F.lds + 86016);
    float freg[16], bown[16];
    hg_cumlog(F, l, h, gt, freg, bown, tid, x);
    {
        const int k = tid & 127, tq = tid >> 7;
        const float m = gt[k] + gt[128 + k];
#pragma unroll
        for (int i = 0; i < 16; ++i) {
            const int t = tq * 16 + i; const float bb = bown[i];
            qh[t * 136 + k] = f2bf(silu_f(x.q[i]) * fexp(bb - m)); kh[t * 136 + k] = f2bf((1.0f - freg[i]) * fexp(m - bb));
        }
        u32x4 p0, p1;
        p0.x = cvt_pk_bf16(x.v[0], x.v[1]); p0.y = cvt_pk_bf16(x.v[2], x.v[3]); p0.z = cvt_pk_bf16(x.v[4], x.v[5]); p0.w = cvt_pk_bf16(x.v[6], x.v[7]);
        p1.x = cvt_pk_bf16(x.v[8], x.v[9]); p1.y = cvt_pk_bf16(x.v[10], x.v[11]); p1.z = cvt_pk_bf16(x.v[12], x.v[13]); p1.w = cvt_pk_bf16(x.v[14], x.v[15]);
        *(u32x4*)(vT + k * 72 + tq * 16) = p0; *(u32x4*)(vT + k * 72 + tq * 16 + 8) = p1;
        const int v = tid >> 2;
#pragma unroll
        for (int i8 = 0; i8 < 4; ++i8) {
            const u32x4 raw = x.sp[i8]; const int kq = (i8 * 4 + (tid & 3)) * 8 - i8 * 8;
            float mm[8];
#pragma unroll
            for (int e = 0; e < 8; ++e) mm[e] = gt[kq + i8 * 8 + e] + gt[128 + kq + i8 * 8 + e];
            u32x4 pk; pk.x = cvt_pk_bf16(__uint_as_float(raw.x << 16) * fexp(mm[0]), __uint_as_float(raw.x & 0xffff0000u) * fexp(mm[1])); pk.y = cvt_pk_bf16(__uint_as_float(raw.y << 16) * fexp(mm[2]), __uint_as_float(raw.y & 0xffff0000u) * fexp(mm[3]));
            pk.z = cvt_pk_bf16(__uint_as_float(raw.z << 16) * fexp(mm[4]), __uint_as_float(raw.z & 0xffff0000u) * fexp(mm[5])); pk.w = cvt_pk_bf16(__uint_as_float(raw.w << 16) * fexp(mm[6]), __uint_as_float(raw.w & 0xffff0000u) * fexp(mm[7]));
            *(u32x4*)(Sp + v * 136 + kq + i8 * 8) = pk;
        }
    }
    LDS_BARRIER();
    const int ti = w >> 1;
    {
        f32x4 sc[2];
#pragma unroll
        for (int q = 0; q < 2; ++q) sc[q] = mma16<128>(qh + ti * 16 * 136, 136, kh + (2 * (w & 1) + q) * 16 * 136, 136, lane, (f32x4){0.f, 0.f, 0.f, 0.f});
#pragma unroll
        for (int q = 0; q < 2; ++q)
#pragma unroll
            for (int j = 0; j < 4; ++j) {
                const int t = ti * 16 + 4 * (lane >> 4) + j, sidx = (2 * (w & 1) + q) * 16 + (lane & 15);
                Sc[t * 72 + sidx] = f2bf(sidx <= t ? sc[q][j] : 0.f);
            }
    }
    LDS_BARRIER();
#pragma unroll
    for (int q = 0; q < 4; ++q) {
        const int vj = (w & 1) * 4 + q;
        f32x4 acc = mma16<64>(Sc + ti * 16 * 72, 72, vT + vj * 16 * 72, 72, lane, (f32x4){0.f, 0.f, 0.f, 0.f});
        acc = mma16<128>(qh + ti * 16 * 136, 136, Sp + vj * 16 * 136, 136, lane, acc);
#pragma unroll
        for (int j = 0; j < 4; ++j) F.O[(t0 + ti * 16 + 4 * (lane >> 4) + j) * D + h * 128 + vj * 16 + (lane & 15)] = acc[j];
    }
    LDS_BARRIER();
}


__device__ __forceinline__ u32x2 pack4(const f32x4 v) { u32x2 p; p.x = cvt_pk_bf16(v[0], v[1]); p.y = cvt_pk_bf16(v[2], v[3]); return p; }
__device__ __forceinline__ f32x4 unpack4(const u32x2 p) { f32x4 v; v[0] = __uint_as_float(p.x << 16); v[1] = __uint_as_float(p.x & 0xffff0000u); v[2] = __uint_as_float(p.y << 16); v[3] = __uint_as_float(p.y & 0xffff0000u); return v; }
__device__ __forceinline__ u32x4 pack8(const float (&v)[8]) { u32x4 p; p.x = cvt_pk_bf16(v[0], v[1]); p.y = cvt_pk_bf16(v[2], v[3]); p.z = cvt_pk_bf16(v[4], v[5]); p.w = cvt_pk_bf16(v[6], v[7]); return p; }

struct RwRaw { float w[8], kka[8], k[8]; bf16_t pr[9], pk[9], pv[9]; };
struct RwIn { float w[8], kk[8], r[8], kka[8], k[8], v[8]; };
__device__ __forceinline__ void rw_load(const Frame& F, int b, int c, int h, int tid, RwRaw& x) {
    const size_t t0 = (size_t)b * SEQ + c * 64; const int k = tid & 63, ig = tid >> 6;
#pragma unroll
    for (int ii = 0; ii < 8; ++ii) { const float* q = F.Q + (t0 + ig * 8 + ii) * QS + h * 64 + k; x.w[ii] = q[Q_W]; x.kka[ii] = q[Q_KKA]; x.k[ii] = q[Q_K]; }
    const bool first = (ig == 0) && (c == 0);
#pragma unroll
    for (int j = 0; j < 9; ++j) { const bf16_t* p = F.P.p + (long)((long)t0 + ig * 8 - 1 + j) * PS + C_RW + h * 64 + k;
        const bool z = first && (j == 0); x.pr[j] = z ? (bf16_t)0 : p[0]; x.pk[j] = z ? (bf16_t)0 : p[512]; x.pv[j] = z ? (bf16_t)0 : p[1024]; }
}
__device__ __forceinline__ void rw_finish(const Frame& F, int l, int h, int tid, const RwRaw& a, RwIn& x) {
    const int k = tid & 63; const float* mu = F.in[I_WMU] + (size_t)l * RW_COLS + h * 64 + k;
    const float mr = mu[0], mkk = mu[512], mv = mu[1024], kkc = F.in[I_WKK][l * GW + h * 64 + k];
#pragma unroll
    for (int ii = 0; ii < 8; ++ii) {
        const float rc = bf2f(a.pr[ii + 1]), rp = bf2f(a.pr[ii]), kc = bf2f(a.pk[ii + 1]), kp = bf2f(a.pk[ii]), vc = bf2f(a.pv[ii + 1]), vp = bf2f(a.pv[ii]);
        x.r[ii] = rc + (rp - rc) * mr; x.v[ii] = vc + (vp - vc) * mv;
        const float kx = (kc + (kp - kc) * mkk) * kkc; const float ss = wave_sum(kx * kx);
        x.kk[ii] = kx * frcp(fmaxf(__builtin_amdgcn_sqrtf(ss), 1e-12f));
        x.w[ii] = a.w[ii]; x.kka[ii] = a.kka[ii]; x.k[ii] = a.k[ii];
    }
}
__device__ __forceinline__ void rw_prep(const Frame& F, int l, int b, int c, int h, int tid, const RwIn& x) {
    const int ru = (b * 64 + c) * 8 + h;
    unsigned char* rec = F.ws + WS_U + (size_t)ru * RW_REC;
    float* aabT = (float*)(F.ws + WS_RWAAB) + (size_t)ru * 4096;
    const int lane = tid & 63, w = __builtin_amdgcn_readfirstlane(tid >> 6);
    float* cumL = (float*)F.lds;
    bf16_t* Ar = (bf16_t*)(F.lds + 16640);
    bf16_t* Rr = Ar + 64 * 72; bf16_t* Br = Rr + 64 * 72; bf16_t* Kr = Br + 64 * 72; bf16_t* KrT = Kr + 64 * 72; bf16_t* vT = KrT + 64 * 72; bf16_t* AakT = vT + 64 * 72; bf16_t* ArkT = AakT + 64 * 72;
    const int k = tid & 63, ig = tid >> 6;
    {
        const float rkc = F.in[I_WRK][l * GW + h * 64 + k]; float* bon = (float*)(F.ws + WS_BON) + ((size_t)b * SEQ + c * 64 + ig * 8) * 8 + h;
#pragma unroll
        for (int ii = 0; ii < 8; ++ii) { const float sv = wave_sum(x.r[ii] * x.k[ii] * rkc); if (k == 0) bon[ii * 8] = sv; }
    }
    float pre[8];
    { float run = 0.f;
#pragma unroll
      for (int ii = 0; ii < 8; ++ii) { run += flog(x.w[ii]); pre[ii] = run; }
      cumL[ig * 64 + k] = run; }
    LDS_BARRIER();
    float off = 0.f, tot = 0.f;
#pragma unroll
    for (int g2 = 0; g2 < 8; ++g2) { const float gv = cumL[g2 * 64 + k]; off += (g2 < ig) ? gv : 0.f; tot += gv; }
    {
        float brv[8], krv[8], vvv[8];
#pragma unroll
        for (int ii = 0; ii < 8; ++ii) {
            const int i = ig * 8 + ii;
            const float cu = off + pre[ii]; const float cux = (ii > 0) ? off + pre[ii - 1] : off;
            const float e_in = fexp(cu), e_ex = fexp(cux), e_neg = fexp(-cu);
            const float ar = -x.kk[ii] * e_ex, rr = x.r[ii] * e_in; brv[ii] = x.kka[ii] * e_neg; krv[ii] = x.k[ii] * e_neg; vvv[ii] = x.v[ii];
            const bf16_t arb = f2bf(ar), rrb = f2bf(rr);
            Ar[i * 72 + k] = arb; Rr[i * 72 + k] = rrb; Br[i * 72 + k] = f2bf(brv[ii]); Kr[i * 72 + k] = f2bf(krv[ii]);
            ((bf16_t*)(rec + RO_AR))[i * 64 + k] = arb; ((bf16_t*)(rec + RO_RR))[i * 64 + k] = rrb;
        }
        *(u32x4*)(KrT + k * 72 + ig * 8) = pack8(krv); *(u32x4*)(vT + k * 72 + ig * 8) = pack8(vvv);
        *(u32x4*)((bf16_t*)(rec + RO_BRT) + k * 64 + ig * 8) = pack8(brv);
        if (ig == 0) ((float*)(F.ws + WS_RWGC))[ru * 64 + k] = fexp(tot);
    }
    LDS_BARRIER();
    const int ri = w >> 1, cj0 = 2 * (w & 1);
    const f32x4 z4 = (f32x4){0.f, 0.f, 0.f, 0.f};
#pragma unroll
    for (int q = 0; q < 2; ++q) {
        const int cj = cj0 + q;
        f32x4 aab = mma16<64>(Br + ri * 16 * 72, 72, Ar + cj * 16 * 72, 72, lane, z4);
        f32x4 aak = mma16<64>(Kr + ri * 16 * 72, 72, Ar + cj * 16 * 72, 72, lane, z4);
        f32x4 arb = mma16<64>(Br + ri * 16 * 72, 72, Rr + cj * 16 * 72, 72, lane, z4);
        f32x4 ark = mma16<64>(Kr + ri * 16 * 72, 72, Rr + cj * 16 * 72, 72, lane, z4);
        const int i0 = ri * 16 + 4 * (lane >> 4), t = cj * 16 + (lane & 15);
#pragma unroll
        for (int j = 0; j < 4; ++j) { const bool st = (i0 + j) < t, inc = (i0 + j) <= t; aab[j] = st ? aab[j] : 0.f; aak[j] = st ? aak[j] : 0.f; arb[j] = inc ? arb[j] : 0.f; ark[j] = inc ? ark[j] : 0.f; }
        *(f32x4*)(aabT + t * 64 + i0) = aab;
        *(u32x2*)(AakT + t * 72 + i0) = pack4(aak);
        *(u32x2*)((bf16_t*)(rec + RO_ARBT) + t * 64 + i0) = pack4(arb);
        *(u32x2*)(ArkT + t * 72 + i0) = pack4(ark);
    }
    LDS_BARRIER();
#pragma unroll
    for (int q = 0; q < 2; ++q) {
        const int cj = cj0 + q, tile = ri * 4 + cj;
        const f32x4 xl = mma16<64>(AakT + ri * 16 * 72, 72, vT + cj * 16 * 72, 72, lane, z4);
        const f32x4 lt = mma16<64>(KrT + ri * 16 * 72, 72, vT + cj * 16 * 72, 72, lane, z4);
        const f32x4 yl = mma16<64>(ArkT + ri * 16 * 72, 72, vT + cj * 16 * 72, 72, lane, z4);
        *(u32x2*)(rec + RO_XL + tile * 512 + lane * 8) = pack4(xl);
        *(u32x2*)(rec + RO_LT + tile * 512 + lane * 8) = pack4(lt);
        *(u32x2*)(rec + RO_YL + tile * 512 + lane * 8) = pack4(yl);
    }
    LDS_BARRIER();
}

template <int t> __device__ __forceinline__ void tsolve_step(float (&T)[64], const LAS float* A, int lane) {
    if constexpr (t < 64) {
        float acc = (lane == t) ? 1.0f : 0.0f;
        const LAS float* row = A + t * 64;
        if constexpr (t > 0) asm("" : "+v"(row) : "v"(T[t - 1]));
        const LAS f32x4* row4 = (const LAS f32x4*)row;
#pragma unroll
        for (int i4 = 0; i4 < t / 4; ++i4) { const f32x4 v = row4[i4]; acc += T[4 * i4] * v[0]; acc += T[4 * i4 + 1] * v[1]; acc += T[4 * i4 + 2] * v[2]; acc += T[4 * i4 + 3] * v[3]; }
#pragma unroll
        for (int i = (t / 4) * 4; i < t; ++i) acc += T[i] * row[i];
        T[t] = acc;
        tsolve_step<t + 1>(T, A, lane);
    }
}
__device__ __forceinline__ void rw_tsolve(const Frame& F, int ru, int w, int lane) {
    LAS float* A = (LAS float*)((LAS unsigned char*)F.lds + w * 16384);
    const float* src = (const float*)(F.ws + WS_RWAAB) + (size_t)ru * 4096;
#pragma unroll
    for (int q = 0; q < 16; ++q) *(LAS f32x4*)(A + (q * 64 + lane) * 4) = *(const f32x4*)(src + (q * 64 + lane) * 4);
    float T[64];
    tsolve_step<0>(T, A, lane);
    bf16_t* Tl = (bf16_t*)(F.lds + w * 16384);
#pragma unroll
    for (int i8 = 0; i8 < 8; ++i8) { float v[8];
#pragma unroll
        for (int e = 0; e < 8; ++e) v[e] = T[i8 * 8 + e];
        *(u32x4*)(Tl + lane * 72 + i8 * 8) = pack8(v); }
    unsigned char* rec = F.ws + WS_U + (size_t)ru * RW_REC;
#pragma unroll 1
    for (int which = 0; which < 2; ++which) {
        bf16_t* M = (bf16_t*)(rec + (which ? RO_BRT : RO_ARBT));
#pragma unroll 1
        for (int tt = 0; tt < 4; ++tt) {
            bf16x8 bfr[2];
#pragma unroll
            for (int s2 = 0; s2 < 2; ++s2) bfr[s2] = *(const bf16x8*)(M + (tt * 16 + (lane & 15)) * 64 + (lane >> 4) * 8 + s2 * 32);
            f32x4 acc[4];
#pragma unroll
            for (int jt = 0; jt < 4; ++jt) {
                acc[jt] = (f32x4){0.f, 0.f, 0.f, 0.f};
#pragma unroll
                for (int s2 = 0; s2 < 2; ++s2) { const bf16x8 a = *(const bf16x8*)(Tl + (jt * 16 + (lane & 15)) * 72 + (lane >> 4) * 8 + s2 * 32); acc[jt] = __builtin_amdgcn_mfma_f32_16x16x32_bf16(a, bfr[s2], acc[jt], 0, 0, 0); }
            }
#pragma unroll
            for (int jt = 0; jt < 4; ++jt) *(u32x2*)(M + (tt * 16 + (lane & 15)) * 64 + jt * 16 + 4 * (lane >> 4)) = pack4(acc[jt]);
        }
    }
}

__device__ __forceinline__ f32x4 mma16r(const bf16x8 (&a)[2], const bf16_t* Bt, int ldb, int lane, f32x4 acc) {
    const bf16_t* bp = Bt + (lane & 15) * ldb + (lane >> 4) * 8;
#pragma unroll
    for (int s2 = 0; s2 < 2; ++s2) { const bf16x8 b = *(const bf16x8*)(bp + s2 * 32); acc = __builtin_amdgcn_mfma_f32_16x16x32_bf16(a[s2], b, acc, 0, 0, 0); }
    return acc;
}
struct RwStage { u32x4 a[4]; u32x2 dXl, dLt, dYl; f32x4 gc; };
__device__ __forceinline__ void rw_stage_load(const Frame& F, int b, int h, int cc, int tid, int tile, int lane, int r4, RwStage& S) {
    const int ru = (b * 64 + cc) * 8 + h; const unsigned char* rec = F.ws + WS_U + (size_t)ru * RW_REC;
#pragma unroll
    for (int m = 0; m < 4; ++m) S.a[m] = *(const u32x4*)(rec + m * 8192 + tid * 16);
    S.dXl = *(const u32x2*)(rec + RO_XL + tile * 512 + lane * 8); S.dLt = *(const u32x2*)(rec + RO_LT + tile * 512 + lane * 8); S.dYl = *(const u32x2*)(rec + RO_YL + tile * 512 + lane * 8);
    S.gc = *(const f32x4*)((const float*)(F.ws + WS_RWGC) + ru * 64 + r4);
}
static_assert(RO_AR == 0 && RO_RR == 8192 && RO_BRT == 16384 && RO_ARBT == 24576 && RO_TT == 32768, "record layout");
__device__ __forceinline__ void rw_stage_park(const RwStage& S, bf16_t* img, int tid) {
#pragma unroll
    for (int m = 0; m < 4; ++m) *(u32x4*)(img + m * 4608 + (tid >> 3) * 72 + (tid & 7) * 8) = S.a[m];
}
__device__ __forceinline__ f32x4 mma16l(const bf16_t* A, const bf16_t* Bt, int lane, f32x4 acc) { return mma16<64>(A, 72, Bt, 72, lane, acc); }
__device__ __forceinline__ void rw_seq(const Frame& F, int job, int tid) {
    const int bh = job >> 1, vh = job & 1, b = bh >> 3, h = bh & 7;
    const int lane = tid & 63, w = __builtin_amdgcn_readfirstlane(tid >> 6), ri = w >> 1, cjl = (w & 1), cj = 2 * vh + cjl;
    bf16_t* S0 = (bf16_t*)F.lds; bf16_t* Xb = S0 + 32 * 72; bf16_t* Ub = Xb + 32 * 72;
    bf16_t* IMG = (bf16_t*)(F.lds + 16384);
    for (int i = tid; i < 32 * 72 / 2; i += 512) ((unsigned*)S0)[i] = 0u;
    f32x4 st = (f32x4){0.f, 0.f, 0.f, 0.f};
    const int vcol = lane & 15, r4 = ri * 16 + 4 * (lane >> 4), tile = ri * 4 + cj;
    RwStage s0, s1, s2;
    rw_stage_load(F, b, h, 0, tid, tile, lane, r4, s0); rw_stage_load(F, b, h, 1, tid, tile, lane, r4, s1); rw_stage_load(F, b, h, 2, tid, tile, lane, r4, s2);
    rw_stage_park(s0, IMG, tid);
    __syncthreads();
    const size_t tb = (size_t)b * SEQ;
#define RW_STEP(cc, S, SN) do { const bf16_t* im = IMG + ((cc) & 1) * 23040 + ri * 16 * 72; \
        const f32x4 xl = unpack4(S.dXl), lt = unpack4(S.dLt); f32x4 y = unpack4(S.dYl); const f32x4 gcc = S.gc; \
        { const f32x4 x = mma16l(im + 0 * 4608, S0 + cjl * 16 * 72, lane, xl); y = mma16l(im + 1 * 4608, S0 + cjl * 16 * 72, lane, y); \
          *(u32x2*)(Xb + (cjl * 16 + vcol) * 72 + r4) = pack4(x); } \
        LDS_BARRIER(); \
        { y = mma16l(im + 3 * 4608, Xb + cjl * 16 * 72, lane, y);                   \
          _Pragma("unroll") for (int j = 0; j < 4; ++j) F.O[(tb + (size_t)(cc) * 64 + r4 + j) * D + 1536 + h * 64 + cj * 16 + vcol] = y[j]; \
          st = mma16l(im + 2 * 4608, Xb + cjl * 16 * 72, lane, st);                 \
          _Pragma("unroll") for (int j = 0; j < 4; ++j) st[j] = (st[j] + lt[j]) * gcc[j]; \
          *(u32x2*)(S0 + (cjl * 16 + vcol) * 72 + r4) = pack4(st); } \
        if ((cc) + 1 < 64) rw_stage_park(SN, IMG + (((cc) + 1) & 1) * 23040, tid); \
        LDS_BARRIER(); \
        if ((cc) + 3 < 64) rw_stage_load(F, b, h, (cc) + 3, tid, tile, lane, r4, S); } while (0)
#pragma unroll 1
    for (int c = 0; c < 64; c += 3) {
        RW_STEP(c, s0, s1);
        if (c + 1 < 64) RW_STEP(c + 1, s1, s2);
        if (c + 2 < 64) RW_STEP(c + 2, s2, s0);
    }
#undef RW_STEP
}

constexpr int NU_HG = 1024, NU_SSD = 512, NU_RG = 256;
__device__ __forceinline__ void hg_scan4(const Frame& F, int e4) {
    const int bh = e4 >> 12, r = (e4 & 4095) * 4, k = r & 127;
    bf16_t* st = (bf16_t*)(F.ws + WS_R4 + R4_HGS) + (size_t)bh * 64 * 16384 + r; const float* dec = (const float*)(F.ws + WS_R4 + R4_HGD) + (size_t)bh * 64 * 128 + k;
    f32x4 h = (f32x4){0.f, 0.f, 0.f, 0.f};
#pragma unroll 1
    for (int c0 = 0; c0 < 64; c0 += 16) {
        u32x2 tmp[16]; f32x4 dd[16];
#pragma unroll
        for (int i = 0; i < 16; ++i) { tmp[i] = *(const u32x2*)(st + (size_t)(c0 + i) * 16384); dd[i] = *(const f32x4*)(dec + (c0 + i) * 128); }
#pragma unroll
        for (int i = 0; i < 16; ++i) { *(u32x2*)(st + (size_t)(c0 + i) * 16384) = pack4(h); h = h * dd[i] + unpack4(tmp[i]); }
    }
}
__device__ __forceinline__ void ssd_scan8(const Frame& F, int e8) {
    const int bh = e8 >> 10, r = (e8 & 1023) * 8;
    bf16_t* st = (bf16_t*)(F.ws + WS_R4 + R4_SSS) + (size_t)bh * 64 * 8192 + r; const float* dec = (const float*)(F.ws + WS_R4 + R4_SSD) + bh * 64;
    float h[8];
#pragma unroll
    for (int j = 0; j < 8; ++j) h[j] = 0.f;
#pragma unroll 1
    for (int c0 = 0; c0 < 64; c0 += 16) {
        u32x4 tmp[16]; float dd[16];
#pragma unroll
        for (int i = 0; i < 16; ++i) { tmp[i] = *(const u32x4*)(st + (size_t)(c0 + i) * 8192); dd[i] = dec[c0 + i]; }
#pragma unroll
        for (int i = 0; i < 16; ++i) {
            *(u32x4*)(st + (size_t)(c0 + i) * 8192) = pack8(h);
#pragma unroll
            for (int j = 0; j < 8; ++j) h[j] = h[j] * dd[i] + bfel(tmp[i], j);
        }
    }
}
__device__ __forceinline__ void rg_scan2(const Frame& F, int e) {
    const int b = e >> 9, j = e & 511;
    float* rgc = (float*)(F.ws + WS_R4 + R4_RGC);
    float h = 0.f;
#pragma unroll 1
    for (int c0 = 0; c0 < 64; c0 += 32) {
        float2 pe[32];
#pragma unroll
        for (int i = 0; i < 32; ++i) pe[i] = *(const float2*)(rgc + ((size_t)(b * 64 + c0 + i) * 512 + j) * 2);
#pragma unroll
        for (int i = 0; i < 32; ++i) { rgc[((size_t)(b * 64 + c0 + i) * 512 + j) * 2 + 1] = h; h = pe[i].x * h + pe[i].y; }
    }
}
__device__ __forceinline__ void phase_m2(const Frame& F, int l) {
    const int tid = opaque_tid();
#ifndef SKIP_RWSEQ
    if (F.bid < 64) { rw_seq(F, F.bid, tid); return; }
#endif
    const int gt = (F.bid - 64) * 512 + tid, nthr = (F.G - 64) * 512;
    constexpr int N_HG = 16 * 4096, N_SS = 32 * 1024, N_RG = 2048;
    for (int it = gt; it < N_RG + N_HG + N_SS; it += nthr) {
        if (it < N_RG) rg_scan2(F, it); else if (it < N_RG + N_HG) hg_scan4(F, it - N_RG); else ssd_scan8(F, it - N_RG - N_HG);
    }
    __syncthreads();
    for (int i = F.bid - 64; i < DEFER_TILES / 2; i += F.G - 64) conv_down_tile(F, 64 * 16 * 8 - DEFER_TILES + l * (DEFER_TILES / 2) + i, tid);
}


__device__ __forceinline__ void phase_front(const Frame& F, int l) {
    for (int ch = F.bid; ch < NTOK / 64; ch += F.G) {
        pre_steps14(F, l, ch); LDS_BARRIER(); pre_5a(F, l, ch); LDS_BARRIER(); pre_5b(F, l, ch); __syncthreads();
        const int tid = opaque_tid();
        { RwRaw nx; rw_load(F, ch >> 6, ch & 63, 0, tid, nx);
#pragma unroll 1
          for (int hh = 0; hh < 8; ++hh) { RwIn cu; rw_finish(F, l, hh, tid, nx, cu); if (hh < 7) rw_load(F, ch >> 6, ch & 63, hh + 1, tid, nx); rw_prep(F, l, ch >> 6, ch & 63, hh, tid, cu); } }
        __syncthreads();
        { const int w = __builtin_amdgcn_readfirstlane(tid >> 6); rw_tsolve(F, ch * 8 + w, w, tid & 63); }
        LDS_BARRIER();
        { HgIn nx; hg_load(F, ch * 4, tid, nx, false);
#pragma unroll 1
          for (int h = 0; h < 4; ++h) { const HgIn cu = nx; if (h < 3) hg_load(F, ch * 4 + h + 1, tid, nx, false); hg_local(F, l, ch * 4 + h, tid, cu); } }
        for (int g = 0; g < 2; ++g) ssd_local(F, l, ch * 2 + g, tid);
        rg_local(F, ch, tid);
        __syncthreads();
    }
}
__device__ __forceinline__ void phase_c3_chunk(const Frame& F, int l, int ch);
__device__ __forceinline__ void phase_back(const Frame& F, int l) {
    for (int ch = F.bid; ch < NTOK / 64; ch += F.G) {
        const int tid = opaque_tid();
        { HgIn nx; hg_load(F, ch * 4, tid, nx, true);
#pragma unroll 1
          for (int h = 0; h < 4; ++h) { const HgIn cu = nx; if (h < 3) hg_load(F, ch * 4 + h + 1, tid, nx, true); hg_out(F, l, ch * 4 + h, tid, cu); } }
        for (int g = 0; g < 2; ++g) ssd_out(F, l, ch * 2 + g, tid);
        rg_out(F, ch, tid);
        __syncthreads();
        phase_c3_chunk(F, l, ch);
        __syncthreads();
    }
}

struct C3In { float o[32], pg[8], pz[8], qv[8], qg[8], bon[8]; };
__device__ __forceinline__ void c3_load(const Frame& F, int l, int t, int lane, C3In& x) {
    const float* o = F.O + (size_t)t * D; const BfPtr p = F.P + (size_t)t * PS; const float* q = F.Q + (size_t)t * QS;
#pragma unroll
    for (int j = 0; j < 32; ++j) if (j < 16 || j >= 24) x.o[j] = o[lane + 64 * j];
#pragma unroll
    for (int j = 0; j < 8; ++j) { const int c = lane + 64 * j; x.pg[j] = p[C_HG_G + c]; x.pz[j] = p[C_SS_Z + c]; { const float vc = p[C_RW + 1024 + c], vp = ((t & (SEQ - 1)) != 0) ? p[C_RW + 1024 + c - (long)PS] : 0.f; x.qv[j] = vc + (vp - vc) * F.in[I_WMU][(size_t)l * RW_COLS + 1024 + c]; } x.qg[j] = q[Q_G + c]; x.bon[j] = ((const float*)(F.ws + WS_BON))[(size_t)t * 8 + j]; }
}
__device__ __forceinline__ void c3_unpack(u32x2 p, float (&f)[4]) { f[0] = __uint_as_float(p.x << 16); f[1] = __uint_as_float(p.x & 0xffff0000u); f[2] = __uint_as_float(p.y << 16); f[3] = __uint_as_float(p.y & 0xffff0000u); }
__device__ __forceinline__ void phase_c3_chunk(const Frame& F, int l, int ch) {
    const int tid_ = opaque_tid(); const int lane = tid_ & 63; const int wave_ = __builtin_amdgcn_readfirstlane(tid_ >> 6);
    const int t0 = ch * 64 + wave_ * 8, c0 = 4 * lane;
    const bf16_t* P = F.Pw;
    const float* hgw = F.in[I_HGNW] + l * GW; const float* snw = F.in[I_SNW] + l * GW;
    const float* lnw = F.in[I_WLNW] + l * GW; const float* lnb = F.in[I_WLNB] + l * GW; const float* mu = F.in[I_WMU] + (size_t)l * RW_COLS + 1024;
    const float* BON = (const float*)(F.ws + WS_BON);
    f32x4 oA[8][2]; u32x2 gA[8][2]; f32x4 wA[2];
    f32x4 oB[8][2]; u32x2 zB[8][2]; f32x4 wB[2];
#pragma unroll
    for (int i = 0; i < 8; ++i)
#pragma unroll
        for (int jj = 0; jj < 2; ++jj) { oA[i][jj] = *(const f32x4*)(F.O + (size_t)(t0 + i) * D + c0 + 256 * jj); gA[i][jj] = *(const u32x2*)(P + (size_t)(t0 + i) * PS + C_HG_G + c0 + 256 * jj); }
#pragma unroll
    for (int jj = 0; jj < 2; ++jj) wA[jj] = *(const f32x4*)(hgw + c0 + 256 * jj);
#pragma unroll
    for (int i = 0; i < 8; ++i)
#pragma unroll
        for (int jj = 0; jj < 2; ++jj) { oB[i][jj] = *(const f32x4*)(F.O + (size_t)(t0 + i) * D + 512 + c0 + 256 * jj); zB[i][jj] = *(const u32x2*)(P + (size_t)(t0 + i) * PS + C_SS_Z + c0 + 256 * jj); }
#pragma unroll
    for (int jj = 0; jj < 2; ++jj) wB[jj] = *(const f32x4*)(snw + c0 + 256 * jj);
#pragma unroll
    for (int i = 0; i < 8; ++i)
#pragma unroll
        for (int jj = 0; jj < 2; ++jj) {
            const f32x4 ov = oA[i][jj];
            float ss = row16_sum(ov[0] * ov[0] + ov[1] * ov[1] + ov[2] * ov[2] + ov[3] * ov[3]); ss += __shfl_xor(ss, 16);
            const float rs = rsqrtf(ss * (1.0f / 128.0f) + NORM_EPS);
            float gf[4]; c3_unpack(gA[i][jj], gf);
            u32x2 pk; pk.x = cvt_pk_bf16(ov[0] * rs * wA[jj][0] * silu_f(gf[0]), ov[1] * rs * wA[jj][1] * silu_f(gf[1])); pk.y = cvt_pk_bf16(ov[2] * rs * wA[jj][2] * silu_f(gf[2]), ov[3] * rs * wA[jj][3] * silu_f(gf[3]));
            *(u32x2*)(F.MIX + (size_t)(t0 + i) * D + c0 + 256 * jj) = pk;
        }
    f32x4 w4[2], b4[2], m4[2];
#pragma unroll
    for (int jj = 0; jj < 2; ++jj) { w4[jj] = *(const f32x4*)(lnw + c0 + 256 * jj); b4[jj] = *(const f32x4*)(lnb + c0 + 256 * jj); m4[jj] = *(const f32x4*)(mu + c0 + 256 * jj); }
    f32x4 oR[2][4][2], qR[2][4][2]; u32x2 vcR[2][4][2], vpR[2][4][2]; float bonR[2][4][2];
#define C3_LOAD_RW(hb) do { _Pragma("unroll") for (int i = 0; i < 4; ++i) { const int t = t0 + 4 * (hb) + i; const bool first = (t & (SEQ - 1)) == 0; \
        _Pragma("unroll") for (int jj = 0; jj < 2; ++jj) { \
            oR[hb][i][jj] = *(const f32x4*)(F.O + (size_t)t * D + 1536 + c0 + 256 * jj); qR[hb][i][jj] = *(const f32x4*)(F.Q + (size_t)t * QS + Q_G + c0 + 256 * jj); \
            const bf16_t* pv = P + (size_t)t * PS + C_RW + 1024 + c0 + 256 * jj; vcR[hb][i][jj] = *(const u32x2*)pv; \
            vpR[hb][i][jj] = (u32x2){0u, 0u}; if (!first) vpR[hb][i][jj] = *(const u32x2*)(pv - PS); \
            bonR[hb][i][jj] = BON[(size_t)t * 8 + (lane >> 4) + 4 * jj]; } } } while (0)
#define C3_MATH_RW(hb) do { _Pragma("unroll") for (int i = 0; i < 4; ++i) _Pragma("unroll") for (int jj = 0; jj < 2; ++jj) { \
        const f32x4 y = oR[hb][i][jj]; const float mean = row16_sum(y[0] + y[1] + y[2] + y[3]) * (1.0f / 64.0f); \
        float d[4]; _Pragma("unroll") for (int k = 0; k < 4; ++k) d[k] = y[k] - mean; \
        const float var = row16_sum(d[0] * d[0] + d[1] * d[1] + d[2] * d[2] + d[3] * d[3]) * (1.0f / 64.0f); const float rstd = rsqrtf(var + 64e-5f); \
        float vcf[4], vpf[4], out[4]; c3_unpack(vcR[hb][i][jj], vcf); c3_unpack(vpR[hb][i][jj], vpf); \
        _Pragma("unroll") for (int k = 0; k < 4; ++k) { const float vv = vcf[k] + (vpf[k] - vcf[k]) * m4[jj][k]; out[k] = (d[k] * rstd * w4[jj][k] + b4[jj][k] + bonR[hb][i][jj] * vv) * qR[hb][i][jj][k]; } \
        u32x2 pk; pk.x = cvt_pk_bf16(out[0], out[1]); pk.y = cvt_pk_bf16(out[2], out[3]); \
        *(u32x2*)(F.MIX + (size_t)(t0 + 4 * (hb) + i) * D + 1536 + c0 + 256 * jj) = pk; } } while (0)
#pragma unroll
    for (int i = 0; i < 8; ++i)
#pragma unroll
        for (int jj = 0; jj < 2; ++jj) {
            float zf[4]; c3_unpack(zB[i][jj], zf);
            float v[4];
#pragma unroll
            for (int k = 0; k < 4; ++k) v[k] = oB[i][jj][k] * silu_f(zf[k]);
            const float ss = wave_sum(v[0] * v[0] + v[1] * v[1] + v[2] * v[2] + v[3] * v[3]);
            const float rs = rsqrtf(ss * (1.0f / 256.0f) + NORM_EPS);
            u32x2 pk; pk.x = cvt_pk_bf16(v[0] * rs * wB[jj][0], v[1] * rs * wB[jj][1]); pk.y = cvt_pk_bf16(v[2] * rs * wB[jj][2], v[3] * rs * wB[jj][3]);
            *(u32x2*)(F.MIX + (size_t)(t0 + i) * D + 512 + c0 + 256 * jj) = pk;
        }
    C3_LOAD_RW(0);
    C3_MATH_RW(0);
    C3_LOAD_RW(1);
    C3_MATH_RW(1);
#undef C3_LOAD_RW
#undef C3_MATH_RW
}


__device__ __forceinline__ void phase_router2(const Frame& F, int l) {
    const int tid = opaque_tid(); const int lane = tid & 63, w = __builtin_amdgcn_readfirstlane(tid >> 6);
    const int r = lane & 15, q = lane >> 4;
    const float* WRT = (const float*)(F.ws + WS_WRT) + (size_t)l * 48 * 2048;
    const float* nw = F.in[I_NFFN] + (size_t)l * D;
    const float* bg = F.in[I_RGB] + l * 4; const float* be = F.in[I_REB] + l * 32;
    unsigned* cnt = F.ctl + CW_CNT + l * 32;
    unsigned* route = (unsigned*)(F.tab + TAB_ROUTE);
    float* Lg = (float*)F.lds + w * (16 * 48);
    for (int tile = w * F.G + F.bid; tile < NTOK / 16; tile += 8 * F.G) {
        const size_t t0 = (size_t)tile * 16;
        f32x4 acc[3]; acc[0] = (f32x4){0.f, 0.f, 0.f, 0.f}; acc[1] = acc[0]; acc[2] = acc[0];
        float ss = 0.f;
        const float* hp = F.h + (t0 + r) * D + 4 * q; const float* bp = WRT + (size_t)r * 2048 + 4 * q;
#pragma unroll 4
        for (int kg = 0; kg < 128; ++kg) {
            const f32x4 a4 = *(const f32x4*)(hp + kg * 16);
            ss += a4[0] * a4[0] + a4[1] * a4[1] + a4[2] * a4[2] + a4[3] * a4[3];
#pragma unroll
            for (int n = 0; n < 3; ++n) {
                const f32x4 b4 = *(const f32x4*)(bp + (size_t)n * 16 * 2048 + kg * 16);
#pragma unroll
                for (int s2 = 0; s2 < 4; ++s2) acc[n] = __builtin_amdgcn_mfma_f32_16x16x4f32(a4[s2], b4[s2], acc[n], 0, 0, 0);
            }
        }
        ss += __shfl_xor(ss, 16); ss += __shfl_xor(ss, 32);
        const float rs = rsqrtf(ss * (1.0f / D) + NORM_EPS);
#pragma unroll
        for (int j = 0; j < 4; ++j) {
            const float rj = __shfl(rs, 4 * q + j);
#pragma unroll
            for (int n = 0; n < 3; ++n) Lg[(4 * q + j) * 48 + n * 16 + r] = acc[n][j] * rj;
        }
        if (lane < 16) {
            const float* lg = Lg + lane * 48; const int t = (int)t0 + lane;
            float gl[4];
#pragma unroll
            for (int i = 0; i < 4; ++i) gl[i] = lg[i] + bg[i];
            int gi = 0; float gm = gl[0];
#pragma unroll
            for (int i = 1; i < 4; ++i) if (gl[i] > gm) { gm = gl[i]; gi = i; }
            float gsum = 0.f;
#pragma unroll
            for (int i = 0; i < 4; ++i) gsum += fexp(gl[i] - gm);
            const float gtop = 1.0f / gsum;
            float el[8];
#pragma unroll
            for (int i = 0; i < 8; ++i) el[i] = lg[4 + gi * 8 + i] + be[gi * 8 + i];
            int j1 = 0; float m1 = el[0];
#pragma unroll
            for (int i = 1; i < 8; ++i) if (el[i] > m1) { m1 = el[i]; j1 = i; }
            int j2 = -1; float m2 = -INFINITY;
#pragma unroll
            for (int i = 0; i < 8; ++i) if (i != j1 && el[i] > m2) { m2 = el[i]; j2 = i; }
            if (j2 < 0) { j2 = (j1 == 0) ? 1 : 0; m2 = m1; }
            const float e2 = fexp(m2 - m1);
            const float g1 = gtop / (1.0f + e2), g2 = gtop * e2 / (1.0f + e2);
            const int x1 = gi * 8 + j1, x2 = gi * 8 + j2;
            const unsigned p1 = atomicAdd(&cnt[x1], 1u), p2 = atomicAdd(&cnt[x2], 1u);
            u32x4 a; a.x = (unsigned)x1; a.y = (unsigned)x2; a.z = p1; a.w = p2;
            *(u32x4*)(route + (size_t)t * 8) = a;
            route[(size_t)t * 8 + 4] = __float_as_uint(g1); route[(size_t)t * 8 + 5] = __float_as_uint(g2);
        }
#pragma unroll 1
        for (int r4b = 0; r4b < 16; r4b += 4) {
            f32x4 v[4][8];
#pragma unroll
            for (int ri = 0; ri < 4; ++ri)
#pragma unroll
                for (int jj = 0; jj < 8; ++jj) v[ri][jj] = *(const f32x4*)(F.h + (t0 + r4b + ri) * D + 4 * (lane + 64 * jj));
#pragma unroll
            for (int ri = 0; ri < 4; ++ri) {
                const float rj = __shfl(rs, r4b + ri);
                bf16_t* urow = F.U + (t0 + r4b + ri) * D;
#pragma unroll
                for (int jj = 0; jj < 8; ++jj) {
                    const int c = 4 * (lane + 64 * jj);
                    const f32x4 wv = *(const f32x4*)(nw + c);
                    u32x2 pk; pk.x = cvt_pk_bf16(v[ri][jj][0] * rj * wv[0], v[ri][jj][1] * rj * wv[1]); pk.y = cvt_pk_bf16(v[ri][jj][2] * rj * wv[2], v[ri][jj][3] * rj * wv[3]);
                    *(u32x2*)(urow + c) = pk;
                }
            }
        }
    }
}


__device__ __forceinline__ void phase_router3(const Frame& F, int l) {
    const int tid = opaque_tid(); const int lane = tid & 63, w = __builtin_amdgcn_readfirstlane(tid >> 6);
    const int r = lane & 15, q = lane >> 4;
    const float* WRT = (const float*)(F.ws + WS_WRT) + (size_t)l * 48 * 2048;
    const float* nw = F.in[I_NFFN] + (size_t)l * D;
    const float* bg = F.in[I_RGB] + l * 4; const float* be = F.in[I_REB] + l * 32;
    unsigned* cnt = F.ctl + CW_CNT + l * 32;
    unsigned* route = (unsigned*)(F.tab + TAB_ROUTE);
    float* As = (float*)F.lds; float* Bs = As + 64 * 260; float* Cs = Bs + 48 * 260;
    float* Lg = As;
    const int tile = w & 3, kh = w >> 2;
    const int lr = tid >> 6, lc = (tid & 63) * 4;
    for (int g = F.bid; g < NTOK / 64; g += F.G) {
        const size_t t0 = (size_t)g * 64;
        f32x4 va[8], vb[6], vn;
        vn = *(const f32x4*)(nw + lc);
#pragma unroll
        for (int it = 0; it < 8; ++it) va[it] = *(const f32x4*)(F.h + (t0 + lr + 8 * it) * D + lc);
#pragma unroll
        for (int it = 0; it < 6; ++it) vb[it] = *(const f32x4*)(WRT + (size_t)(lr + 8 * it) * 2048 + lc);
        f32x4 acc[3]; acc[0] = (f32x4){0.f, 0.f, 0.f, 0.f}; acc[1] = acc[0]; acc[2] = acc[0];
        float ss = 0.f;
#pragma unroll 1
        for (int s = 0; s < 8; ++s) {
            LDS_BARRIER();
#pragma unroll
            for (int it = 0; it < 8; ++it) *(f32x4*)(As + (lr + 8 * it) * 260 + lc) = va[it];
#pragma unroll
            for (int it = 0; it < 6; ++it) *(f32x4*)(Bs + (lr + 8 * it) * 260 + lc) = vb[it];
            LDS_BARRIER();
#pragma unroll
            for (int it = 0; it < 8; ++it) {
                u32x2 pk; pk.x = cvt_pk_bf16(va[it][0] * vn[0], va[it][1] * vn[1]); pk.y = cvt_pk_bf16(va[it][2] * vn[2], va[it][3] * vn[3]);
                *(u32x2*)(F.U + (t0 + lr + 8 * it) * D + 256 * s + lc) = pk;
            }
            if (s < 7) {
                const int c0 = 256 * (s + 1) + lc;
                vn = *(const f32x4*)(nw + c0);
#pragma unroll
                for (int it = 0; it < 8; ++it) va[it] = *(const f32x4*)(F.h + (t0 + lr + 8 * it) * D + c0);
#pragma unroll
                for (int it = 0; it < 6; ++it) vb[it] = *(const f32x4*)(WRT + (size_t)(lr + 8 * it) * 2048 + c0);
            }
            const float* ap = As + (16 * tile + r) * 260 + 4 * q + kh * 128; const float* bp = Bs + r * 260 + 4 * q + kh * 128;
#pragma unroll
            for (int kg = 0; kg < 8; ++kg) {
                const f32x4 a4 = *(const f32x4*)(ap + 16 * kg);
                ss += a4[0] * a4[0] + a4[1] * a4[1] + a4[2] * a4[2] + a4[3] * a4[3];
#pragma unroll
                for (int n = 0; n < 3; ++n) {
                    const f32x4 b4 = *(const f32x4*)(bp + n * 16 * 260 + 16 * kg);
#pragma unroll
                    for (int s2 = 0; s2 < 4; ++s2) acc[n] = __builtin_amdgcn_mfma_f32_16x16x4f32(a4[s2], b4[s2], acc[n], 0, 0, 0);
                }
            }
        }
        if (kh == 1) {
            float* c = Cs + (tile * 64 + lane) * 13;
#pragma unroll
            for (int n = 0; n < 3; ++n)
#pragma unroll
                for (int j = 0; j < 4; ++j) c[n * 4 + j] = acc[n][j];
            c[12] = ss;
        }
        LDS_BARRIER();
        if (kh == 0) {
            const float* c = Cs + (tile * 64 + lane) * 13;
#pragma unroll
            for (int n = 0; n < 3; ++n)
#pragma unroll
                for (int j = 0; j < 4; ++j) acc[n][j] += c[n * 4 + j];
            ss += c[12];
            ss += __shfl_xor(ss, 16); ss += __shfl_xor(ss, 32);
            const float rs = rsqrtf(ss * (1.0f / D) + NORM_EPS);
#pragma unroll
            for (int j = 0; j < 4; ++j) {
                const float rj = __shfl(rs, 4 * q + j);
#pragma unroll
                for (int n = 0; n < 3; ++n) Lg[(16 * tile + 4 * q + j) * 48 + n * 16 + r] = acc[n][j] * rj;
            }
            if (lane < 16) {
                const float* lg = Lg + (16 * tile + lane) * 48; const int t = (int)t0 + 16 * tile + lane;
                float gl[4];
#pragma unroll
                for (int i = 0; i < 4; ++i) gl[i] = lg[i] + bg[i];
                int gi = 0; float gm = gl[0];
#pragma unroll
                for (int i = 1; i < 4; ++i) if (gl[i] > gm) { gm = gl[i]; gi = i; }
                float gsum = 0.f;
#pragma unroll
                for (int i = 0; i < 4; ++i) gsum += fexp(gl[i] - gm);
                const float gtop = 1.0f / gsum;
                float el[8];
#pragma unroll
                for (int i = 0; i < 8; ++i) el[i] = lg[4 + gi * 8 + i] + be[gi * 8 + i];
                int j1 = 0; float m1 = el[0];
#pragma unroll
                for (int i = 1; i < 8; ++i) if (el[i] > m1) { m1 = el[i]; j1 = i; }
                int j2 = -1; float m2 = -INFINITY;
#pragma unroll
                for (int i = 0; i < 8; ++i) if (i != j1 && el[i] > m2) { m2 = el[i]; j2 = i; }
                if (j2 < 0) { j2 = (j1 == 0) ? 1 : 0; m2 = m1; }
                const float e2 = fexp(m2 - m1);
                const float g1 = gtop / (1.0f + e2), g2 = gtop * e2 / (1.0f + e2);
                const int x1 = gi * 8 + j1, x2 = gi * 8 + j2;
                const unsigned p1 = atomicAdd(&cnt[x1], 1u), p2 = atomicAdd(&cnt[x2], 1u);
                u32x4 a; a.x = (unsigned)x1; a.y = (unsigned)x2; a.z = p1; a.w = p2;
                *(u32x4*)(route + (size_t)t * 8) = a;
                route[(size_t)t * 8 + 4] = __float_as_uint(g1); route[(size_t)t * 8 + 5] = __float_as_uint(g2); route[(size_t)t * 8 + 6] = __float_as_uint(rs);
            }
        }
    }
}

__device__ __forceinline__ void phase_tables(const Frame& F, int l) {
    const int tid = opaque_tid(); const int lane = tid & 63;
    int* pst = (int*)F.lds;
    const unsigned* cnt = F.ctl + CW_CNT + l * 32;
    int* slot_tok = (int*)(F.tab + TAB_SLOTTOK);
    if (tid < 32) pst[32 + tid] = (int)__hip_atomic_load(&cnt[tid], __ATOMIC_RELAXED, __HIP_MEMORY_SCOPE_AGENT);
    __syncthreads();
    if (tid == 0) {
        int* tile_exp = (int*)(F.tab + TAB_TILEEXP); int* ntiles = (int*)(F.tab + TAB_NTILES);
        int off = 0, nt = 0;
        for (int e = 0; e < NEXP; ++e) {
            pst[e] = off; const int tiles = (pst[32 + e] + 255) >> 8;
            if (F.bid == 0) for (int i = 0; i < tiles && nt < MAXTILE; ++i) tile_exp[nt + i] = e;
            nt += tiles; off += tiles * 256;
        }
        if (F.bid == 0) *ntiles = nt < MAXTILE ? nt : MAXTILE;
    }
    __syncthreads();
    if (F.bid == 0) {
        for (int e = 0; e < NEXP; ++e) { const int c = pst[32 + e], beg = pst[e] + c, end = pst[e] + (((c + 255) >> 8) << 8); for (int sidx = beg + tid; sidx < end; sidx += 512) if (sidx < MAXSLOT) { slot_tok[sidx] = 0; ((float*)(F.ws + WS_SLOTRS))[sidx] = 0.f; } }
    }
    const unsigned* route = (const unsigned*)(F.tab + TAB_ROUTE);
    int* tokslot = (int*)(F.tab + TAB_TOKSLOT); float* slotgate = (float*)(F.tab + TAB_SLOTGATE); float* slotrs = (float*)(F.ws + WS_SLOTRS);
    for (int t = F.bid * 512 + tid; t < NTOK; t += F.G * 512) {
        const u32x4 a = *(const u32x4*)(route + (size_t)t * 8);
        int s0 = pst[a.x & 31u] + (int)a.z, s1 = pst[a.y & 31u] + (int)a.w;
        s0 = min(max(s0, 0), MAXSLOT - 1); s1 = min(max(s1, 0), MAXSLOT - 1);
        tokslot[2 * t] = s0; tokslot[2 * t + 1] = s1; slot_tok[s0] = t; slot_tok[s1] = t;
        slotgate[s0] = __uint_as_float(route[(size_t)t * 8 + 4]); slotgate[s1] = __uint_as_float(route[(size_t)t * 8 + 5]);
        const float rsv = __uint_as_float(route[(size_t)t * 8 + 6]); slotrs[s0] = rsv; slotrs[s1] = rsv;
    }
    (void)lane;
}

__device__ __forceinline__ void phase_offsets(const Frame& F, int l) {
    const int tid_ = opaque_tid(); const int lane_ = tid_ & 63; const int wave_ = __builtin_amdgcn_readfirstlane(tid_ >> 6); (void)lane_; (void)wave_;
    if (F.bid == 0 && tid_ == 0) {
        const unsigned* cnt = F.ctl + CW_CNT + l * 32;
        int* padstart = (int*)(F.tab + TAB_PADSTART); int* tile_exp = (int*)(F.tab + TAB_TILEEXP); int* ntiles = (int*)(F.tab + TAB_NTILES);
        int off = 0, nt = 0;
        for (int e = 0; e < NEXP; ++e) {
            const int c = (int)__hip_atomic_load(&cnt[e], __ATOMIC_RELAXED, __HIP_MEMORY_SCOPE_AGENT);
            padstart[e] = off;
            const int tiles = (c + 255) >> 8;
            for (int i = 0; i < tiles && nt < MAXTILE; ++i) tile_exp[nt++] = e;
            off += tiles * 256;
        }
        *ntiles = nt;
    }
}

__device__ __forceinline__ void phase_scatter(const Frame& F) {
    const int tid_ = opaque_tid(); const int lane_ = tid_ & 63; const int wave_ = __builtin_amdgcn_readfirstlane(tid_ >> 6); (void)lane_; (void)wave_;
    const int gw = F.bid * 8 + wave_, nw = F.G * 8, lane = lane_;
    const unsigned* route = (const unsigned*)(F.tab + TAB_ROUTE); const int* padstart = (const int*)(F.tab + TAB_PADSTART);
    int* tokslot = (int*)(F.tab + TAB_TOKSLOT); float* slotgate = (float*)(F.tab + TAB_SLOTGATE);
    for (int t = gw; t < NTOK; t += nw) {
        const u32x4 a = *(const u32x4*)(route + (size_t)t * 8);
        int s0 = padstart[a.x & 31u] + (int)a.z, s1 = padstart[a.y & 31u] + (int)a.w;
        s0 = min(max(s0, 0), MAXSLOT - 1); s1 = min(max(s1, 0), MAXSLOT - 1);
        if (lane == 0) { tokslot[2 * t] = s0; tokslot[2 * t + 1] = s1; slotgate[s0] = __uint_as_float(route[(size_t)t * 8 + 4]); slotgate[s1] = __uint_as_float(route[(size_t)t * 8 + 5]); }
        const u32x4* src = (const u32x4*)(F.U + (size_t)t * D);
        u32x4* d0 = (u32x4*)(F.XPERM + (size_t)s0 * D); u32x4* d1 = (u32x4*)(F.XPERM + (size_t)s1 * D);
#pragma unroll
        for (int i = 0; i < 4; ++i) { const u32x4 x = src[lane + 64 * i]; d0[lane + 64 * i] = x; d1[lane + 64 * i] = x; }
    }
}

constexpr int PH_PER_LAYER = 10, N_PHASES = 1 + DEPTH * PH_PER_LAYER;

__global__ void __launch_bounds__(512, 2) mega(Args args) {
    extern __shared__ __attribute__((aligned(16))) unsigned char lds[];
    Frame F;
    F.in = args.in; F.h = args.out; F.ws = args.ws; F.lds = lds;
    F.G = gridDim.x; F.bid = blockIdx.x;
    F.ctl = (unsigned*)(args.ws + WS_CTL); F.tab = args.ws + WS_TAB;
    F.P = BfPtr{(const bf16_t*)(args.ws + WS_R1)}; F.Pw = (bf16_t*)(args.ws + WS_R1); F.Y = (bf16_t*)(args.ws + WS_R1); F.HID = (bf16_t*)(args.ws + WS_R1 + R1_HID);
    F.Q = (float*)(args.ws + WS_R2); F.XPERM = (bf16_t*)(args.ws + WS_R2); F.O = (float*)(args.ws + WS_R3);
    F.U = (bf16_t*)(args.ws + WS_U); F.MIX = (bf16_t*)(args.ws + WS_MIX);
    LAS unsigned char* ldsl = (LAS unsigned char*)lds;
    volatile LAS unsigned* misc = (volatile LAS unsigned*)(ldsl + LDS_MISC);
    if (threadIdx.x < 16) misc[threadIdx.x] = 0u;
    __syncthreads();
    const int lo = args.ph_lo, hi = args.ph_hi;
    XcdBarrier bar; bar.bar = F.ctl + CW_BAR; bar.x = 0; bar.st = misc;
    if (hi - lo > 1) bar = xcd_barrier_post(F.ctl + CW_BAR, misc);
#define IN(k) (lo <= (k) && (k) < hi)

    int ph = 0;
#ifndef PROBE_GROUP
#define PROBE_GROUP 0
#endif
#define PHASE_BEGIN if (IN(ph)) {
#define PHASE_BEGIN_R(g) if (IN(ph)) { for (int rep_ = 0; rep_ < 1 + (PROBE_GROUP == (g)); ++rep_) {
#define PHASE_END_R } PHASE_END
#define PHASE_END } if (IN(ph) && IN(ph + 1)) xcd_barrier(bar); ++ph;
    PHASE_BEGIN_R(1) phase_prologue(F); __syncthreads(); phase_norm1(F, 0, F.in[I_NMIX]); PHASE_END_R
    for (int l = 0; l < DEPTH; ++l) {
        if (l > 0) { PHASE_BEGIN phase_norm1(F, 1, F.in[I_NMIX] + (size_t)l * D); PHASE_END }
        PHASE_BEGIN_R(2)
            pg8::Gemm g{F.U, (const bf16_t*)(F.ws + WS_WIN) + (size_t)l * PS * D, D, 0, nullptr};
            pg8::StaticOrder S; S.init(NTOK, PS, F.G, F.bid);
            pg8::EpiBf E{F.Pw, PS};
            pg8::gemm_phase(ldsl, g, S, E);
            { const int rem = S.nwg % F.G;
              if (rem > 0 && F.bid >= rem) { __syncthreads(); const int tid_ = opaque_tid();
                  for (int i = F.bid - rem; i < DEFER_GEMM / 2; i += F.G - rem) conv_down_tile(F, 64 * 16 * 8 - DEFER_TILES - DEFER_GEMM + l * (DEFER_GEMM / 2) + i, tid_); }
              else if (rem == 0) { __syncthreads(); const int tid_ = opaque_tid();
                  for (int i = F.bid; i < DEFER_GEMM / 2; i += F.G) conv_down_tile(F, 64 * 16 * 8 - DEFER_TILES - DEFER_GEMM + l * (DEFER_GEMM / 2) + i, tid_); } }
        PHASE_END_R
        PHASE_BEGIN_R(4) phase_front(F, l); PHASE_END_R
        PHASE_BEGIN phase_m2(F, l); PHASE_END
        PHASE_BEGIN_R(6) phase_back(F, l); PHASE_END_R
        PHASE_BEGIN
            pg8::Gemm g{F.MIX, (const bf16_t*)(F.ws + WS_WOUT) + (size_t)l * D * D, D, 0, nullptr};
            pg8::StaticOrder S; S.init(NTOK, D, F.G, F.bid);
            pg8::EpiRes E{l == 0 ? F.in[I_X] : F.h, F.h, D};
            pg8::gemm_phase(ldsl, g, S, E);
        PHASE_END
        PHASE_BEGIN phase_router3(F, l); PHASE_END
        PHASE_BEGIN phase_tables(F, l); PHASE_END
        PHASE_BEGIN_R(2)
            pg8::Gemm g{F.U, (const bf16_t*)(F.ws + WS_WGU) + (size_t)l * NEXP * 2048 * 2048, D, (size_t)2048 * 2048 * 2, (const int*)(F.tab + TAB_SLOTTOK)};
            pg8::MoeOrder S{*(const int*)(F.tab + TAB_NTILES), (const int*)(F.tab + TAB_TILEEXP), 8, F.G, F.bid};
            pg8::EpiGU E{F.HID, (const float*)(F.ws + WS_SLOTRS)};
            pg8::gemm_phase<pg8::EpiGU, pg8::MoeOrder, true>(ldsl, g, S, E);
        PHASE_END_R
        PHASE_BEGIN_R(2)
            pg8::Gemm g{F.HID, (const bf16_t*)(F.ws + WS_WD) + (size_t)l * NEXP * 2048 * 1024, DEXP, (size_t)2048 * 1024 * 2, nullptr};
            pg8::MoeOrder S{*(const int*)(F.tab + TAB_NTILES), (const int*)(F.tab + TAB_TILEEXP), 8, F.G, F.bid};
            pg8::EpiDown E{F.Y, (const float*)(F.tab + TAB_SLOTGATE)};
            pg8::gemm_phase(ldsl, g, S, E);
        PHASE_END_R
    }
    PHASE_BEGIN phase_norm1(F, 2, F.in[I_NFIN]); PHASE_END
#undef PHASE_BEGIN
#undef PHASE_END
#undef IN
}

extern "C" void kernel_launch(void* const* d_in, const int* in_sizes, int n_in, void* d_out, int out_size, void* d_ws, size_t ws_size, hipStream_t stream) {
    static int grid = 0;
    if (grid == 0) {
        if (n_in != NIN || out_size != NTOK * D || ws_size < WS_END) { fprintf(stderr, "kernel_launch: unexpected shapes (n_in %d, out %d, ws %zu < %zu)\n", n_in, out_size, ws_size, (size_t)WS_END); grid = -1; return; }
        int dev = 0, cus = 0;
        if (hipGetDevice(&dev) != hipSuccess || hipDeviceGetAttribute(&cus, hipDeviceAttributeMultiprocessorCount, dev) != hipSuccess) { grid = -1; return; }
        if (hipFuncSetAttribute((const void*)mega, hipFuncAttributeMaxDynamicSharedMemorySize, LDS_BYTES) != hipSuccess) { fprintf(stderr, "kernel_launch: hipFuncSetAttribute failed\n"); grid = -1; return; }
        int per_cu = 0;
        if (hipOccupancyMaxActiveBlocksPerMultiprocessor(&per_cu, (const void*)mega, 512, LDS_BYTES) != hipSuccess || per_cu < 1) fprintf(stderr, "kernel_launch: occupancy query says %d\n", per_cu);
        (void)hipGetLastError();
        grid = cus;
    }
    if (grid < 0) return;
    (void)hipMemsetAsync((char*)d_ws + WS_CTL, 0, CTL_BYTES, stream);
    Args a{};
    for (int i = 0; i < NIN; ++i) a.in[i] = (const float*)d_in[i];
    a.out = (float*)d_out; a.ws = (unsigned char*)d_ws;
#if MK_MULTI
    for (int p = 0; p < N_PHASES; ++p) { a.ph_lo = p; a.ph_hi = p + 1; hipLaunchKernelGGL(mega, dim3(grid), dim3(512), LDS_BYTES, stream, a); }
#else
    a.ph_lo = 0; a.ph_hi = N_PHASES;
    hipLaunchKernelGGL(mega, dim3(grid), dim3(512), LDS_BYTES, stream, a);
#endif
}
```

```cpp
#include <hip/hip_runtime.h>
#include <stdint.h>
#include <stdio.h>

#ifndef MK_MULTI
#define MK_MULTI 0
#endif

#define LAS __attribute__((address_space(3)))
#define LDS_BARRIER() do { asm volatile("s_waitcnt lgkmcnt(0)" ::: "memory"); __builtin_amdgcn_s_barrier(); asm volatile("" ::: "memory"); } while (0)
typedef unsigned short bf16_t;
typedef short bf16x8 __attribute__((ext_vector_type(8)));
typedef float f32x4 __attribute__((ext_vector_type(4)));
typedef unsigned u32x4 __attribute__((ext_vector_type(4)));
typedef unsigned u32x2 __attribute__((ext_vector_type(2)));

constexpr int D = 2048, SEQ = 4096, NTOK = 16384, DEPTH = 2, GW = 512;
constexpr int IN_COLS = 6600, PS = 6656;
constexpr int C_HG_Q = 0, C_HG_F = 512, C_HG_I = 1024, C_HG_G = 1536;
constexpr int C_SS_Z = 2048, C_SS_X = 2560, C_SS_DT = 3584;
constexpr int C_RG_G = 3592, C_RG_X = 4104;
constexpr int C_RW = 4616;
constexpr int RW_COLS = 1984;
constexpr int QS = 5120;
constexpr int Q_RGA = 512, Q_RGU = 1024, Q_R = 1536, Q_W = 2048, Q_K = 2560, Q_V = 3072, Q_KK = 3584, Q_KKA = 4096, Q_G = 4608;
constexpr int NEXP = 32, DEXP = 1024;
constexpr int MAXSLOT = 40960, MAXTILE = 160;
constexpr float NORM_EPS = 1e-6f;

constexpr size_t al256(size_t x) { return (x + 255) & ~(size_t)255; }
constexpr size_t WS_CTL = 0;
constexpr size_t CTL_BYTES = 65536;
constexpr size_t WS_TAB = WS_CTL + CTL_BYTES;
constexpr size_t TAB_ROUTE = 0;
constexpr size_t TAB_TOKSLOT = TAB_ROUTE + (size_t)NTOK * 32;
constexpr size_t TAB_SLOTGATE = TAB_TOKSLOT + (size_t)NTOK * 8;
constexpr size_t TAB_PADSTART = TAB_SLOTGATE + (size_t)MAXSLOT * 4;
constexpr size_t TAB_TILEEXP = TAB_PADSTART + 256;
constexpr size_t TAB_NTILES = TAB_TILEEXP + 1024;
constexpr size_t TAB_SLOTTOK = TAB_NTILES + 256;
constexpr size_t TAB_BYTES = al256(TAB_SLOTTOK + (size_t)MAXSLOT * 4);
constexpr size_t WS_WIN = al256(WS_TAB + TAB_BYTES);
constexpr size_t WS_WOUT = WS_WIN + (size_t)2 * PS * D * 2;
constexpr size_t WS_WGU = WS_WOUT + (size_t)2 * D * D * 2;
constexpr size_t WS_WD = WS_WGU + (size_t)2 * NEXP * 2048 * 2048 * 2;
constexpr size_t WS_U = WS_WD + (size_t)2 * NEXP * 2048 * 1024 * 2;
constexpr size_t WS_MIX = WS_U + (size_t)NTOK * D * 2;
constexpr size_t WS_R1 = WS_MIX + (size_t)NTOK * D * 2;
constexpr size_t R1_HID = (size_t)MAXSLOT * D * 2;
constexpr size_t R1_BYTES = R1_HID + (size_t)MAXSLOT * DEXP * 2;
static_assert((size_t)NTOK * PS * 2 <= R1_BYTES, "R1 alias");
constexpr size_t WS_R2 = WS_R1 + R1_BYTES;
constexpr size_t R2_BYTES = (size_t)NTOK * QS * 4;
static_assert((size_t)MAXSLOT * D * 2 <= R2_BYTES, "R2 alias");
constexpr size_t WS_R3 = WS_R2 + R2_BYTES;
constexpr size_t WS_R4 = WS_R3 + (size_t)NTOK * D * 4;
constexpr size_t R4_HGS = 0;
constexpr size_t R4_SSS = R4_HGS + (size_t)16 * 64 * 16384 * 4;
constexpr size_t R4_HGD = R4_SSS + (size_t)32 * 64 * 8192 * 4;
constexpr size_t R4_SSD = R4_HGD + (size_t)16 * 64 * 128 * 4;
constexpr size_t R4_RGC = R4_SSD + (size_t)32 * 64 * 4;
constexpr size_t WS_RWAAB = al256(WS_R4 + R4_RGC + (size_t)4 * 64 * 512 * 2 * 4);
constexpr size_t WS_RWGC = WS_RWAAB + (size_t)2048 * 4096 * 4;
constexpr size_t WS_SW = WS_RWGC + (size_t)2048 * 64 * 4;
constexpr size_t SW_W2T = 0, SW_A2T = SW_W2T + 512 * 96 * 2, SW_G2T = SW_A2T + 512 * 96 * 2, SW_WAT = SW_G2T + 512 * 256 * 2, SW_WXT = SW_WAT + 8 * 64 * 64 * 2, SW_LAYER = SW_WXT + 8 * 64 * 64 * 2;
constexpr size_t WS_WRT = al256(WS_SW + 2 * SW_LAYER);
constexpr size_t WS_BON = al256(WS_WRT + (size_t)2 * 48 * 2048 * 4);
constexpr size_t WS_SLOTRS = al256(WS_BON + (size_t)NTOK * 8 * 4);
constexpr size_t WS_END = WS_SLOTRS + (size_t)MAXSLOT * 4;
constexpr size_t RW_REC = 65536;
constexpr int RO_AR = 0, RO_RR = 8192, RO_BRT = 16384, RO_ARBT = 24576, RO_TT = 32768, RO_XL = 40960, RO_LT = 49152, RO_YL = 57344;
static_assert(WS_MIX == WS_U + (size_t)NTOK * D * 2 && (size_t)2048 * RW_REC <= (size_t)2 * NTOK * D * 2, "RW record region");

constexpr int CW_BAR = 0;
constexpr int CW_CNT = 4096;

typedef __bf16 bf16v2 __attribute__((ext_vector_type(2)));
typedef float f32x2 __attribute__((ext_vector_type(2)));
__device__ __forceinline__ unsigned cvt_pk_bf16(float lo, float hi) { const f32x2 v = {lo, hi}; const bf16v2 b = __builtin_convertvector(v, bf16v2); return __builtin_bit_cast(unsigned, b); }
__device__ __forceinline__ u32x4 pair16(const f32x4 a0, const f32x4 a1) {
    const auto sx = __builtin_amdgcn_permlane16_swap(cvt_pk_bf16(a0[0], a0[1]), cvt_pk_bf16(a1[0], a1[1]), false, false);
    const auto sy = __builtin_amdgcn_permlane16_swap(cvt_pk_bf16(a0[2], a0[3]), cvt_pk_bf16(a1[2], a1[3]), false, false);
    u32x4 w; w.x = sx[0]; w.y = sy[0]; w.z = sx[1]; w.w = sy[1]; return w;
}
__device__ __forceinline__ int pair16_col(int lane) { const int q = lane >> 4; return 8 * (q >> 1) + 16 * (q & 1); }
__device__ __forceinline__ bf16_t f2bf(float f) { return (bf16_t)(cvt_pk_bf16(f, 0.0f) & 0xffffu); }
#define DPP_ADD(v, ctrl, rmask, bc) ((v) + __uint_as_float(__builtin_amdgcn_update_dpp(0u, __float_as_uint(v), (ctrl), (rmask), 0xf, (bc))))
__device__ __forceinline__ float row16_sum(float v) {
    v = DPP_ADD(v, 0xB1, 0xf, true); v = DPP_ADD(v, 0x4E, 0xf, true); v = DPP_ADD(v, 0x141, 0xf, true); v = DPP_ADD(v, 0x140, 0xf, true);
    return v;
}
__device__ __forceinline__ float wave_sum(float v) {
    v = row16_sum(v);
    v = DPP_ADD(v, 0x142, 0xa, false);
    v = DPP_ADD(v, 0x143, 0xc, false);
    return __int_as_float(__builtin_amdgcn_readlane(__float_as_int(v), 63));
}
__device__ __forceinline__ float fexp(float x) { return __expf(x); }
__device__ __forceinline__ float flog(float x) { return __logf(x); }
__device__ __forceinline__ float frcp(float x) { return __builtin_amdgcn_rcpf(x); }
__device__ __forceinline__ float sigmoid_f(float x) { return frcp(1.0f + fexp(-x)); }
__device__ __forceinline__ float silu_f(float x) { return x * sigmoid_f(x); }
__device__ __forceinline__ float softplus_f(float x) { return fmaxf(x, 0.f) + flog(1.0f + fexp(-fabsf(x))); }
__device__ __forceinline__ float ftanh(float x) { const float e = fexp(-2.0f * fabsf(x)); const float t = (1.0f - e) * frcp(1.0f + e); return x < 0.f ? -t : t; }
__device__ __forceinline__ float gelu_tanh_f(float x) { const float u = 0.7978845608028654f * (x + 0.044715f * x * x * x); return 0.5f * x * (1.0f + ftanh(u)); }

__device__ __forceinline__ int opaque_tid() { int t = threadIdx.x; asm volatile("" : "+v"(t)); return t; }

#define XB_TMO      128
#define XB_XCNT(j)  (256  + 64 * (j))
#define XB_XSUB(j)  (1280 + 64 * (j))
#define XB_XGEN(j)  (2304 + 64 * (j))
#define XB_TOP      3328
#define XB_TOPGEN   3392
#define XCD_BAR_WORDS 3456
#define XB_SPIN_CAP (1u << 18)
__device__ __forceinline__ unsigned xb_ld(unsigned* p)              { return __hip_atomic_load(p, __ATOMIC_RELAXED, __HIP_MEMORY_SCOPE_AGENT); }
__device__ __forceinline__ unsigned xb_add(unsigned* p, unsigned v) { return __hip_atomic_fetch_add(p, v, __ATOMIC_RELAXED, __HIP_MEMORY_SCOPE_AGENT); }
__device__ __forceinline__ unsigned xb_xcc_id() { return (unsigned)__builtin_amdgcn_s_getreg((3 << 11) | 20) & 0xFu; }
#define XB_SPIN(cond, bar) do { unsigned _sp = 0; while (cond) { __builtin_amdgcn_s_sleep(1); \
    if ((++_sp & 255u) == 0u) { if (xb_ld(&(bar)[XB_TMO])) break; if (_sp > XB_SPIN_CAP) { atomicAdd(&(bar)[XB_TMO], 1u); break; } } } } while (0)
struct XcdBarrier { unsigned* bar; unsigned x; volatile LAS unsigned* st; };
__device__ __forceinline__ XcdBarrier xcd_barrier_post(unsigned* bar, volatile LAS unsigned* st) {
    XcdBarrier b; b.bar = bar; b.x = xb_xcc_id(); b.st = st;
    if (threadIdx.x == 0) (void)xb_add(&bar[XB_XCNT(b.x)], 1u);
    return b;
}
__device__ __forceinline__ void xcd_barrier_complete(unsigned* bar, unsigned x, unsigned& nloc, unsigned& nx) {
    const unsigned G = gridDim.x * gridDim.y * gridDim.z;
    unsigned sum, cnt, mine, sp = 0u;
    for (;;) {
        sum = 0u; cnt = 0u; mine = 0u;
#pragma unroll
        for (unsigned j = 0; j < 16; ++j) { const unsigned c = xb_ld(&bar[XB_XCNT(j)]); sum += c; cnt += (c > 0u) ? 1u : 0u; mine = (j == x) ? c : mine; }
        if (sum == G) break;
        __builtin_amdgcn_s_sleep(1);
        if ((++sp & 255u) == 0u) { if (xb_ld(&bar[XB_TMO])) break; if (sp > XB_SPIN_CAP) { atomicAdd(&bar[XB_TMO], 1u); break; } }
    }
    nloc = mine > 0u ? mine : 1u; nx = cnt > 0u ? cnt : 1u;
}
__device__ __forceinline__ void xcd_barrier(const XcdBarrier& b) {
    asm volatile("s_waitcnt vmcnt(0)" ::: "memory");
    __syncthreads();
    if (threadIdx.x == 0) {
        unsigned* bar = b.bar;
        __builtin_amdgcn_s_waitcnt(0);
        unsigned nloc = b.st[0], nx = b.st[1];
        if (nloc == 0u) { xcd_barrier_complete(bar, b.x, nloc, nx); b.st[0] = nloc; b.st[1] = nx; }
        const unsigned old = xb_add(&bar[XB_XSUB(b.x)], 1u);
        const unsigned gen = old / nloc;
        if (old + 1u == (gen + 1u) * nloc) {
            __builtin_amdgcn_fence(__ATOMIC_RELEASE, "agent");
            asm volatile("s_waitcnt vmcnt(0)" ::: "memory");
            const unsigned og = xb_add(&bar[XB_TOP], 1u);
            const unsigned tg = og / nx;
            if (og + 1u == (tg + 1u) * nx) xb_add(&bar[XB_TOPGEN], 1u);
            else XB_SPIN(xb_ld(&bar[XB_TOPGEN]) == tg, bar);
            __builtin_amdgcn_fence(__ATOMIC_ACQUIRE, "agent");
            xb_add(&bar[XB_XGEN(b.x)], 1u);
            asm volatile("s_waitcnt vmcnt(0)" ::: "memory");
        } else {
            XB_SPIN(xb_ld(&bar[XB_XGEN(b.x)]) == gen, bar);
            __builtin_amdgcn_fence(__ATOMIC_ACQUIRE, "agent");
            asm volatile("s_waitcnt vmcnt(0)" ::: "memory");
        }
    }
    __syncthreads();
}

namespace pg8 {
constexpr int BM = 256, BK = 64, HALF = 128, HTB = HALF * BK * 2, STAGE_BYTES = 8 * HTB, NXCD = 8;
__host__ __device__ __forceinline__ int lds_byte(int r, int c) { const int st = (r >> 4) * 2 + (c >> 5), rr = r & 15, cc = c & 31, ob = rr * 64 + cc * 2; return st * 1024 + (ob ^ (((ob >> 9) & 1) << 5)); }
__host__ __device__ __forceinline__ void stage_rc(int b, int& R, int& C) { const int st = b / 1024, sb = b % 1024, swz = sb ^ (((sb >> 9) & 1) << 5); R = (st >> 1) * 16 + swz / 64; C = (st & 1) * 32 + (swz % 64) / 2; }

struct Unit { int pm, pn, e; };
struct Gemm { const bf16_t* A; const bf16_t* Bt; int K; size_t ebytes; const int* rowmap; };

struct StaticOrder {
    int nM, nN, nwg, G, c, WGM;
    __device__ void init(int M, int N, int G_, int c_, int wgm = 4) { nM = M / BM; nN = N / BM; nwg = nM * nN; G = G_; c = c_; WGM = wgm; }
    __device__ bool next(int i, Unit& u) const {
        const long L = (long)i * G + c; if (L >= nwg) return false;
        int wgid = (int)L; { const int q = nwg / NXCD, r = nwg % NXCD, xcd = wgid % NXCD, off = wgid / NXCD; wgid = (xcd < r ? xcd * (q + 1) : r * (q + 1) + (xcd - r) * q) + off; }
        const int nig = WGM * nN, gid = wgid / nig, fm = gid * WGM, gsz = (nM - fm) < WGM ? (nM - fm) : WGM;
        u.pm = fm + ((wgid % nig) % gsz); u.pn = (wgid % nig) / gsz; u.e = 0; return true;
    }
};
struct MoeOrder {
    int nt; const int* tile_exp; int nN, G, c;
    __device__ bool next(int i, Unit& u) const {
        int t, pn;
        if ((G & 255) == 0 && nN == 8) { const int x = c & 7, idx = c >> 3, per = G >> 8;
            const int grp = idx >> 5;
            t = 4 * ((i * per + grp) * 8 + x) + ((idx & 31) >> 3); pn = idx & 7; (void)per; }
        else { const long L = (long)i * G + c; t = (int)(L / nN); pn = (int)(L % nN); }
        const bool ok = t < nt;
        u.pm = ok ? t : 0; u.pn = ok ? pn : 0; u.e = tile_exp[u.pm]; return ok;
    }
};

struct EpiBf {
    bf16_t* C; int ldc;
    __device__ __forceinline__ void operator()(const f32x4 (&acc)[2][2][4][2], const Unit& u, int wr, int wc, int fr, int fq) const {
        const int row0 = u.pm * BM + wr * 64 + fr, col0 = u.pn * BM + wc * 32 + 8 * (fq >> 1) + 16 * (fq & 1);
#pragma unroll
        for (int ai = 0; ai < 2; ++ai)
#pragma unroll
            for (int m = 0; m < 4; ++m) { bf16_t* rowp = C + (size_t)(row0 + ai * HALF + m * 16) * ldc + col0;
#pragma unroll
                for (int bj = 0; bj < 2; ++bj) {
                    const f32x4 v0 = acc[ai][bj][m][0], v1 = acc[ai][bj][m][1];
                    const auto sx = __builtin_amdgcn_permlane16_swap(cvt_pk_bf16(v0[0], v0[1]), cvt_pk_bf16(v1[0], v1[1]), false, false);
                    const auto sy = __builtin_amdgcn_permlane16_swap(cvt_pk_bf16(v0[2], v0[3]), cvt_pk_bf16(v1[2], v1[3]), false, false);
                    u32x4 w; w.x = sx[0]; w.y = sy[0]; w.z = sx[1]; w.w = sy[1];
                    *(u32x4*)(rowp + bj * HALF) = w; } }
    }
};
struct EpiRes {
    const float* Hsrc; float* H; int ldc;
    __device__ __forceinline__ void operator()(const f32x4 (&acc)[2][2][4][2], const Unit& u, int wr, int wc, int fr, int fq) const {
        const int row0 = u.pm * BM + wr * 64 + fr, col0 = u.pn * BM + wc * 32 + 4 * fq;
#pragma unroll
        for (int ai = 0; ai < 2; ++ai) {
            f32x4 r[4][2][2];
#pragma unroll
            for (int m = 0; m < 4; ++m) { const size_t off = (size_t)(row0 + ai * HALF + m * 16) * ldc + col0;
#pragma unroll
                for (int bj = 0; bj < 2; ++bj)
#pragma unroll
                    for (int n = 0; n < 2; ++n) r[m][bj][n] = *(const f32x4*)(Hsrc + off + bj * HALF + n * 16); }
#pragma unroll
            for (int m = 0; m < 4; ++m) { const size_t off = (size_t)(row0 + ai * HALF + m * 16) * ldc + col0;
#pragma unroll
                for (int bj = 0; bj < 2; ++bj)
#pragma unroll
                    for (int n = 0; n < 2; ++n) *(f32x4*)(H + off + bj * HALF + n * 16) = r[m][bj][n] + acc[ai][bj][m][n]; }
        }
    }
};
struct EpiGU {
    bf16_t* Hid; const float* rs;
    __device__ __forceinline__ void operator()(const f32x4 (&acc)[2][2][4][2], const Unit& u, int wr, int wc, int fr, int fq) const {
        const int row0 = u.pm * BM + wr * 64 + fr, col0 = u.pn * HALF + wc * 32 + 8 * (fq >> 1) + 16 * (fq & 1);
        float sc[2][4];
#pragma unroll
        for (int ai = 0; ai < 2; ++ai)
#pragma unroll
            for (int m = 0; m < 4; ++m) sc[ai][m] = rs[row0 + ai * HALF + m * 16];
#pragma unroll
        for (int ai = 0; ai < 2; ++ai)
#pragma unroll
            for (int m = 0; m < 4; ++m) { bf16_t* rowp = Hid + (size_t)(row0 + ai * HALF + m * 16) * DEXP + col0;
                unsigned px[2], py[2];
#pragma unroll
                for (int n = 0; n < 2; ++n) { const f32x4 g = acc[ai][0][m][n] * sc[ai][m], uu = acc[ai][1][m][n] * sc[ai][m]; float h[4];
#pragma unroll
                    for (int j = 0; j < 4; ++j) h[j] = g[j] * __builtin_amdgcn_rcpf(1.0f + __expf(-g[j])) * uu[j];
                    px[n] = cvt_pk_bf16(h[0], h[1]); py[n] = cvt_pk_bf16(h[2], h[3]); }
                const auto sx = __builtin_amdgcn_permlane16_swap(px[0], px[1], false, false);
                const auto sy = __builtin_amdgcn_permlane16_swap(py[0], py[1], false, false);
                u32x4 w; w.x = sx[0]; w.y = sy[0]; w.z = sx[1]; w.w = sy[1];
                *(u32x4*)rowp = w; }
    }
};
struct EpiDown {
    bf16_t* Y; const float* gate;
    __device__ __forceinline__ void operator()(const f32x4 (&acc)[2][2][4][2], const Unit& u, int wr, int wc, int fr, int fq) const {
        const int row0 = u.pm * BM + wr * 64 + fr, col0 = u.pn * BM + wc * 32 + 8 * (fq >> 1) + 16 * (fq & 1);
#pragma unroll
        for (int ai = 0; ai < 2; ++ai)
#pragma unroll
            for (int m = 0; m < 4; ++m) { const int row = row0 + ai * HALF + m * 16; const float gt = gate[row]; bf16_t* rowp = Y + (size_t)row * D + col0;
#pragma unroll
                for (int bj = 0; bj < 2; ++bj) {
                    const f32x4 v0 = acc[ai][bj][m][0] * gt, v1 = acc[ai][bj][m][1] * gt;
                    const auto sx = __builtin_amdgcn_permlane16_swap(cvt_pk_bf16(v0[0], v0[1]), cvt_pk_bf16(v1[0], v1[1]), false, false);
                    const auto sy = __builtin_amdgcn_permlane16_swap(cvt_pk_bf16(v0[2], v0[3]), cvt_pk_bf16(v1[2], v1[3]), false, false);
                    u32x4 w; w.x = sx[0]; w.y = sy[0]; w.z = sx[1]; w.w = sy[1];
                    *(u32x4*)(rowp + bj * HALF) = w; } }
    }
};

template <class Epi, class Sched, bool GATHER = false, bool SP2 = true, bool ALIGN_EPI = true>
__device__ __forceinline__ void gemm_phase(LAS unsigned char* lds, const Gemm g, const Sched& S, const Epi& E) {
    const int tid = opaque_tid(), wid = __builtin_amdgcn_readfirstlane(tid >> 6), lane = tid & 63, wr = wid >> 2, wc = wid & 3, fr = lane & 15, fq = lane >> 4;
    const int K = g.K, nt = K / BK;
    unsigned voffA[2];
#pragma unroll
    for (int i = 0; i < 2; ++i) { int R, C; stage_rc(tid * 16 + i * 8192, R, C); voffA[i] = (unsigned)(R * K + C) * 2u; }
    unsigned gA[2][2], gN[2][2];
#define PG8_GLOAD(dst, pm_) do { if constexpr (GATHER) { int rm_[2][2]; \
        _Pragma("unroll") for (int _h = 0; _h < 2; ++_h) _Pragma("unroll") for (int _i = 0; _i < 2; ++_i) { int R_, C_; stage_rc(tid * 16 + _i * 8192, R_, C_); rm_[_h][_i] = g.rowmap[(pm_) * BM + _h * HALF + R_]; } \
        _Pragma("unroll") for (int _h = 0; _h < 2; ++_h) _Pragma("unroll") for (int _i = 0; _i < 2; ++_i) { int R_, C_; stage_rc(tid * 16 + _i * 8192, R_, C_); dst[_h][_i] = (unsigned)(rm_[_h][_i] * K + C_) * 2u; } } } while (0)
    const size_t kstep = (size_t)(BK * 2);
    const size_t hstep = (size_t)HALF * K * 2;
    const size_t tstep = 2 * hstep;
    const unsigned ldsw = (unsigned)wid * 1024u;
    const int aoff = lds_byte(wr * 64 + fr, fq * 8), boff = lds_byte(wc * 32 + fr, fq * 8);
#define PG8_SA(b, h) (((b) * 2 + (h)) * HTB)
#define PG8_SB(b, h) ((4 + (b) * 2 + (h)) * HTB)
#define PG8_STAGE(bufoff, gbase, voff) do { _Pragma("unroll") for (int _i = 0; _i < 2; ++_i) \
        __builtin_amdgcn_global_load_lds((const unsigned*)((const char*)(gbase) + (voff)[_i]), (LAS unsigned*)(lds + (bufoff) + ldsw + _i * 8192), 16, 0, 0); } while (0)
#define PG8_STAGE_A(bufoff, gbase, half, nextsel) do { if constexpr (GATHER) { unsigned _vo[2]; _Pragma("unroll") for (int _i = 0; _i < 2; ++_i) _vo[_i] = (nextsel) ? gN[half][_i] : gA[half][_i]; PG8_STAGE(bufoff, gbase, _vo); } \
        else { PG8_STAGE(bufoff, (gbase) + (half) * hstep, voffA); } } while (0)
#define PG8_LDA(dst, b, h) do { _Pragma("unroll") for (int m = 0; m < 4; ++m) _Pragma("unroll") for (int k = 0; k < 2; ++k) dst[m][k] = *(const LAS bf16x8*)(lds + PG8_SA(b, h) + aoff + m * 2048 + k * 1024); } while (0)
#define PG8_LDB(dst, b, h) do { _Pragma("unroll") for (int n = 0; n < 2; ++n) _Pragma("unroll") for (int k = 0; k < 2; ++k) dst[n][k] = *(const LAS bf16x8*)(lds + PG8_SB(b, h) + boff + n * 2048 + k * 1024); } while (0)
#define PG8_MMA(ai, bj, At, Bt) do { __builtin_amdgcn_s_setprio(1); _Pragma("unroll") for (int m = 0; m < 4; ++m) _Pragma("unroll") for (int n = 0; n < 2; ++n) _Pragma("unroll") for (int k = 0; k < 2; ++k) \
        acc[ai][bj][m][n] = __builtin_amdgcn_mfma_f32_16x16x32_bf16(Bt[n][k], At[m][k], acc[ai][bj][m][n], 0, 0, 0); __builtin_amdgcn_s_setprio(0); } while (0)
#define PG8_WAIT_V(n) asm volatile("s_waitcnt vmcnt(" #n ")" ::: "memory")
#define PG8_WAIT_L(n) asm volatile("s_waitcnt lgkmcnt(" #n ")" ::: "memory")
#define PG8_BAR __builtin_amdgcn_s_barrier()
#define PG8_SCHED __builtin_amdgcn_sched_barrier(0)
    Unit cur, nxt; int ui = 0;
    if (!S.next(0, cur)) return;
    f32x4 acc[2][2][4][2];
#pragma unroll
    for (int a = 0; a < 2; ++a)
#pragma unroll
        for (int b = 0; b < 2; ++b)
#pragma unroll
            for (int m = 0; m < 4; ++m)
#pragma unroll
                for (int n = 0; n < 2; ++n) acc[a][b][m][n] = (f32x4){0.f, 0.f, 0.f, 0.f};
    bf16x8 At[4][2], B0[2][2], B1[2][2];
    const char* cA = GATHER ? (const char*)g.A : (const char*)g.A + (size_t)cur.pm * tstep; const char* cB = (const char*)g.Bt + (size_t)cur.e * g.ebytes + (size_t)cur.pn * tstep;
    PG8_GLOAD(gA, cur.pm);
    if constexpr (SP2) {
        PG8_STAGE(PG8_SB(0, 0), cB, voffA); PG8_STAGE(PG8_SB(0, 1), cB + hstep, voffA); PG8_STAGE_A(PG8_SA(0, 0), cA, 0, false); PG8_STAGE_A(PG8_SA(0, 1), cA, 1, false);
        if (wr == 1) PG8_BAR;
        PG8_WAIT_V(2); PG8_BAR;
        PG8_STAGE(PG8_SB(1, 0), cB + kstep, voffA); PG8_STAGE_A(PG8_SA(1, 0), cA + kstep, 0, false); PG8_STAGE(PG8_SB(1, 1), cB + hstep + kstep, voffA);
        PG8_WAIT_V(6); PG8_BAR;
    } else {
    PG8_STAGE(PG8_SB(0, 0), cB, voffA); PG8_STAGE_A(PG8_SA(0, 0), cA, 0, false); PG8_STAGE(PG8_SB(0, 1), cB + hstep, voffA); PG8_STAGE_A(PG8_SA(0, 1), cA, 1, false);
    if (wr == 1) PG8_BAR;
    PG8_WAIT_V(4); PG8_BAR;
    PG8_STAGE(PG8_SB(1, 0), cB + kstep, voffA); PG8_STAGE_A(PG8_SA(1, 0), cA + kstep, 0, false); PG8_STAGE(PG8_SB(1, 1), cB + hstep + kstep, voffA);
    PG8_WAIT_V(6); PG8_BAR;
    }
    for (;;) {
        const bool has_next = S.next(ui + 1, nxt);
        const char* nA = GATHER ? cA : (has_next ? (const char*)g.A + (size_t)nxt.pm * tstep : cA); const char* nB = has_next ? (const char*)g.Bt + (size_t)nxt.e * g.ebytes + (size_t)nxt.pn * tstep : cB;
        PG8_GLOAD(gN, nxt.pm);
        for (int t = 0; t < nt; t += 2) {
            const bool last = (t == nt - 2);
            const char* a1 = cA + (size_t)(t + 1) * kstep;
            const char* a2 = last ? nA : cA + (size_t)(t + 2) * kstep; const char* b2 = last ? nB : cB + (size_t)(t + 2) * kstep;
            const char* a3 = a2 + kstep; const char* b3 = b2 + kstep;
            if constexpr (SP2) {
            PG8_LDB(B0, 0, 0); PG8_LDB(B1, 0, 1); PG8_SCHED; PG8_LDA(At, 0, 0); PG8_STAGE_A(PG8_SA(1, 1), a1, 1, false);
            PG8_WAIT_V(8); PG8_WAIT_L(0); PG8_BAR; PG8_MMA(0, 0, At, B0); PG8_MMA(0, 1, At, B1); PG8_BAR; PG8_SCHED;
            PG8_LDA(At, 0, 1); PG8_STAGE(PG8_SB(0, 0), b2, voffA); PG8_STAGE(PG8_SB(0, 1), b2 + hstep, voffA); PG8_STAGE_A(PG8_SA(0, 0), a2, 0, last);
            PG8_WAIT_V(8); PG8_WAIT_L(0); PG8_BAR; PG8_MMA(1, 0, At, B0); PG8_MMA(1, 1, At, B1); PG8_BAR; PG8_SCHED;
            PG8_LDB(B0, 1, 0); PG8_LDB(B1, 1, 1); PG8_SCHED; PG8_LDA(At, 1, 0); PG8_STAGE_A(PG8_SA(0, 1), a2, 1, last);
            PG8_WAIT_V(8); PG8_WAIT_L(0); PG8_BAR; PG8_MMA(0, 0, At, B0); PG8_MMA(0, 1, At, B1); PG8_BAR; PG8_SCHED;
            PG8_LDA(At, 1, 1); PG8_STAGE(PG8_SB(1, 0), b3, voffA); PG8_STAGE(PG8_SB(1, 1), b3 + hstep, voffA); PG8_STAGE_A(PG8_SA(1, 0), a3, 0, last);
            PG8_WAIT_V(8); PG8_WAIT_L(0); PG8_BAR; PG8_MMA(1, 0, At, B0); PG8_MMA(1, 1, At, B1); PG8_BAR; PG8_SCHED;
            } else {
            PG8_LDB(B0, 0, 0); PG8_SCHED; PG8_LDA(At, 0, 0); PG8_STAGE_A(PG8_SA(1, 1), a1, 1, false);
            PG8_WAIT_L(8); PG8_BAR; PG8_WAIT_L(0); PG8_MMA(0, 0, At, B0); PG8_BAR; PG8_SCHED;
            PG8_LDB(B1, 0, 1); PG8_STAGE(PG8_SB(0, 0), b2, voffA);
            PG8_BAR; PG8_WAIT_L(0); PG8_MMA(0, 1, At, B1); PG8_BAR;
            PG8_LDA(At, 0, 1); PG8_STAGE_A(PG8_SA(0, 0), a2, 0, last);
            PG8_BAR; PG8_WAIT_L(0); PG8_MMA(1, 0, At, B0); PG8_BAR; PG8_SCHED;
            PG8_STAGE(PG8_SB(0, 1), b2 + hstep, voffA);
            PG8_WAIT_V(6); PG8_BAR; PG8_MMA(1, 1, At, B1); PG8_BAR;
            PG8_LDB(B0, 1, 0); PG8_SCHED; PG8_LDA(At, 1, 0); PG8_STAGE_A(PG8_SA(0, 1), a2, 1, last);
            PG8_WAIT_L(8); PG8_BAR; PG8_WAIT_L(0); PG8_MMA(0, 0, At, B0); PG8_BAR; PG8_SCHED;
            PG8_LDB(B1, 1, 1); PG8_STAGE(PG8_SB(1, 0), b3, voffA);
            PG8_BAR; PG8_WAIT_L(0); PG8_MMA(0, 1, At, B1); PG8_BAR;
            PG8_LDA(At, 1, 1); PG8_STAGE_A(PG8_SA(1, 0), a3, 0, last);
            PG8_BAR; PG8_WAIT_L(0); PG8_MMA(1, 0, At, B0); PG8_BAR; PG8_SCHED;
            PG8_STAGE(PG8_SB(1, 1), b3 + hstep, voffA);
            PG8_WAIT_V(6); PG8_BAR; PG8_MMA(1, 1, At, B1); PG8_BAR;
            }
        }
        if constexpr (ALIGN_EPI) { if (wr == 0) PG8_BAR; }
        E(acc, cur, wr, wc, fr, fq);
        if (!has_next) break;
#pragma unroll
        for (int a = 0; a < 2; ++a)
#pragma unroll
            for (int b = 0; b < 2; ++b)
#pragma unroll
                for (int m = 0; m < 4; ++m)
#pragma unroll
                    for (int n = 0; n < 2; ++n) acc[a][b][m][n] = (f32x4){0.f, 0.f, 0.f, 0.f};
        cur = nxt; cA = nA; cB = nB; ++ui;
        if constexpr (GATHER) { _Pragma("unroll") for (int _h = 0; _h < 2; ++_h) _Pragma("unroll") for (int _i = 0; _i < 2; ++_i) gA[_h][_i] = gN[_h][_i]; }
        if constexpr (ALIGN_EPI) { if (wr == 1) PG8_BAR; }
    }
    PG8_WAIT_V(0);
    if constexpr (!ALIGN_EPI) { if (wr == 0) PG8_BAR; }
    PG8_BAR;
#undef PG8_SA
#undef PG8_SB
#undef PG8_STAGE
#undef PG8_STAGE_A
#undef PG8_GLOAD
#undef PG8_LDA
#undef PG8_LDB
#undef PG8_MMA
#undef PG8_WAIT_V
#undef PG8_WAIT_L
#undef PG8_BAR
#undef PG8_SCHED
}
}

constexpr int NIN = 39;
constexpr int LDS_STAGE = 131072;
constexpr int LDS_MISC = LDS_STAGE;
constexpr int LDS_BYTES = LDS_STAGE + 1024;
struct Args { const float* in[NIN]; float* out; unsigned char* ws; int ph_lo, ph_hi; };
enum { I_X = 0, I_WIN, I_WOUT, I_NMIX, I_NFFN, I_NFIN, I_HGLB, I_HGNW, I_SCW, I_SCB, I_SDTB, I_SALOG, I_SD, I_SNW, I_RCW, I_RCB, I_RWA, I_RBA, I_RWX, I_RBX, I_RLAM,
       I_WMU, I_WW0, I_WW2, I_WA0, I_WA2, I_WG2, I_WKK, I_WKA, I_WRK, I_WLNW, I_WLNB, I_RGW, I_RGB, I_REW, I_REB, I_MG, I_MU, I_MD };

__device__ __forceinline__ float bf2f(bf16_t x) { return __uint_as_float(((unsigned)x) << 16); }
struct BfPtr {
    const bf16_t* p;
    __device__ __forceinline__ float operator[](long i) const { return bf2f(p[i]); }
    __device__ __forceinline__ BfPtr operator+(long o) const { return BfPtr{p + o}; }
};
struct Frame {
    const float* const* in; float* h; unsigned char* ws; unsigned char* lds;
    int G, bid;
    BfPtr P; bf16_t* Pw; float* Q; float* O; bf16_t* U; bf16_t* MIX; bf16_t* XPERM; bf16_t* HID; bf16_t* Y;
    unsigned* ctl; unsigned char* tab;
};

__device__ __forceinline__ void tconv_tile256(float* sm, const float* __restrict__ src, int N, int k0, int n0, int nlim, bf16_t* dstA, bf16_t* dstB, int K, int tid) {
    {
        const int r = tid >> 6, c4 = (tid & 63) * 4; const int n = n0 + c4;
        f32x4 v[8];
#pragma unroll
        for (int it = 0; it < 8; ++it) { v[it] = (f32x4){0.f, 0.f, 0.f, 0.f}; if (n < nlim) v[it] = *(const f32x4*)(src + (size_t)(k0 + r + 8 * it) * N + n); }
#pragma unroll
        for (int it = 0; it < 8; ++it) *(f32x4*)(sm + (r + 8 * it) * 260 + c4) = v[it];
    }
    __syncthreads();
    {
        const int kq = (tid & 7) * 8;
#pragma unroll
        for (int ps = 0; ps < 4; ++ps) {
            const int n = (tid >> 3) + 64 * ps;
            float v[8];
#pragma unroll
            for (int i = 0; i < 8; ++i) v[i] = sm[(kq + i) * 260 + n];
            u32x4 w; w.x = cvt_pk_bf16(v[0], v[1]); w.y = cvt_pk_bf16(v[2], v[3]); w.z = cvt_pk_bf16(v[4], v[5]); w.w = cvt_pk_bf16(v[6], v[7]);
            bf16_t* dst = (n < 128) ? dstA + (size_t)n * K : dstB + (size_t)(n - 128) * K;
            *(u32x4*)(dst + k0 + kq) = w;
        }
    }
    __syncthreads();
}

constexpr int DEFER_TILES = 1152, DEFER_GEMM = 1536;
__device__ __forceinline__ void conv_down_tile(const Frame& F, int q, int tid_) {
    const int le = q / 128, r = q % 128, kt = r / 8, ntl = r % 8;
    bf16_t* d = (bf16_t*)(F.ws + WS_WD) + ((size_t)le * D + ntl * 256) * DEXP;
    tconv_tile256((float*)F.lds, F.in[I_MD] + (size_t)le * DEXP * D, D, kt * 64, ntl * 256, D, d, d + (size_t)128 * DEXP, DEXP, tid_);
}
__device__ __forceinline__ void phase_prologue(const Frame& F) {
    const int tid_ = opaque_tid();
    float* sm = (float*)F.lds;
    constexpr int T_IN = 2 * 32 * 26, T_OUT = 2 * 32 * 8, T_G = 64 * 32 * 4, T_D = 64 * 16 * 8;
    constexpr int T_ALL = T_IN + T_OUT + 2 * T_G + T_D;
    for (int t = F.bid; t < T_ALL - DEFER_TILES - DEFER_GEMM; t += F.G) {
        if (t < T_IN) {
            const int l = t / (32 * 26), r = t % (32 * 26), kt = r / 26, ntl = r % 26;
            bf16_t* d = (bf16_t*)(F.ws + WS_WIN) + ((size_t)l * PS + ntl * 256) * D;
            tconv_tile256(sm, F.in[I_WIN] + (size_t)l * D * IN_COLS, IN_COLS, kt * 64, ntl * 256, IN_COLS, d, d + (size_t)128 * D, D, tid_);
        } else if (t < T_IN + T_OUT) {
            const int q = t - T_IN; const int l = q / 256, r = q % 256, kt = r / 8, ntl = r % 8;
            bf16_t* d = (bf16_t*)(F.ws + WS_WOUT) + ((size_t)l * D + ntl * 256) * D;
            tconv_tile256(sm, F.in[I_WOUT] + (size_t)l * D * D, D, kt * 64, ntl * 256, D, d, d + (size_t)128 * D, D, tid_);
        } else if (t < T_IN + T_OUT + 2 * T_G) {
            int q = t - T_IN - T_OUT; const int sgu = q / T_G; q %= T_G;
            const int le = q / 128, r = q % 128, kt = r / 4, ntl = r % 4;
            const int n0 = ntl * 256;
            bf16_t* d = (bf16_t*)(F.ws + WS_WGU) + ((size_t)le * 2048 + 256 * (n0 >> 7) + 128 * sgu) * D;
            tconv_tile256(sm, F.in[sgu ? I_MU : I_MG] + (size_t)le * D * DEXP, DEXP, kt * 64, n0, DEXP, d, d + (size_t)256 * D, D, tid_);
        } else {
            conv_down_tile(F, t - T_IN - T_OUT - 2 * T_G, tid_);
        }
    }
    for (int e = F.bid * 512 + tid_; e < 2 * 48 * 2048; e += F.G * 512) {
        const int l = e / (48 * 2048), c = (e / 2048) % 48, k = e % 2048;
        float v = 0.f;
        if (c < 4) v = F.in[I_RGW][((size_t)l * D + k) * 4 + c]; else if (c < 36) v = F.in[I_REW][((size_t)l * D + k) * 32 + (c - 4)];
        ((float*)(F.ws + WS_WRT))[e] = v * F.in[I_NFFN][(size_t)l * D + k];
    }
    for (int e = F.bid * 512 + tid_; e < 2 * 294912; e += F.G * 512) {
        const int l = e / 294912; int r = e % 294912;
        bf16_t* sw = (bf16_t*)(F.ws + WS_SW + (size_t)l * SW_LAYER);
        int K, n, k, base;
        if (r < 49152) { base = SW_W2T / 2; K = 96; } else if (r < 98304) { r -= 49152; base = SW_A2T / 2; K = 96; } else if (r < 229376) { r -= 98304; base = SW_G2T / 2; K = 256; }
        else if (r < 262144) { r -= 229376; base = SW_WAT / 2; K = 64; } else { r -= 262144; base = SW_WXT / 2; K = 64; }
        { const int j = r & 7, ln = (r >> 3) & 63, blk = r >> 9, KS = K / 32, nt = blk / KS, ks = blk % KS; n = nt * 16 + (ln & 15); k = ks * 32 + (ln >> 4) * 8 + j; }
        float v;
        if (base == (int)(SW_W2T / 2)) v = F.in[I_WW2][((size_t)l * 96 + k) * GW + n];
        else if (base == (int)(SW_A2T / 2)) v = F.in[I_WA2][((size_t)l * 96 + k) * GW + n];
        else if (base == (int)(SW_G2T / 2)) v = F.in[I_WG2][((size_t)l * 256 + k) * GW + n];
        else if (base == (int)(SW_WAT / 2)) v = F.in[I_RWA][(((size_t)l * 8 + (n >> 6)) * 64 + k) * 64 + (n & 63)];
        else v = F.in[I_RWX][(((size_t)l * 8 + (n >> 6)) * 64 + k) * 64 + (n & 63)];
        sw[base + r] = f2bf(v);
    }
}

__device__ __forceinline__ void phase_norm1(const Frame& F, int mode, const float* __restrict__ w) {
    const int tid_ = opaque_tid(); const int lane_ = tid_ & 63; const int wave_ = __builtin_amdgcn_readfirstlane(tid_ >> 6); (void)lane_; (void)wave_;
    const int gw = F.bid * 8 + wave_, nw = F.G * 8;
    const int* tokslot = (const int*)(F.tab + TAB_TOKSLOT);
    for (int t = gw; t < NTOK; t += nw) {
        float4 v[8];
        const float* src = (mode == 0) ? F.in[I_X] : F.h;
#pragma unroll
        for (int j = 0; j < 8; ++j) v[j] = *(const float4*)(src + (size_t)t * D + 4 * (lane_ + 64 * j));
        if (mode != 0) {
            const int s0 = tokslot[2 * t], s1 = tokslot[2 * t + 1];
#pragma unroll
            for (int j = 0; j < 8; ++j) {
                const u32x2 pa = *(const u32x2*)(F.Y + (size_t)s0 * D + 4 * (lane_ + 64 * j));
                const u32x2 pb = *(const u32x2*)(F.Y + (size_t)s1 * D + 4 * (lane_ + 64 * j));
                v[j].x += __uint_as_float(pa.x << 16) + __uint_as_float(pb.x << 16); v[j].y += __uint_as_float(pa.x & 0xffff0000u) + __uint_as_float(pb.x & 0xffff0000u);
                v[j].z += __uint_as_float(pa.y << 16) + __uint_as_float(pb.y << 16); v[j].w += __uint_as_float(pa.y & 0xffff0000u) + __uint_as_float(pb.y & 0xffff0000u);
            }
        }
        float ss = 0.f;
#pragma unroll
        for (int j = 0; j < 8; ++j) ss += v[j].x * v[j].x + v[j].y * v[j].y + v[j].z * v[j].z + v[j].w * v[j].w;
        ss = wave_sum(ss);
        const float rs = rsqrtf(ss * (1.0f / D) + NORM_EPS);
#pragma unroll
        for (int j = 0; j < 8; ++j) {
            const int c = 4 * (lane_ + 64 * j);
            const float4 wv = *(const float4*)(w + c);
            if (mode == 2) {
                float4 o; o.x = v[j].x * rs * wv.x; o.y = v[j].y * rs * wv.y; o.z = v[j].z * rs * wv.z; o.w = v[j].w * rs * wv.w;
                *(float4*)(F.h + (size_t)t * D + c) = o;
            } else {
                if (mode != 0) *(float4*)(F.h + (size_t)t * D + c) = v[j];
                u32x2 p; p.x = cvt_pk_bf16(v[j].x * rs * wv.x, v[j].y * rs * wv.y); p.y = cvt_pk_bf16(v[j].z * rs * wv.z, v[j].w * rs * wv.w);
                *(u32x2*)(F.U + (size_t)t * D + c) = p;
            }
        }
    }
}


template <int K>
__device__ __forceinline__ f32x4 mma16(const bf16_t* A, int lda, const bf16_t* Bt, int ldb, int lane, f32x4 acc);
__device__ __forceinline__ u32x4 pack8(const float (&v)[8]);
__device__ __forceinline__ float bflo(unsigned u) { return __uint_as_float(u << 16); }
__device__ __forceinline__ float bfhi(unsigned u) { return __uint_as_float(u & 0xffff0000u); }
__device__ __forceinline__ float bfel(const u32x4 r, int e) { const unsigned u = (e < 2) ? r.x : (e < 4) ? r.y : (e < 6) ? r.z : r.w; return (e & 1) ? bfhi(u) : bflo(u); }
__device__ __forceinline__ void pre_steps14(const Frame& F, int l, int ch) {
    const int tid = opaque_tid();
    bf16_t* XB = (bf16_t*)F.lds;
    bf16_t* AW = (bf16_t*)(F.lds + 66560);
    bf16_t* AA = (bf16_t*)(F.lds + 79872);
    bf16_t* AG = (bf16_t*)(F.lds + 93184);
    const size_t t0 = (size_t)ch * 64; const bool has_prev = (ch & 63) != 0;
    const bf16_t* Pb = F.P.p;
    const u32x4 zero4 = {0u, 0u, 0u, 0u};
    const int tsG = tid >> 6, tsW = tid / 56, j0W = 8 * (tid % 56);
    u32x4 rawG[11], rawW[9];
#pragma unroll
    for (int i = 0; i < 11; ++i) { const int tok = tsG * 8 - 3 + i; rawG[i] = (tok >= 0 || has_prev) ? *(const u32x4*)(Pb + (long)((long)t0 + tok) * PS + C_RG_X + 8 * (tid & 63)) : zero4; }
    if (tid < 448) {
#pragma unroll
        for (int i = 0; i < 9; ++i) { const int tok = tsW * 8 - 1 + i; rawW[i] = (tok >= 0 || has_prev) ? *(const u32x4*)(Pb + (long)((long)t0 + tok) * PS + C_RW + 1536 + j0W) : zero4; }
    }
    {
        const int c0 = 8 * (tid & 127), tq = tid >> 7;
        const float* scw = F.in[I_SCW] + (size_t)l * 4 * 1024 + c0; const float* scb = F.in[I_SCB] + (size_t)l * 1024 + c0;
        u32x4 raw[19];
#pragma unroll
        for (int i = 0; i < 19; ++i) { const int tok = tq * 16 - 3 + i; raw[i] = (tok >= 0 || has_prev) ? *(const u32x4*)(Pb + (long)((long)t0 + tok) * PS + C_SS_X + c0) : zero4; }
        float cw[4][8], cb[8];
#pragma unroll
        for (int k = 0; k < 4; ++k) { const f32x4 a = *(const f32x4*)(scw + k * 1024), b = *(const f32x4*)(scw + k * 1024 + 4);
#pragma unroll
            for (int e = 0; e < 4; ++e) { cw[k][e] = a[e]; cw[k][4 + e] = b[e]; } }
        { const f32x4 a = *(const f32x4*)(scb), b = *(const f32x4*)(scb + 4);
#pragma unroll
            for (int e = 0; e < 4; ++e) { cb[e] = a[e]; cb[4 + e] = b[e]; } }
#pragma unroll
        for (int t = 0; t < 16; ++t) {
            float o[8];
#pragma unroll
            for (int e = 0; e < 8; ++e) o[e] = silu_f(cb[e] + cw[3][e] * bfel(raw[t + 3], e) + cw[2][e] * bfel(raw[t + 2], e) + cw[1][e] * bfel(raw[t + 1], e) + cw[0][e] * bfel(raw[t], e));
            *(u32x4*)((bf16_t*)(F.Q + (t0 + tq * 16 + t) * QS) + c0) = pack8(o);
        }
    }
    {
        const int c0 = 8 * (tid & 63);
        const float* rcw = F.in[I_RCW] + (size_t)l * 4 * GW + c0; const float* rcb = F.in[I_RCB] + (size_t)l * GW + c0;
        float cw[4][8], cb[8];
#pragma unroll
        for (int k = 0; k < 4; ++k) { const f32x4 a = *(const f32x4*)(rcw + k * GW), b = *(const f32x4*)(rcw + k * GW + 4);
#pragma unroll
            for (int e = 0; e < 4; ++e) { cw[k][e] = a[e]; cw[k][4 + e] = b[e]; } }
        { const f32x4 a = *(const f32x4*)(rcb), b = *(const f32x4*)(rcb + 4);
#pragma unroll
            for (int e = 0; e < 4; ++e) { cb[e] = a[e]; cb[4 + e] = b[e]; } }
#pragma unroll
        for (int t = 0; t < 8; ++t) {
            float o[8];
#pragma unroll
            for (int e = 0; e < 8; ++e) o[e] = cb[e] + cw[3][e] * bfel(rawG[t + 3], e) + cw[2][e] * bfel(rawG[t + 2], e) + cw[1][e] * bfel(rawG[t + 1], e) + cw[0][e] * bfel(rawG[t], e);
            *(u32x4*)(XB + (tsG * 8 + t) * 520 + c0) = pack8(o);
        }
    }
    if (tid < 448) {
        const int ts = tsW, j0 = j0W;
        const float* mu = F.in[I_WMU] + (size_t)l * RW_COLS + 1536 + j0;
        float m8[8];
        { const f32x4 a = *(const f32x4*)(mu), b = *(const f32x4*)(mu + 4);
#pragma unroll
            for (int e = 0; e < 4; ++e) { m8[e] = a[e]; m8[4 + e] = b[e]; } }
#pragma unroll
        for (int t = 0; t < 8; ++t) {
            float o[8];
#pragma unroll
            for (int e = 0; e < 8; ++e) { const float cur = bfel(rawW[t + 1], e), prev = bfel(rawW[t], e); const float v = cur + (prev - cur) * m8[e]; o[e] = (j0 < 96) ? ftanh(v) : (j0 < 192) ? v : sigmoid_f(v); }
            const int tt = ts * 8 + t;
            bf16_t* dst = (j0 < 96) ? AW + tt * 104 + j0 : (j0 < 192) ? AA + tt * 104 + (j0 - 96) : AG + tt * 264 + (j0 - 192);
            *(u32x4*)dst = pack8(o);
        }
    }
}
template <int KS>
__device__ __forceinline__ f32x4 mma16f(const bf16_t* A, int lda, const bf16_t* Bf, int lane, f32x4 acc) {
    const bf16_t* ap = A + (lane & 15) * lda + (lane >> 4) * 8; const bf16_t* bp = Bf + lane * 8;
#pragma unroll
    for (int ks = 0; ks < KS; ++ks) { const bf16x8 a = *(const bf16x8*)(ap + ks * 32); const bf16x8 b = *(const bf16x8*)(bp + ks * 512); acc = __builtin_amdgcn_mfma_f32_16x16x32_bf16(a, b, acc, 0, 0, 0); }
    return acc;
}
template <int KS>
__device__ __forceinline__ f32x4 mma16p(const bf16_t* A, int lda, const bf16x8* f, int lane, f32x4 acc) {
    const bf16_t* ap = A + (lane & 15) * lda + (lane >> 4) * 8;
#pragma unroll
    for (int ks = 0; ks < KS; ++ks) { const bf16x8 a = *(const bf16x8*)(ap + ks * 32); acc = __builtin_amdgcn_mfma_f32_16x16x32_bf16(a, f[ks], acc, 0, 0, 0); }
    return acc;
}
__device__ __forceinline__ void store_pair(float* base, int q, int cl, int jj, float va, float vb) {
    const auto sw = __builtin_amdgcn_permlane32_swap(__float_as_uint(va), __float_as_uint(vb), false, false);
    const bool lo = q < 2; const int qq = q & 1, ch = lo ? cl : 16 + cl;
    base[(size_t)(4 * qq + jj) * QS + ch] = __uint_as_float(sw[0]);
    base[(size_t)(4 * (qq + 2) + jj) * QS + ch] = __uint_as_float(sw[1]);
}
__device__ __forceinline__ void pre_5a(const Frame& F, int l, int ch) {
    const int j = opaque_tid(); const int lane = j & 63; const int w = __builtin_amdgcn_readfirstlane(j >> 6);
    bf16_t* XB = (bf16_t*)F.lds;
    bf16_t* AW = (bf16_t*)(F.lds + 66560);
    bf16_t* AA = (bf16_t*)(F.lds + 79872);
    bf16_t* AG = (bf16_t*)(F.lds + 93184);
    const bf16_t* sw = (const bf16_t*)(F.ws + WS_SW + (size_t)l * SW_LAYER);
    const bf16_t* W2T = sw + SW_W2T / 2; const bf16_t* A2T = sw + SW_A2T / 2; const bf16_t* G2T = sw + SW_G2T / 2; const bf16_t* WAT = sw + SW_WAT / 2; const bf16_t* WXT = sw + SW_WXT / 2;
    float lb = 0.f;
    if (l > 0) { const float p0 = F.in[I_HGLB][j], p1 = F.in[I_HGLB][GW + j]; const float m = fmaxf(p0, p1); const float e0 = fexp(p0 - m), e1 = fexp(p1 - m); lb = e1 / (e0 + e1); }
    const float* scw = F.in[I_SCW] + (size_t)l * 4 * 1024; const float* scb = F.in[I_SCB] + (size_t)l * 1024;
    const float* rcw = F.in[I_RCW] + (size_t)l * 4 * GW; const float* rcb = F.in[I_RCB] + (size_t)l * GW;
    const float* mu = F.in[I_WMU] + (size_t)l * RW_COLS;
        const size_t t0 = (size_t)ch * 64;
        const f32x4 z4 = (f32x4){0.f, 0.f, 0.f, 0.f};
        const int cl = lane & 15, rq = 4 * (lane >> 4);
#ifndef SKIP_5A
        {
            int l5 = l; asm volatile("" : "+s"(l5));
            float ba[4], bx[4], spl[4];
#pragma unroll
            for (int n = 0; n < 4; ++n) { const int c = w * 64 + n * 16 + cl; ba[n] = F.in[I_RBA][l5 * GW + c]; bx[n] = F.in[I_RBX][l5 * GW + c]; spl[n] = softplus_f(-F.in[I_RLAM][l5 * GW + c]); }
#pragma unroll
            for (int m = 0; m < 4; ++m)
#pragma unroll
                for (int np = 0; np < 2; ++np) {
                    float av[2][4], uv[2][4];
#pragma unroll
                    for (int h2 = 0; h2 < 2; ++h2) {
                        const int n = 2 * np + h2, c = w * 64 + n * 16 + cl;
                        const f32x4 ra = mma16f<2>(XB + m * 16 * 520 + w * 64, 520, WAT + ((w * 4 + n) * 2) * 512, lane, z4);
                        const f32x4 ri = mma16f<2>(XB + m * 16 * 520 + w * 64, 520, WXT + ((w * 4 + n) * 2) * 512, lane, z4);
#pragma unroll
                        for (int jj = 0; jj < 4; ++jj) {
                            const int t = m * 16 + rq + jj;
                            const float r = sigmoid_f(ra[jj] + ba[n]), ii = sigmoid_f(ri[jj] + bx[n]);
                            const float la = -8.0f * r * spl[n]; av[h2][jj] = fexp(la);
                            uv[h2][jj] = __builtin_amdgcn_sqrtf(1.0f - fexp(2.0f * la)) * (ii * bf2f(XB[t * 520 + c]));
                        }
                    }
                    float* qb = F.Q + (t0 + m * 16) * QS + w * 64 + np * 32;
#pragma unroll
                    for (int jj = 0; jj < 4; ++jj) { store_pair(qb + Q_RGA, lane >> 4, cl, jj, av[0][jj], av[1][jj]); store_pair(qb + Q_RGU, lane >> 4, cl, jj, uv[0][jj], uv[1][jj]); }
                }
        }
#endif
}
__device__ __forceinline__ void pre_5b(const Frame& F, int l, int ch) {
    const int j = opaque_tid(); const int lane = j & 63; const int w = __builtin_amdgcn_readfirstlane(j >> 6);
    bf16_t* XB = (bf16_t*)F.lds;
    bf16_t* AW = (bf16_t*)(F.lds + 66560);
    bf16_t* AA = (bf16_t*)(F.lds + 79872);
    bf16_t* AG = (bf16_t*)(F.lds + 93184);
    const bf16_t* sw = (const bf16_t*)(F.ws + WS_SW + (size_t)l * SW_LAYER);
    const bf16_t* W2T = sw + SW_W2T / 2; const bf16_t* A2T = sw + SW_A2T / 2; const bf16_t* G2T = sw + SW_G2T / 2; const bf16_t* WAT = sw + SW_WAT / 2; const bf16_t* WXT = sw + SW_WXT / 2;
    float lb = 0.f;
    if (l > 0) { const float p0 = F.in[I_HGLB][j], p1 = F.in[I_HGLB][GW + j]; const float m = fmaxf(p0, p1); const float e0 = fexp(p0 - m), e1 = fexp(p1 - m); lb = e1 / (e0 + e1); }
    const float* scw = F.in[I_SCW] + (size_t)l * 4 * 1024; const float* scb = F.in[I_SCB] + (size_t)l * 1024;
    const float* rcw = F.in[I_RCW] + (size_t)l * 4 * GW; const float* rcb = F.in[I_RCB] + (size_t)l * GW;
    const float* mu = F.in[I_WMU] + (size_t)l * RW_COLS;
        const size_t t0 = (size_t)ch * 64;
        const f32x4 z4 = (f32x4){0.f, 0.f, 0.f, 0.f};
        const int cl = lane & 15, rq = 4 * (lane >> 4);
#ifndef SKIP_5B
        {
            int l5 = l; asm volatile("" : "+s"(l5));
            const float* mu5 = F.in[I_WMU] + (size_t)l5 * RW_COLS;
            float kkc[4], mk[4];
#pragma unroll
            for (int n = 0; n < 4; ++n) { const int c = w * 64 + n * 16 + cl; kkc[n] = F.in[I_WKK][l5 * GW + c]; mk[n] = mu5[512 + c]; }
#define PRE5B_LOADW(dst, n_) do { const bf16_t* b2_ = W2T + ((w * 4 + (n_)) * 3) * 512 + lane * 8; \
        _Pragma("unroll") for (int ks_ = 0; ks_ < 3; ++ks_) dst[ks_] = *(const bf16x8*)(b2_ + ks_ * 512); } while (0)
#define PRE5B_LOADA(dst, n_) do { const bf16_t* ba_ = A2T + ((w * 4 + (n_)) * 3) * 512 + lane * 8; \
        _Pragma("unroll") for (int ks_ = 0; ks_ < 3; ++ks_) dst[ks_] = *(const bf16x8*)(ba_ + ks_ * 512); } while (0)
#define PRE5B_LOADG(dst, n_) do { const bf16_t* bg_ = G2T + ((w * 4 + (n_)) * 8) * 512 + lane * 8; \
        _Pragma("unroll") for (int ks_ = 0; ks_ < 8; ++ks_) dst[ks_] = *(const bf16x8*)(bg_ + ks_ * 512); } while (0)
            for (int m = 0; m < 4; ++m) {
                {
                    bf16_t* stg = (bf16_t*)F.lds + w * 4096;
                    const size_t trow0 = t0 + m * 16;
                    const bool hp0 = ((trow0 & (SEQ - 1)) != 0);
#pragma unroll
                    for (int it = 0; it < 7; ++it) {
                        const int seg = it * 8 + (lane >> 3);
                        if (seg < 51) {
                            const int row = seg / 3, grp = seg - row * 3;
                            u32x4 v = {0u, 0u, 0u, 0u};
                            if (row > 0 || hp0) v = *(const u32x4*)(F.P.p + (long)((long)trow0 - 1 + row) * PS + C_RW + grp * 512 + w * 64 + (lane & 7) * 8);
                            *(u32x4*)(stg + row * 196 + grp * 64 + (lane & 7) * 8) = v;
                        }
                    }
                }
                const bf16_t* spb = (const bf16_t*)F.lds + w * 4096 + rq * 196 + cl;
                bf16x8 wa0[3]; PRE5B_LOADW(wa0, 0);
                float inv[4];
                {
                    float ssq[4] = {0.f, 0.f, 0.f, 0.f};
#pragma unroll
                    for (int n = 0; n < 4; ++n) { float kp = bf2f(spb[n * 16 + 64]);
#pragma unroll
                        for (int jj = 0; jj < 4; ++jj) { const float kc = bf2f(spb[(jj + 1) * 196 + n * 16 + 64]); const float x = (kc + (kp - kc) * mk[n]) * kkc[n]; ssq[jj] += x * x; kp = kc; } }
#pragma unroll
                    for (int jj = 0; jj < 4; ++jj) inv[jj] = frcp(fmaxf(__builtin_amdgcn_sqrtf(row16_sum(ssq[jj])), 1e-12f));
                }
#define PRE5B_TILE(n, wac, wan, more) do { const int c = w * 64 + (n) * 16 + cl; bf16x8 fa[3], fg[8]; PRE5B_LOADA(fa, n); PRE5B_LOADG(fg, n); \
        const f32x4 ws = mma16p<3>(AW + m * 16 * 104, 104, wac, lane, z4); \
        if (more) PRE5B_LOADW(wan, (n) + 1); \
        const f32x4 as = mma16p<3>(AA + m * 16 * 104, 104, fa, lane, z4); \
        __builtin_amdgcn_sched_barrier(0); \
        f32x4 gs = mma16p<4>(AG + m * 16 * 264, 264, fg, lane, z4); \
        __builtin_amdgcn_sched_barrier(0); \
        gs = mma16p<4>(AG + m * 16 * 264 + 128, 264, fg + 4, lane, gs); \
        __builtin_amdgcn_sched_barrier(0); \
        const float w0n = F.in[I_WW0][l5 * GW + c], a0n = F.in[I_WA0][l5 * GW + c], kan = F.in[I_WKA][l5 * GW + c]; \
        const bf16_t* spk = (const bf16_t*)F.lds + w * 4096 + rq * 196 + 64 + (n) * 16 + cl; float kprev = bf2f(spk[0]); \
        _Pragma("unroll") for (int jj = 0; jj < 4; ++jj) { \
            const float kcur = bf2f(spk[(jj + 1) * 196]); const float k0v = kcur + (kprev - kcur) * mk[n]; kprev = kcur; \
            const float wlog = -softplus_f(-(w0n + ws[jj])) - 0.5f; const float decay = fexp(-fexp(wlog)); const float a = sigmoid_f(a0n + as[jj]); \
            const float kk = k0v * kkc[n] * inv[jj]; const float k = k0v * (1.0f + (a - 1.0f) * kan); \
            float* q = F.Q + (t0 + m * 16 + rq + jj) * QS; \
            q[Q_W + c] = decay; q[Q_K + c] = k; q[Q_KKA + c] = kk * a; q[Q_G + c] = gs[jj]; } } while (0)
                {
                    bf16x8 wa1[3];
                    PRE5B_TILE(0, wa0, wa1, true);
                    PRE5B_TILE(1, wa1, wa0, true);
                    PRE5B_TILE(2, wa0, wa1, true);
                    PRE5B_TILE(3, wa1, wa0, false);
                }
#undef PRE5B_TILE
            }
#undef PRE5B_LOADW
#undef PRE5B_LOADA
#undef PRE5B_LOADG
        }
#endif
}
__device__ __forceinline__ void phase_pre(const Frame& F, int l) {
    for (int ch = F.bid; ch < NTOK / 64; ch += F.G) { pre_steps14(F, l, ch); __syncthreads(); pre_5a(F, l, ch); pre_5b(F, l, ch); __syncthreads(); }
}


template <int K>
__device__ __forceinline__ f32x4 mma16(const bf16_t* A, int lda, const bf16_t* Bt, int ldb, int lane, f32x4 acc) {
    const int r = lane & 15, kq = (lane >> 4) * 8;
    const bf16_t* ap = A + r * lda + kq; const bf16_t* bp = Bt + r * ldb + kq;
#pragma unroll
    for (int k0 = 0; k0 < K; k0 += 32) {
        const bf16x8 a = *(const bf16x8*)(ap + k0); const bf16x8 b = *(const bf16x8*)(bp + k0);
        acc = __builtin_amdgcn_mfma_f32_16x16x32_bf16(a, b, acc, 0, 0, 0);
    }
    return acc;
}
__device__ __forceinline__ float wave_scan_incl(float v, int lane) {
#pragma unroll
    for (int o = 1; o < 64; o <<= 1) { const float u = __shfl_up(v, o); if (lane >= o) v += u; }
    return v;
}

__device__ __forceinline__ void rg_local(const Frame& F, int u, int tid) {
    const int b = u >> 6, c = u & 63; const size_t t0 = (size_t)b * SEQ + c * 64;
    float* rgc = (float*)(F.ws + WS_R4 + R4_RGC);
    float ap = 1.f, h = 0.f;
#pragma unroll 1
    for (int tb = 0; tb < 64; tb += 32) {
        float a[32], uu[32];
#pragma unroll
        for (int i = 0; i < 32; ++i) { a[i] = F.Q[(t0 + tb + i) * QS + Q_RGA + tid]; uu[i] = F.Q[(t0 + tb + i) * QS + Q_RGU + tid]; }
#pragma unroll
        for (int i = 0; i < 32; ++i) { h = a[i] * h + uu[i]; ap *= a[i]; }
    }
    rgc[((size_t)u * 512 + tid) * 2] = ap; rgc[((size_t)u * 512 + tid) * 2 + 1] = h;
}
__device__ __forceinline__ void rg_scan(const Frame& F, int e) {
    const int b = e >> 9, j = e & 511;
    float* rgc = (float*)(F.ws + WS_R4 + R4_RGC);
    float h = 0.f;
    for (int c = 0; c < 64; ++c) { float* p = rgc + ((size_t)(b * 64 + c) * 512 + j) * 2; const float ap = p[0], he = p[1]; p[1] = h; h = ap * h + he; }
}
__device__ __forceinline__ void rg_out(const Frame& F, int u, int tid) {
    const int b = u >> 6, c = u & 63; const size_t t0 = (size_t)b * SEQ + c * 64;
    const float* rgc = (const float*)(F.ws + WS_R4 + R4_RGC);
    float h = rgc[((size_t)u * 512 + tid) * 2 + 1];
#pragma unroll 1
    for (int tb = 0; tb < 64; tb += 32) {
        float a[32], uu[32], gt[32];
#pragma unroll
        for (int i = 0; i < 32; ++i) { a[i] = F.Q[(t0 + tb + i) * QS + Q_RGA + tid]; uu[i] = F.Q[(t0 + tb + i) * QS + Q_RGU + tid]; gt[i] = F.P[(t0 + tb + i) * PS + C_RG_G + tid]; }
#pragma unroll
        for (int i = 0; i < 32; ++i) { h = a[i] * h + uu[i]; F.MIX[(t0 + tb + i) * D + 1024 + tid] = f2bf(h * gelu_tanh_f(gt[i])); }
    }
}

__device__ __forceinline__ void ssd_acum(const Frame& F, int l, size_t t0, int g, float* acum, int tid) {
    const int lane = tid & 63, w = tid >> 6;
    if (w < 4) {
        const int head = 4 * g + w;
        const float A = -fexp(F.in[I_SALOG][l * 8 + head]);
        const float dtv = softplus_f(F.P[(t0 + lane) * PS + C_SS_DT + head] + F.in[I_SDTB][l * 8 + head]);
        acum[256 + w * 64 + lane] = dtv;
        acum[w * 64 + lane] = wave_scan_incl(dtv * A, lane);
    }
}
__device__ __forceinline__ void ssd_local(const Frame& F, int l, int u, int tid) {
    const int g = u & 1, c = (u >> 1) & 63, b = u >> 7; const size_t t0 = (size_t)b * SEQ + c * 64;
    const int lane = tid & 63, w = __builtin_amdgcn_readfirstlane(tid >> 6);
    float* acum = (float*)F.lds;
    bf16_t* BmT = (bf16_t*)(F.lds + 2048);
    bf16_t* XW = (bf16_t*)(F.lds + 2048 + 18432);
    ssd_acum(F, l, t0, g, acum, tid);
    LDS_BARRIER();
    if (tid < 256) {
        const int hh = tid >> 6, p = tid & 63, head = 4 * g + hh;
        const float aend = acum[hh * 64 + 63];
#pragma unroll
        for (int l8 = 0; l8 < 8; ++l8) {
            float v[8];
#pragma unroll
            for (int i = 0; i < 8; ++i) { const int tt = l8 * 8 + i; const float x = bf2f(((const bf16_t*)(F.Q + (t0 + tt) * QS))[head * 64 + p]); const float dtv = acum[256 + hh * 64 + tt];
                v[i] = x * dtv * fexp(aend - acum[hh * 64 + tt]); }
            u32x4 pk; pk.x = cvt_pk_bf16(v[0], v[1]); pk.y = cvt_pk_bf16(v[2], v[3]); pk.z = cvt_pk_bf16(v[4], v[5]); pk.w = cvt_pk_bf16(v[6], v[7]);
            *(u32x4*)(XW + (hh * 64 + p) * 72 + l8 * 8) = pk;
        }
    } else {
        const int n = tid & 127, lh = (tid - 256) >> 7;
#pragma unroll
        for (int l8 = 0; l8 < 4; ++l8) {
            float v[8];
#pragma unroll
            for (int i = 0; i < 8; ++i) { const int tt = lh * 32 + l8 * 8 + i; v[i] = bf2f(((const bf16_t*)(F.Q + (t0 + tt) * QS))[512 + g * 128 + n]); }
            u32x4 pk; pk.x = cvt_pk_bf16(v[0], v[1]); pk.y = cvt_pk_bf16(v[2], v[3]); pk.z = cvt_pk_bf16(v[4], v[5]); pk.w = cvt_pk_bf16(v[6], v[7]);
            *(u32x4*)(BmT + n * 72 + lh * 32 + l8 * 8) = pk;
        }
    }
    LDS_BARRIER();
    {
        const int hh = w >> 1, head = 4 * g + hh;
        bf16_t* dst = (bf16_t*)(F.ws + WS_R4 + R4_SSS) + ((size_t)(b * 8 + head) * 64 + c) * 8192;
#pragma unroll
        for (int pi = 0; pi < 4; ++pi)
#pragma unroll
            for (int np = 0; np < 2; ++np) {
                const int ni = (w & 1) * 4 + 2 * np;
                const f32x4 a0 = mma16<64>(BmT + ni * 16 * 72, 72, XW + (hh * 64 + pi * 16) * 72, 72, lane, (f32x4){0.f, 0.f, 0.f, 0.f});
                const f32x4 a1 = mma16<64>(BmT + (ni + 1) * 16 * 72, 72, XW + (hh * 64 + pi * 16) * 72, 72, lane, (f32x4){0.f, 0.f, 0.f, 0.f});
                *(u32x4*)(dst + (pi * 16 + (lane & 15)) * 128 + ni * 16 + pair16_col(lane)) = pair16(a0, a1);
            }
        if (tid < 4) ((float*)(F.ws + WS_R4 + R4_SSD))[(size_t)(b * 8 + 4 * g + tid) * 64 + c] = fexp(acum[tid * 64 + 63]);
    }
    LDS_BARRIER();
}
__device__ __forceinline__ void ssd_scan(const Frame& F, int e) {
    const int bh = e >> 13, r = e & 8191;
    bf16_t* st = (bf16_t*)(F.ws + WS_R4 + R4_SSS) + (size_t)bh * 64 * 8192 + r; const float* dec = (const float*)(F.ws + WS_R4 + R4_SSD) + bh * 64;
    float h = 0.f;
    for (int c0 = 0; c0 < 64; c0 += 16) {
        float tmp[16], dd[16];
#pragma unroll
        for (int i = 0; i < 16; ++i) { tmp[i] = bf2f(st[(size_t)(c0 + i) * 8192]); dd[i] = dec[c0 + i]; }
#pragma unroll
        for (int i = 0; i < 16; ++i) { st[(size_t)(c0 + i) * 8192] = f2bf(h); h = h * dd[i] + tmp[i]; }
    }
}
__device__ __forceinline__ void ssd_out(const Frame& F, int l, int u, int tid) {
    const int g = u & 1, c = (u >> 1) & 63, b = u >> 7; const size_t t0 = (size_t)b * SEQ + c * 64;
    const int lane = tid & 63, w = __builtin_amdgcn_readfirstlane(tid >> 6);
    float* acum = (float*)F.lds;
    bf16_t* Cm = (bf16_t*)(F.lds + 2048);
    bf16_t* Bm = (bf16_t*)(F.lds + 19456);
    bf16_t* XT = (bf16_t*)(F.lds + 36864);
    bf16_t* PV = (bf16_t*)(F.lds + 46080);
    bf16_t* Mh = (bf16_t*)(F.lds + 63488);
    bf16_t* XS = (bf16_t*)(F.lds + 72704);
    ssd_acum(F, l, t0, g, acum, tid);
    const int row8 = tid >> 3, seg8 = tid & 7;
    {
        const bf16_t* qrow = (const bf16_t*)(F.Q + (t0 + row8) * QS);
#pragma unroll
        for (int hf = 0; hf < 2; ++hf) {
            *(u32x4*)(Bm + row8 * 136 + (seg8 + 8 * hf) * 8) = *(const u32x4*)(qrow + 512 + g * 128 + (seg8 + 8 * hf) * 8);
            *(u32x4*)(Cm + row8 * 136 + (seg8 + 8 * hf) * 8) = *(const u32x4*)(qrow + 768 + g * 128 + (seg8 + 8 * hf) * 8);
        }
#pragma unroll
        for (int it = 0; it < 4; ++it) *(u32x4*)(XS + row8 * 264 + (seg8 + 8 * it) * 8) = *(const u32x4*)(qrow + g * 256 + (seg8 + 8 * it) * 8);
    }
    u32x4 pv[2];
    { const bf16_t* src = (const bf16_t*)(F.ws + WS_R4 + R4_SSS) + ((size_t)(b * 8 + 4 * g) * 64 + c) * 8192 + row8 * 128;
      pv[0] = *(const u32x4*)(src + seg8 * 8); pv[1] = *(const u32x4*)(src + (seg8 + 8) * 8); }
    LDS_BARRIER();
    const int ti = w >> 1, sj0 = 2 * (w & 1);
    f32x4 cb[2];
#pragma unroll
    for (int q = 0; q < 2; ++q) cb[q] = mma16<128>(Cm + ti * 16 * 136, 136, Bm + (sj0 + q) * 16 * 136, 136, lane, (f32x4){0.f, 0.f, 0.f, 0.f});
    for (int hh = 0; hh < 4; ++hh) {
        const int head = 4 * g + hh;
#pragma unroll
        for (int q = 0; q < 2; ++q)
#pragma unroll
            for (int j = 0; j < 4; ++j) {
                const int lrow = ti * 16 + 4 * (lane >> 4) + j, sidx = (sj0 + q) * 16 + (lane & 15);
                const float v = (sidx <= lrow) ? cb[q][j] * fexp(acum[hh * 64 + lrow] - acum[hh * 64 + sidx]) : 0.f;
                Mh[lrow * 72 + sidx] = f2bf(v);
            }
        {
            const int p = tid & 63, sq = tid >> 6;
            float v[8];
#pragma unroll
            for (int i = 0; i < 8; ++i) { const int sidx = sq * 8 + i; v[i] = bf2f(XS[sidx * 264 + hh * 64 + p]) * acum[256 + hh * 64 + sidx]; }
            *(u32x4*)(XT + p * 72 + sq * 8) = pack8(v);
        }
        *(u32x4*)(PV + row8 * 136 + seg8 * 8) = pv[0]; *(u32x4*)(PV + row8 * 136 + (seg8 + 8) * 8) = pv[1];
        if (hh < 3) { const bf16_t* src = (const bf16_t*)(F.ws + WS_R4 + R4_SSS) + ((size_t)(b * 8 + head + 1) * 64 + c) * 8192 + row8 * 128;
            pv[0] = *(const u32x4*)(src + seg8 * 8); pv[1] = *(const u32x4*)(src + (seg8 + 8) * 8); }
        LDS_BARRIER();
        const float Dk = F.in[I_SD][l * 8 + head];
#pragma unroll
        for (int q = 0; q < 2; ++q) {
            const int pj = sj0 + q;
            const f32x4 a1 = mma16<64>(Mh + ti * 16 * 72, 72, XT + pj * 16 * 72, 72, lane, (f32x4){0.f, 0.f, 0.f, 0.f});
            const f32x4 a2 = mma16<128>(Cm + ti * 16 * 136, 136, PV + pj * 16 * 136, 136, lane, (f32x4){0.f, 0.f, 0.f, 0.f});
#pragma unroll
            for (int j = 0; j < 4; ++j) {
                const int lrow = ti * 16 + 4 * (lane >> 4) + j, p = pj * 16 + (lane & 15);
                const float xs = bf2f(XS[lrow * 264 + hh * 64 + p]);
                F.O[(t0 + lrow) * D + 512 + head * 64 + p] = a1[j] + fexp(acum[hh * 64 + lrow]) * a2[j] + Dk * xs;
            }
        }
        LDS_BARRIER();
    }
}


struct HgIn { float fr[16], q[16], v[16]; u32x4 sp[4]; };
__device__ __forceinline__ void hg_load(const Frame& F, int u, int tid, HgIn& x, bool out_phase) {
    const int h = u & 3, c = (u >> 2) & 63, b = u >> 8; const size_t t0 = (size_t)b * SEQ + c * 64;
    const int k = tid & 127, tq = tid >> 7;
#pragma unroll
    for (int i = 0; i < 16; ++i) { const BfPtr p = F.P + (t0 + tq * 16 + i) * PS + h * 128 + k; x.fr[i] = p[C_HG_F]; x.v[i] = p[C_HG_I]; if (out_phase) x.q[i] = p[C_HG_Q]; }
    if (out_phase) {
        const bf16_t* src = (const bf16_t*)(F.ws + WS_R4 + R4_HGS) + ((size_t)(b * 4 + h) * 64 + c) * 16384 + (tid >> 2) * 128;
#pragma unroll
        for (int i8 = 0; i8 < 4; ++i8) x.sp[i8] = *(const u32x4*)(src + (i8 * 4 + (tid & 3)) * 8);
    }
}
__device__ __forceinline__ void hg_cumlog(const Frame& F, int l, int h, float* gt, float (&freg)[16], float (&bown)[16], int tid, const HgIn& x) {
    const int k = tid & 127, tq = tid >> 7;
    float lb = 0.f;
    if (l > 0) { const float p0 = F.in[I_HGLB][h * 128 + k], p1 = F.in[I_HGLB][GW + h * 128 + k]; const float m = fmaxf(p0, p1); const float e0 = fexp(p0 - m), e1 = fexp(p1 - m); lb = e1 * frcp(e0 + e1); }
    float run = 0.f;
#pragma unroll
    for (int i = 0; i < 16; ++i) { const float f = lb + (1.0f - lb) * sigmoid_f(x.fr[i]); freg[i] = f; run += flog(f); bown[i] = run; }
    gt[tq * 128 + k] = run;
    LDS_BARRIER();
    float off = 0.f;
#pragma unroll
    for (int g2 = 0; g2 < 3; ++g2) off += (g2 < tq) ? gt[g2 * 128 + k] : 0.f;
#pragma unroll
    for (int i = 0; i < 16; ++i) bown[i] += off;
}
__device__ __forceinline__ void hg_local(const Frame& F, int l, int u, int tid, const HgIn& x) {
    const int h = u & 3, c = (u >> 2) & 63, b = u >> 8;
    const int lane = tid & 63, w = __builtin_amdgcn_readfirstlane(tid >> 6);
    float* gt = (float*)F.lds;
    bf16_t* kdT = (bf16_t*)(F.lds + 32768);
    bf16_t* vT = (bf16_t*)(F.lds + 51200);
    float freg[16], bown[16];
    hg_cumlog(F, l, h, gt, freg, bown, tid, x);
    {
        const int k = tid & 127, tq = tid >> 7;
        const float bend = gt[k] + gt[128 + k] + gt[256 + k] + gt[384 + k];
        float kd[16];
#pragma unroll
        for (int i = 0; i < 16; ++i) kd[i] = (1.0f - freg[i]) * fexp(bend - bown[i]);
        u32x4 p0, p1;
        p0.x = cvt_pk_bf16(kd[0], kd[1]); p0.y = cvt_pk_bf16(kd[2], kd[3]); p0.z = cvt_pk_bf16(kd[4], kd[5]); p0.w = cvt_pk_bf16(kd[6], kd[7]);
        p1.x = cvt_pk_bf16(kd[8], kd[9]); p1.y = cvt_pk_bf16(kd[10], kd[11]); p1.z = cvt_pk_bf16(kd[12], kd[13]); p1.w = cvt_pk_bf16(kd[14], kd[15]);
        *(u32x4*)(kdT + k * 72 + tq * 16) = p0; *(u32x4*)(kdT + k * 72 + tq * 16 + 8) = p1;
        p0.x = cvt_pk_bf16(x.v[0], x.v[1]); p0.y = cvt_pk_bf16(x.v[2], x.v[3]); p0.z = cvt_pk_bf16(x.v[4], x.v[5]); p0.w = cvt_pk_bf16(x.v[6], x.v[7]);
        p1.x = cvt_pk_bf16(x.v[8], x.v[9]); p1.y = cvt_pk_bf16(x.v[10], x.v[11]); p1.z = cvt_pk_bf16(x.v[12], x.v[13]); p1.w = cvt_pk_bf16(x.v[14], x.v[15]);
        *(u32x4*)(vT + k * 72 + tq * 16) = p0; *(u32x4*)(vT + k * 72 + tq * 16 + 8) = p1;
        if (tq == 0) ((float*)(F.ws + WS_R4 + R4_HGD))[((size_t)(b * 4 + h) * 64 + c) * 128 + k] = fexp(bend);
    }
    LDS_BARRIER();
    {
        bf16_t* dst = (bf16_t*)(F.ws + WS_R4 + R4_HGS) + ((size_t)(b * 4 + h) * 64 + c) * 16384;
#pragma unroll
        for (int kp = 0; kp < 4; ++kp) {
            const f32x4 a0 = mma16<64>(kdT + (2 * kp) * 16 * 72, 72, vT + w * 16 * 72, 72, lane, (f32x4){0.f, 0.f, 0.f, 0.f});
            const f32x4 a1 = mma16<64>(kdT + (2 * kp + 1) * 16 * 72, 72, vT + w * 16 * 72, 72, lane, (f32x4){0.f, 0.f, 0.f, 0.f});
            *(u32x4*)(dst + (w * 16 + (lane & 15)) * 128 + kp * 32 + pair16_col(lane)) = pair16(a0, a1);
        }
    }
    LDS_BARRIER();
}
__device__ __forceinline__ void hg_scan(const Frame& F, int e) {
    const int bh = e >> 14, r = e & 16383, k = r & 127;
    bf16_t* st = (bf16_t*)(F.ws + WS_R4 + R4_HGS) + (size_t)bh * 64 * 16384 + r; const float* dec = (const float*)(F.ws + WS_R4 + R4_HGD) + (size_t)bh * 64 * 128 + k;
    float h = 0.f;
    for (int c0 = 0; c0 < 64; c0 += 16) {
        float tmp[16], dd[16];
#pragma unroll
        for (int i = 0; i < 16; ++i) { tmp[i] = bf2f(st[(size_t)(c0 + i) * 16384]); dd[i] = dec[(c0 + i) * 128]; }
#pragma unroll
        for (int i = 0; i < 16; ++i) { st[(size_t)(c0 + i) * 16384] = f2bf(h); h = h * dd[i] + tmp[i]; }
    }
}
__device__ __forceinline__ void hg_out(const Frame& F, int l, int u, int tid, const HgIn& x) {
    const int h = u & 3, c = (u >> 2) & 63, b = u >> 8; const size_t t0 = (size_t)b * SEQ + c * 64;
    const int lane = tid & 63, w = __builtin_amdgcn_readfirstlane(tid >> 6);
    float* gt = (float*)F.lds;
    bf16_t* Sc = (bf16_t*)F.lds;
    bf16_t* qh = (bf16_t*)(F.lds + 32768);
    bf16_t* kh = (bf16_t*)(F.lds + 50176);
    bf16_t* vT = (bf16_t*)(F.lds + 67584);
    bf16_t* Sp = (bf16_t*)(F.lds + 86016);
    float freg[16], bown[16];
    hg_cumlog(F, l, h, gt, freg, bown, tid, x);
    {
        const int k = tid & 127, tq = tid >> 7;
        const float m = gt[k] + gt[128 + k];
#pragma unroll
        for (int i = 0; i < 16; ++i) {
            const int t = tq * 16 + i; const float bb = bown[i];
            qh[t * 136 + k] = f2bf(silu_f(x.q[i]) * fexp(bb - m)); kh[t * 136 + k] = f2bf((1.0f - freg[i]) * fexp(m - bb));
        }
        u32x4 p0, p1;
        p0.x = cvt_pk_bf16(x.v[0], x.v[1]); p0.y = cvt_pk_bf16(x.v[2], x.v[3]); p0.z = cvt_pk_bf16(x.v[4], x.v[5]); p0.w = cvt_pk_bf16(x.v[6], x.v[7]);
        p1.x = cvt_pk_bf16(x.v[8], x.v[9]); p1.y = cvt_pk_bf16(x.v[10], x.v[11]); p1.z = cvt_pk_bf16(x.v[12], x.v[13]); p1.w = cvt_pk_bf16(x.v[14], x.v[15]);
        *(u32x4*)(vT + k * 72 + tq * 16) = p0; *(u32x4*)(vT + k * 72 + tq * 16 + 8) = p1;
        const int v = tid >> 2;
#pragma unroll
        for (int i8 = 0; i8 < 4; ++i8) {
            const u32x4 raw = x.sp[i8]; const int kq = (i8 * 4 + (tid & 3)) * 8 - i8 * 8;
            float mm[8];
#pragma unroll
            for (int e = 0; e < 8; ++e) mm[e] = gt[kq + i8 * 8 + e] + gt[128 + kq + i8 * 8 + e];
            u32x4 pk; pk.x = cvt_pk_bf16(__uint_as_float(raw.x << 16) * fexp(mm[0]), __uint_as_float(raw.x & 0xffff0000u) * fexp(mm[1])); pk.y = cvt_pk_bf16(__uint_as_float(raw.y << 16) * fexp(mm[2]), __uint_as_float(raw.y & 0xffff0000u) * fexp(mm[3]));
            pk.z = cvt_pk_bf16(__uint_as_float(raw.z << 16) * fexp(mm[4]), __uint_as_float(raw.z & 0xffff0000u) * fexp(mm[5])); pk.w = cvt_pk_bf16(__uint_as_float(raw.w << 16) * fexp(mm[6]), __uint_as_float(raw.w & 0xffff0000u) * fexp(mm[7]));
            *(u32x4*)(Sp + v * 136 + kq + i8 * 8) = pk;
        }
    }
    LDS_BARRIER();
    const int ti = w >> 1;
    {
        f32x4 sc[2];
#pragma unroll
        for (int q = 0; q < 2; ++q) sc[q] = mma16<128>(qh + ti * 16 * 136, 136, kh + (2 * (w & 1) + q) * 16 * 136, 136, lane, (f32x4){0.f, 0.f, 0.f, 0.f});
#pragma unroll
        for (int q = 0; q < 2; ++q)
#pragma unroll
            for (int j = 0; j < 4; ++j) {
                const int t = ti * 16 + 4 * (lane >> 4) + j, sidx = (2 * (w & 1) + q) * 16 + (lane & 15);
                Sc[t * 72 + sidx] = f2bf(sidx <= t ? sc[q][j] : 0.f);
            }
    }
    LDS_BARRIER();
#pragma unroll
    for (int q = 0; q < 4; ++q) {
        const int vj = (w & 1) * 4 + q;
        f32x4 acc = mma16<64>(Sc + ti * 16 * 72, 72, vT + vj * 16 * 72, 72, lane, (f32x4){0.f, 0.f, 0.f, 0.f});
        acc = mma16<128>(qh + ti * 16 * 136, 136, Sp + vj * 16 * 136, 136, lane, acc);
#pragma unroll
        for (int j = 0; j < 4; ++j) F.O[(t0 + ti * 16 + 4 * (lane >> 4) + j) * D + h * 128 + vj * 16 + (lane & 15)] = acc[j];
    }
    LDS_BARRIER();
}


__device__ __forceinline__ u32x2 pack4(const f32x4 v) { u32x2 p; p.x = cvt_pk_bf16(v[0], v[1]); p.y = cvt_pk_bf16(v[2], v[3]); return p; }
__device__ __forceinline__ f32x4 unpack4(const u32x2 p) { f32x4 v; v[0] = __uint_as_float(p.x << 16); v[1] = __uint_as_float(p.x & 0xffff0000u); v[2] = __uint_as_float(p.y << 16); v[3] = __uint_as_float(p.y & 0xffff0000u); return v; }
__device__ __forceinline__ u32x4 pack8(const float (&v)[8]) { u32x4 p; p.x = cvt_pk_bf16(v[0], v[1]); p.y = cvt_pk_bf16(v[2], v[3]); p.z = cvt_pk_bf16(v[4], v[5]); p.w = cvt_pk_bf16(v[6], v[7]); return p; }

struct RwRaw { float w[8], kka[8], k[8]; bf16_t pr[9], pk[9], pv[9]; };
struct RwIn { float w[8], kk[8], r[8], kka[8], k[8], v[8]; };
__device__ __forceinline__ void rw_load(const Frame& F, int b, int c, int h, int tid, RwRaw& x) {
    const size_t t0 = (size_t)b * SEQ + c * 64; const int k = tid & 63, ig = tid >> 6;
#pragma unroll
    for (int ii = 0; ii < 8; ++ii) { const float* q = F.Q + (t0 + ig * 8 + ii) * QS + h * 64 + k; x.w[ii] = q[Q_W]; x.kka[ii] = q[Q_KKA]; x.k[ii] = q[Q_K]; }
    const bool first = (ig == 0) && (c == 0);
#pragma unroll
    for (int j = 0; j < 9; ++j) { const bf16_t* p = F.P.p + (long)((long)t0 + ig * 8 - 1 + j) * PS + C_RW + h * 64 + k;
        const bool z = first && (j == 0); x.pr[j] = z ? (bf16_t)0 : p[0]; x.pk[j] = z ? (bf16_t)0 : p[512]; x.pv[j] = z ? (bf16_t)0 : p[1024]; }
}
__device__ __forceinline__ void rw_finish(const Frame& F, int l, int h, int tid, const RwRaw& a, RwIn& x) {
    const int k = tid & 63; const float* mu = F.in[I_WMU] + (size_t)l * RW_COLS + h * 64 + k;
    const float mr = mu[0], mkk = mu[512], mv = mu[1024], kkc = F.in[I_WKK][l * GW + h * 64 + k];
#pragma unroll
    for (int ii = 0; ii < 8; ++ii) {
        const float rc = bf2f(a.pr[ii + 1]), rp = bf2f(a.pr[ii]), kc = bf2f(a.pk[ii + 1]), kp = bf2f(a.pk[ii]), vc = bf2f(a.pv[ii + 1]), vp = bf2f(a.pv[ii]);
        x.r[ii] = rc + (rp - rc) * mr; x.v[ii] = vc + (vp - vc) * mv;
        const float kx = (kc + (kp - kc) * mkk) * kkc; const float ss = wave_sum(kx * kx);
        x.kk[ii] = kx * frcp(fmaxf(__builtin_amdgcn_sqrtf(ss), 1e-12f));
        x.w[ii] = a.w[ii]; x.kka[ii] = a.kka[ii]; x.k[ii] = a.k[ii];
    }
}
__device__ __forceinline__ void rw_prep(const Frame& F, int l, int b, int c, int h, int tid, const RwIn& x) {
    const int ru = (b * 64 + c) * 8 + h;
    unsigned char* rec = F.ws + WS_U + (size_t)ru * RW_REC;
    float* aabT = (float*)(F.ws + WS_RWAAB) + (size_t)ru * 4096;
    const int lane = tid & 63, w = __builtin_amdgcn_readfirstlane(tid >> 6);
    float* cumL = (float*)F.lds;
    bf16_t* Ar = (bf16_t*)(F.lds + 16640);
    bf16_t* Rr = Ar + 64 * 72; bf16_t* Br = Rr + 64 * 72; bf16_t* Kr = Br + 64 * 72; bf16_t* KrT = Kr + 64 * 72; bf16_t* vT = KrT + 64 * 72; bf16_t* AakT = vT + 64 * 72; bf16_t* ArkT = AakT + 64 * 72;
    const int k = tid & 63, ig = tid >> 6;
    {
        const float rkc = F.in[I_WRK][l * GW + h * 64 + k]; float* bon = (float*)(F.ws + WS_BON) + ((size_t)b * SEQ + c * 64 + ig * 8) * 8 + h;
#pragma unroll
        for (int ii = 0; ii < 8; ++ii) { const float sv = wave_sum(x.r[ii] * x.k[ii] * rkc); if (k == 0) bon[ii * 8] = sv; }
    }
    float pre[8];
    { float run = 0.f;
#pragma unroll
      for (int ii = 0; ii < 8; ++ii) { run += flog(x.w[ii]); pre[ii] = run; }
      cumL[ig * 64 + k] = run; }
    LDS_BARRIER();
    float off = 0.f, tot = 0.f;
#pragma unroll
    for (int g2 = 0; g2 < 8; ++g2) { const float gv = cumL[g2 * 64 + k]; off += (g2 < ig) ? gv : 0.f; tot += gv; }
    {
        float brv[8], krv[8], vvv[8];
#pragma unroll
        for (int ii = 0; ii < 8; ++ii) {
            const int i = ig * 8 + ii;
            const float cu = off + pre[ii]; const float cux = (ii > 0) ? off + pre[ii - 1] : off;
            const float e_in = fexp(cu), e_ex = fexp(cux), e_neg = fexp(-cu);
            const float ar = -x.kk[ii] * e_ex, rr = x.r[ii] * e_in; brv[ii] = x.kka[ii] * e_neg; krv[ii] = x.k[ii] * e_neg; vvv[ii] = x.v[ii];
            const bf16_t arb = f2bf(ar), rrb = f2bf(rr);
            Ar[i * 72 + k] = arb; Rr[i * 72 + k] = rrb; Br[i * 72 + k] = f2bf(brv[ii]); Kr[i * 72 + k] = f2bf(krv[ii]);
            ((bf16_t*)(rec + RO_AR))[i * 64 + k] = arb; ((bf16_t*)(rec + RO_RR))[i * 64 + k] = rrb;
        }
        *(u32x4*)(KrT + k * 72 + ig * 8) = pack8(krv); *(u32x4*)(vT + k * 72 + ig * 8) = pack8(vvv);
        *(u32x4*)((bf16_t*)(rec + RO_BRT) + k * 64 + ig * 8) = pack8(brv);
        if (ig == 0) ((float*)(F.ws + WS_RWGC))[ru * 64 + k] = fexp(tot);
    }
    LDS_BARRIER();
    const int ri = w >> 1, cj0 = 2 * (w & 1);
    const f32x4 z4 = (f32x4){0.f, 0.f, 0.f, 0.f};
#pragma unroll
    for (int q = 0; q < 2; ++q) {
        const int cj = cj0 + q;
        f32x4 aab = mma16<64>(Br + ri * 16 * 72, 72, Ar + cj * 16 * 72, 72, lane, z4);
        f32x4 aak = mma16<64>(Kr + ri * 16 * 72, 72, Ar + cj * 16 * 72, 72, lane, z4);
        f32x4 arb = mma16<64>(Br + ri * 16 * 72, 72, Rr + cj * 16 * 72, 72, lane, z4);
        f32x4 ark = mma16<64>(Kr + ri * 16 * 72, 72, Rr + cj * 16 * 72, 72, lane, z4);
        const int i0 = ri * 16 + 4 * (lane >> 4), t = cj * 16 + (lane & 15);
#pragma unroll
        for (int j = 0; j < 4; ++j) { const bool st = (i0 + j) < t, inc = (i0 + j) <= t; aab[j] = st ? aab[j] : 0.f; aak[j] = st ? aak[j] : 0.f; arb[j] = inc ? arb[j] : 0.f; ark[j] = inc ? ark[j] : 0.f; }
        *(f32x4*)(aabT + t * 64 + i0) = aab;
        *(u32x2*)(AakT + t * 72 + i0) = pack4(aak);
        *(u32x2*)((bf16_t*)(rec + RO_ARBT) + t * 64 + i0) = pack4(arb);
        *(u32x2*)(ArkT + t * 72 + i0) = pack4(ark);
    }
    LDS_BARRIER();
#pragma unroll
    for (int q = 0; q < 2; ++q) {
        const int cj = cj0 + q, tile = ri * 4 + cj;
        const f32x4 xl = mma16<64>(AakT + ri * 16 * 72, 72, vT + cj * 16 * 72, 72, lane, z4);
        const f32x4 lt = mma16<64>(KrT + ri * 16 * 72, 72, vT + cj * 16 * 72, 72, lane, z4);
        const f32x4 yl = mma16<64>(ArkT + ri * 16 * 72, 72, vT + cj * 16 * 72, 72, lane, z4);
        *(u32x2*)(rec + RO_XL + tile * 512 + lane * 8) = pack4(xl);
        *(u32x2*)(rec + RO_LT + tile * 512 + lane * 8) = pack4(lt);
        *(u32x2*)(rec + RO_YL + tile * 512 + lane * 8) = pack4(yl);
    }
    LDS_BARRIER();
}

template <int t> __device__ __forceinline__ void tsolve_step(float (&T)[64], const LAS float* A, int lane) {
    if constexpr (t < 64) {
        float acc = (lane == t) ? 1.0f : 0.0f;
        const LAS float* row = A + t * 64;
        if constexpr (t > 0) asm("" : "+v"(row) : "v"(T[t - 1]));
        const LAS f32x4* row4 = (const LAS f32x4*)row;
#pragma unroll
        for (int i4 = 0; i4 < t / 4; ++i4) { const f32x4 v = row4[i4]; acc += T[4 * i4] * v[0]; acc += T[4 * i4 + 1] * v[1]; acc += T[4 * i4 + 2] * v[2]; acc += T[4 * i4 + 3] * v[3]; }
#pragma unroll
        for (int i = (t / 4) * 4; i < t; ++i) acc += T[i] * row[i];
        T[t] = acc;
        tsolve_step<t + 1>(T, A, lane);
    }
}
__device__ __forceinline__ void rw_tsolve(const Frame& F, int ru, int w, int lane) {
    LAS float* A = (LAS float*)((LAS unsigned char*)F.lds + w * 16384);
    const float* src = (const float*)(F.ws + WS_RWAAB) + (size_t)ru * 4096;
#pragma unroll
    for (int q = 0; q < 16; ++q) *(LAS f32x4*)(A + (q * 64 + lane) * 4) = *(const f32x4*)(src + (q * 64 + lane) * 4);
    float T[64];
    tsolve_step<0>(T, A, lane);
    bf16_t* Tl = (bf16_t*)(F.lds + w * 16384);
#pragma unroll
    for (int i8 = 0; i8 < 8; ++i8) { float v[8];
#pragma unroll
        for (int e = 0; e < 8; ++e) v[e] = T[i8 * 8 + e];
        *(u32x4*)(Tl + lane * 72 + i8 * 8) = pack8(v); }
    unsigned char* rec = F.ws + WS_U + (size_t)ru * RW_REC;
#pragma unroll 1
    for (int which = 0; which < 2; ++which) {
        bf16_t* M = (bf16_t*)(rec + (which ? RO_BRT : RO_ARBT));
#pragma unroll 1
        for (int tt = 0; tt < 4; ++tt) {
            bf16x8 bfr[2];
#pragma unroll
            for (int s2 = 0; s2 < 2; ++s2) bfr[s2] = *(const bf16x8*)(M + (tt * 16 + (lane & 15)) * 64 + (lane >> 4) * 8 + s2 * 32);
            f32x4 acc[4];
#pragma unroll
            for (int jt = 0; jt < 4; ++jt) {
                acc[jt] = (f32x4){0.f, 0.f, 0.f, 0.f};
#pragma unroll
                for (int s2 = 0; s2 < 2; ++s2) { const bf16x8 a = *(const bf16x8*)(Tl + (jt * 16 + (lane & 15)) * 72 + (lane >> 4) * 8 + s2 * 32); acc[jt] = __builtin_amdgcn_mfma_f32_16x16x32_bf16(a, bfr[s2], acc[jt], 0, 0, 0); }
            }
#pragma unroll
            for (int jp = 0; jp < 2; ++jp) *(u32x4*)(M + (tt * 16 + (lane & 15)) * 64 + jp * 32 + pair16_col(lane)) = pair16(acc[2 * jp], acc[2 * jp + 1]);
        }
    }
}

__device__ __forceinline__ f32x4 mma16r(const bf16x8 (&a)[2], const bf16_t* Bt, int ldb, int lane, f32x4 acc) {
    const bf16_t* bp = Bt + (lane & 15) * ldb + (lane >> 4) * 8;
#pragma unroll
    for (int s2 = 0; s2 < 2; ++s2) { const bf16x8 b = *(const bf16x8*)(bp + s2 * 32); acc = __builtin_amdgcn_mfma_f32_16x16x32_bf16(a[s2], b, acc, 0, 0, 0); }
    return acc;
}
struct RwStage { u32x4 a[4]; u32x2 dXl, dLt, dYl; f32x4 gc; };
__device__ __forceinline__ void rw_stage_load(const Frame& F, int b, int h, int cc, int tid, int tile, int lane, int r4, RwStage& S) {
    const int ru = (b * 64 + cc) * 8 + h; const unsigned char* rec = F.ws + WS_U + (size_t)ru * RW_REC;
#pragma unroll
    for (int m = 0; m < 4; ++m) S.a[m] = *(const u32x4*)(rec + m * 8192 + tid * 16);
    S.dXl = *(const u32x2*)(rec + RO_XL + tile * 512 + lane * 8); S.dLt = *(const u32x2*)(rec + RO_LT + tile * 512 + lane * 8); S.dYl = *(const u32x2*)(rec + RO_YL + tile * 512 + lane * 8);
    S.gc = *(const f32x4*)((const float*)(F.ws + WS_RWGC) + ru * 64 + r4);
}
static_assert(RO_AR == 0 && RO_RR == 8192 && RO_BRT == 16384 && RO_ARBT == 24576 && RO_TT == 32768, "record layout");
__device__ __forceinline__ void rw_stage_park(const RwStage& S, bf16_t* img, int tid) {
#pragma unroll
    for (int m = 0; m < 4; ++m) *(u32x4*)(img + m * 4608 + (tid >> 3) * 72 + (tid & 7) * 8) = S.a[m];
}
__device__ __forceinline__ f32x4 mma16l(const bf16_t* A, const bf16_t* Bt, int lane, f32x4 acc) { return mma16<64>(A, 72, Bt, 72, lane, acc); }
__device__ __forceinline__ void rw_seq(const Frame& F, int job, int tid) {
    const int bh = job >> 1, vh = job & 1, b = bh >> 3, h = bh & 7;
    const int lane = tid & 63, w = __builtin_amdgcn_readfirstlane(tid >> 6), ri = w >> 1, cjl = (w & 1), cj = 2 * vh + cjl;
    bf16_t* S0 = (bf16_t*)F.lds; bf16_t* Xb = S0 + 32 * 72; bf16_t* Ub = Xb + 32 * 72;
    bf16_t* IMG = (bf16_t*)(F.lds + 16384);
    for (int i = tid; i < 32 * 72 / 2; i += 512) ((unsigned*)S0)[i] = 0u;
    f32x4 st = (f32x4){0.f, 0.f, 0.f, 0.f};
    const int vcol = lane & 15, r4 = ri * 16 + 4 * (lane >> 4), tile = ri * 4 + cj;
    RwStage s0, s1, s2;
    rw_stage_load(F, b, h, 0, tid, tile, lane, r4, s0); rw_stage_load(F, b, h, 1, tid, tile, lane, r4, s1); rw_stage_load(F, b, h, 2, tid, tile, lane, r4, s2);
    rw_stage_park(s0, IMG, tid);
    __syncthreads();
    const size_t tb = (size_t)b * SEQ;
#define RW_STEP(cc, S, SN) do { const bf16_t* im = IMG + ((cc) & 1) * 23040 + ri * 16 * 72; \
        const f32x4 xl = unpack4(S.dXl), lt = unpack4(S.dLt); f32x4 y = unpack4(S.dYl); const f32x4 gcc = S.gc; \
        { const f32x4 x = mma16l(im + 0 * 4608, S0 + cjl * 16 * 72, lane, xl); y = mma16l(im + 1 * 4608, S0 + cjl * 16 * 72, lane, y); \
          *(u32x2*)(Xb + (cjl * 16 + vcol) * 72 + r4) = pack4(x); } \
        LDS_BARRIER(); \
        { y = mma16l(im + 3 * 4608, Xb + cjl * 16 * 72, lane, y);                   \
          _Pragma("unroll") for (int j = 0; j < 4; ++j) F.O[(tb + (size_t)(cc) * 64 + r4 + j) * D + 1536 + h * 64 + cj * 16 + vcol] = y[j]; \
          st = mma16l(im + 2 * 4608, Xb + cjl * 16 * 72, lane, st);                 \
          _Pragma("unroll") for (int j = 0; j < 4; ++j) st[j] = (st[j] + lt[j]) * gcc[j]; \
          *(u32x2*)(S0 + (cjl * 16 + vcol) * 72 + r4) = pack4(st); } \
        if ((cc) + 1 < 64) rw_stage_park(SN, IMG + (((cc) + 1) & 1) * 23040, tid); \
        LDS_BARRIER(); \
        if ((cc) + 3 < 64) rw_stage_load(F, b, h, (cc) + 3, tid, tile, lane, r4, S); } while (0)
#pragma unroll 1
    for (int c = 0; c < 64; c += 3) {
        RW_STEP(c, s0, s1);
        if (c + 1 < 64) RW_STEP(c + 1, s1, s2);
        if (c + 2 < 64) RW_STEP(c + 2, s2, s0);
    }
#undef RW_STEP
}

constexpr int NU_HG = 1024, NU_SSD = 512, NU_RG = 256;
__device__ __forceinline__ void hg_scan4(const Frame& F, int e4) {
    const int bh = e4 >> 12, r = (e4 & 4095) * 4, k = r & 127;
    bf16_t* st = (bf16_t*)(F.ws + WS_R4 + R4_HGS) + (size_t)bh * 64 * 16384 + r; const float* dec = (const float*)(F.ws + WS_R4 + R4_HGD) + (size_t)bh * 64 * 128 + k;
    f32x4 h = (f32x4){0.f, 0.f, 0.f, 0.f};
#pragma unroll 1
    for (int c0 = 0; c0 < 64; c0 += 16) {
        u32x2 tmp[16]; f32x4 dd[16];
#pragma unroll
        for (int i = 0; i < 16; ++i) { tmp[i] = *(const u32x2*)(st + (size_t)(c0 + i) * 16384); dd[i] = *(const f32x4*)(dec + (c0 + i) * 128); }
#pragma unroll
        for (int i = 0; i < 16; ++i) { *(u32x2*)(st + (size_t)(c0 + i) * 16384) = pack4(h); h = h * dd[i] + unpack4(tmp[i]); }
    }
}
__device__ __forceinline__ void ssd_scan8(const Frame& F, int e8) {
    const int bh = e8 >> 10, r = (e8 & 1023) * 8;
    bf16_t* st = (bf16_t*)(F.ws + WS_R4 + R4_SSS) + (size_t)bh * 64 * 8192 + r; const float* dec = (const float*)(F.ws + WS_R4 + R4_SSD) + bh * 64;
    float h[8];
#pragma unroll
    for (int j = 0; j < 8; ++j) h[j] = 0.f;
#pragma unroll 1
    for (int c0 = 0; c0 < 64; c0 += 16) {
        u32x4 tmp[16]; float dd[16];
#pragma unroll
        for (int i = 0; i < 16; ++i) { tmp[i] = *(const u32x4*)(st + (size_t)(c0 + i) * 8192); dd[i] = dec[c0 + i]; }
#pragma unroll
        for (int i = 0; i < 16; ++i) {
            *(u32x4*)(st + (size_t)(c0 + i) * 8192) = pack8(h);
#pragma unroll
            for (int j = 0; j < 8; ++j) h[j] = h[j] * dd[i] + bfel(tmp[i], j);
        }
    }
}
__device__ __forceinline__ void rg_scan2(const Frame& F, int e) {
    const int b = e >> 9, j = e & 511;
    float* rgc = (float*)(F.ws + WS_R4 + R4_RGC);
    float h = 0.f;
#pragma unroll 1
    for (int c0 = 0; c0 < 64; c0 += 32) {
        float2 pe[32];
#pragma unroll
        for (int i = 0; i < 32; ++i) pe[i] = *(const float2*)(rgc + ((size_t)(b * 64 + c0 + i) * 512 + j) * 2);
#pragma unroll
        for (int i = 0; i < 32; ++i) { rgc[((size_t)(b * 64 + c0 + i) * 512 + j) * 2 + 1] = h; h = pe[i].x * h + pe[i].y; }
    }
}
__device__ __forceinline__ void phase_m2(const Frame& F, int l) {
    const int tid = opaque_tid();
#ifndef SKIP_RWSEQ
    if (F.bid < 64) { rw_seq(F, F.bid, tid); return; }
#endif
    const int gt = (F.bid - 64) * 512 + tid, nthr = (F.G - 64) * 512;
    constexpr int N_HG = 16 * 4096, N_SS = 32 * 1024, N_RG = 2048;
    for (int it = gt; it < N_RG + N_HG + N_SS; it += nthr) {
        if (it < N_RG) rg_scan2(F, it); else if (it < N_RG + N_HG) hg_scan4(F, it - N_RG); else ssd_scan8(F, it - N_RG - N_HG);
    }
    __syncthreads();
    for (int i = F.bid - 64; i < DEFER_TILES / 2; i += F.G - 64) conv_down_tile(F, 64 * 16 * 8 - DEFER_TILES + l * (DEFER_TILES / 2) + i, tid);
}


__device__ __forceinline__ void phase_front(const Frame& F, int l) {
    for (int ch = F.bid; ch < NTOK / 64; ch += F.G) {
        pre_steps14(F, l, ch); LDS_BARRIER(); pre_5a(F, l, ch); LDS_BARRIER(); pre_5b(F, l, ch); __syncthreads();
        const int tid = opaque_tid();
        { RwRaw nx; rw_load(F, ch >> 6, ch & 63, 0, tid, nx);
#pragma unroll 1
          for (int hh = 0; hh < 8; ++hh) { RwIn cu; rw_finish(F, l, hh, tid, nx, cu); if (hh < 7) rw_load(F, ch >> 6, ch & 63, hh + 1, tid, nx); rw_prep(F, l, ch >> 6, ch & 63, hh, tid, cu); } }
        __syncthreads();
        { const int w = __builtin_amdgcn_readfirstlane(tid >> 6); rw_tsolve(F, ch * 8 + w, w, tid & 63); }
        LDS_BARRIER();
        { HgIn nx; hg_load(F, ch * 4, tid, nx, false);
#pragma unroll 1
          for (int h = 0; h < 4; ++h) { const HgIn cu = nx; if (h < 3) hg_load(F, ch * 4 + h + 1, tid, nx, false); hg_local(F, l, ch * 4 + h, tid, cu); } }
        for (int g = 0; g < 2; ++g) ssd_local(F, l, ch * 2 + g, tid);
        rg_local(F, ch, tid);
        __syncthreads();
    }
}
__device__ __forceinline__ void phase_c3_chunk(const Frame& F, int l, int ch);
__device__ __forceinline__ void phase_back(const Frame& F, int l) {
    for (int ch = F.bid; ch < NTOK / 64; ch += F.G) {
        const int tid = opaque_tid();
        { HgIn nx; hg_load(F, ch * 4, tid, nx, true);
#pragma unroll 1
          for (int h = 0; h < 4; ++h) { const HgIn cu = nx; if (h < 3) hg_load(F, ch * 4 + h + 1, tid, nx, true); hg_out(F, l, ch * 4 + h, tid, cu); } }
        for (int g = 0; g < 2; ++g) ssd_out(F, l, ch * 2 + g, tid);
        rg_out(F, ch, tid);
        __syncthreads();
        phase_c3_chunk(F, l, ch);
        __syncthreads();
    }
}

struct C3In { float o[32], pg[8], pz[8], qv[8], qg[8], bon[8]; };
__device__ __forceinline__ void c3_load(const Frame& F, int l, int t, int lane, C3In& x) {
    const float* o = F.O + (size_t)t * D; const BfPtr p = F.P + (size_t)t * PS; const float* q = F.Q + (size_t)t * QS;
#pragma unroll
    for (int j = 0; j < 32; ++j) if (j < 16 || j >= 24) x.o[j] = o[lane + 64 * j];
#pragma unroll
    for (int j = 0; j < 8; ++j) { const int c = lane + 64 * j; x.pg[j] = p[C_HG_G + c]; x.pz[j] = p[C_SS_Z + c]; { const float vc = p[C_RW + 1024 + c], vp = ((t & (SEQ - 1)) != 0) ? p[C_RW + 1024 + c - (long)PS] : 0.f; x.qv[j] = vc + (vp - vc) * F.in[I_WMU][(size_t)l * RW_COLS + 1024 + c]; } x.qg[j] = q[Q_G + c]; x.bon[j] = ((const float*)(F.ws + WS_BON))[(size_t)t * 8 + j]; }
}
__device__ __forceinline__ void c3_unpack(u32x2 p, float (&f)[4]) { f[0] = __uint_as_float(p.x << 16); f[1] = __uint_as_float(p.x & 0xffff0000u); f[2] = __uint_as_float(p.y << 16); f[3] = __uint_as_float(p.y & 0xffff0000u); }
__device__ __forceinline__ void phase_c3_chunk(const Frame& F, int l, int ch) {
    const int tid_ = opaque_tid(); const int lane = tid_ & 63; const int wave_ = __builtin_amdgcn_readfirstlane(tid_ >> 6);
    const int t0 = ch * 64 + wave_ * 8, c0 = 4 * lane;
    const bf16_t* P = F.Pw;
    const float* hgw = F.in[I_HGNW] + l * GW; const float* snw = F.in[I_SNW] + l * GW;
    const float* lnw = F.in[I_WLNW] + l * GW; const float* lnb = F.in[I_WLNB] + l * GW; const float* mu = F.in[I_WMU] + (size_t)l * RW_COLS + 1024;
    const float* BON = (const float*)(F.ws + WS_BON);
    f32x4 oA[8][2]; u32x2 gA[8][2]; f32x4 wA[2];
    f32x4 oB[8][2]; u32x2 zB[8][2]; f32x4 wB[2];
#pragma unroll
    for (int i = 0; i < 8; ++i)
#pragma unroll
        for (int jj = 0; jj < 2; ++jj) { oA[i][jj] = *(const f32x4*)(F.O + (size_t)(t0 + i) * D + c0 + 256 * jj); gA[i][jj] = *(const u32x2*)(P + (size_t)(t0 + i) * PS + C_HG_G + c0 + 256 * jj); }
#pragma unroll
    for (int jj = 0; jj < 2; ++jj) wA[jj] = *(const f32x4*)(hgw + c0 + 256 * jj);
#pragma unroll
    for (int i = 0; i < 8; ++i)
#pragma unroll
        for (int jj = 0; jj < 2; ++jj) { oB[i][jj] = *(const f32x4*)(F.O + (size_t)(t0 + i) * D + 512 + c0 + 256 * jj); zB[i][jj] = *(const u32x2*)(P + (size_t)(t0 + i) * PS + C_SS_Z + c0 + 256 * jj); }
#pragma unroll
    for (int jj = 0; jj < 2; ++jj) wB[jj] = *(const f32x4*)(snw + c0 + 256 * jj);
#pragma unroll
    for (int i = 0; i < 8; ++i)
#pragma unroll
        for (int jj = 0; jj < 2; ++jj) {
            const f32x4 ov = oA[i][jj];
            float ss = row16_sum(ov[0] * ov[0] + ov[1] * ov[1] + ov[2] * ov[2] + ov[3] * ov[3]); ss += __shfl_xor(ss, 16);
            const float rs = rsqrtf(ss * (1.0f / 128.0f) + NORM_EPS);
            float gf[4]; c3_unpack(gA[i][jj], gf);
            u32x2 pk; pk.x = cvt_pk_bf16(ov[0] * rs * wA[jj][0] * silu_f(gf[0]), ov[1] * rs * wA[jj][1] * silu_f(gf[1])); pk.y = cvt_pk_bf16(ov[2] * rs * wA[jj][2] * silu_f(gf[2]), ov[3] * rs * wA[jj][3] * silu_f(gf[3]));
            *(u32x2*)(F.MIX + (size_t)(t0 + i) * D + c0 + 256 * jj) = pk;
        }
    f32x4 w4[2], b4[2], m4[2];
#pragma unroll
    for (int jj = 0; jj < 2; ++jj) { w4[jj] = *(const f32x4*)(lnw + c0 + 256 * jj); b4[jj] = *(const f32x4*)(lnb + c0 + 256 * jj); m4[jj] = *(const f32x4*)(mu + c0 + 256 * jj); }
    f32x4 oR[2][4][2], qR[2][4][2]; u32x2 vcR[2][4][2], vpR[2][4][2]; float bonR[2][4][2];
#define C3_LOAD_RW(hb) do { _Pragma("unroll") for (int i = 0; i < 4; ++i) { const int t = t0 + 4 * (hb) + i; const bool first = (t & (SEQ - 1)) == 0; \
        _Pragma("unroll") for (int jj = 0; jj < 2; ++jj) { \
            oR[hb][i][jj] = *(const f32x4*)(F.O + (size_t)t * D + 1536 + c0 + 256 * jj); qR[hb][i][jj] = *(const f32x4*)(F.Q + (size_t)t * QS + Q_G + c0 + 256 * jj); \
            const bf16_t* pv = P + (size_t)t * PS + C_RW + 1024 + c0 + 256 * jj; vcR[hb][i][jj] = *(const u32x2*)pv; \
            vpR[hb][i][jj] = (u32x2){0u, 0u}; if (!first) vpR[hb][i][jj] = *(const u32x2*)(pv - PS); \
            bonR[hb][i][jj] = BON[(size_t)t * 8 + (lane >> 4) + 4 * jj]; } } } while (0)
#define C3_MATH_RW(hb) do { _Pragma("unroll") for (int i = 0; i < 4; ++i) _Pragma("unroll") for (int jj = 0; jj < 2; ++jj) { \
        const f32x4 y = oR[hb][i][jj]; const float mean = row16_sum(y[0] + y[1] + y[2] + y[3]) * (1.0f / 64.0f); \
        float d[4]; _Pragma("unroll") for (int k = 0; k < 4; ++k) d[k] = y[k] - mean; \
        const float var = row16_sum(d[0] * d[0] + d[1] * d[1] + d[2] * d[2] + d[3] * d[3]) * (1.0f / 64.0f); const float rstd = rsqrtf(var + 64e-5f); \
        float vcf[4], vpf[4], out[4]; c3_unpack(vcR[hb][i][jj], vcf); c3_unpack(vpR[hb][i][jj], vpf); \
        _Pragma("unroll") for (int k = 0; k < 4; ++k) { const float vv = vcf[k] + (vpf[k] - vcf[k]) * m4[jj][k]; out[k] = (d[k] * rstd * w4[jj][k] + b4[jj][k] + bonR[hb][i][jj] * vv) * qR[hb][i][jj][k]; } \
        u32x2 pk; pk.x = cvt_pk_bf16(out[0], out[1]); pk.y = cvt_pk_bf16(out[2], out[3]); \
        *(u32x2*)(F.MIX + (size_t)(t0 + 4 * (hb) + i) * D + 1536 + c0 + 256 * jj) = pk; } } while (0)
#pragma unroll
    for (int i = 0; i < 8; ++i)
#pragma unroll
        for (int jj = 0; jj < 2; ++jj) {
            float zf[4]; c3_unpack(zB[i][jj], zf);
            float v[4];
#pragma unroll
            for (int k = 0; k < 4; ++k) v[k] = oB[i][jj][k] * silu_f(zf[k]);
            const float ss = wave_sum(v[0] * v[0] + v[1] * v[1] + v[2] * v[2] + v[3] * v[3]);
            const float rs = rsqrtf(ss * (1.0f / 256.0f) + NORM_EPS);
            u32x2 pk; pk.x = cvt_pk_bf16(v[0] * rs * wB[jj][0], v[1] * rs * wB[jj][1]); pk.y = cvt_pk_bf16(v[2] * rs * wB[jj][2], v[3] * rs * wB[jj][3]);
            *(u32x2*)(F.MIX + (size_t)(t0 + i) * D + 512 + c0 + 256 * jj) = pk;
        }
    C3_LOAD_RW(0);
    C3_MATH_RW(0);
    C3_LOAD_RW(1);
    C3_MATH_RW(1);
#undef C3_LOAD_RW
#undef C3_MATH_RW
}


__device__ __forceinline__ void phase_router2(const Frame& F, int l) {
    const int tid = opaque_tid(); const int lane = tid & 63, w = __builtin_amdgcn_readfirstlane(tid >> 6);
    const int r = lane & 15, q = lane >> 4;
    const float* WRT = (const float*)(F.ws + WS_WRT) + (size_t)l * 48 * 2048;
    const float* nw = F.in[I_NFFN] + (size_t)l * D;
    const float* bg = F.in[I_RGB] + l * 4; const float* be = F.in[I_REB] + l * 32;
    unsigned* cnt = F.ctl + CW_CNT + l * 32;
    unsigned* route = (unsigned*)(F.tab + TAB_ROUTE);
    float* Lg = (float*)F.lds + w * (16 * 48);
    for (int tile = w * F.G + F.bid; tile < NTOK / 16; tile += 8 * F.G) {
        const size_t t0 = (size_t)tile * 16;
        f32x4 acc[3]; acc[0] = (f32x4){0.f, 0.f, 0.f, 0.f}; acc[1] = acc[0]; acc[2] = acc[0];
        float ss = 0.f;
        const float* hp = F.h + (t0 + r) * D + 4 * q; const float* bp = WRT + (size_t)r * 2048 + 4 * q;
#pragma unroll 4
        for (int kg = 0; kg < 128; ++kg) {
            const f32x4 a4 = *(const f32x4*)(hp + kg * 16);
            ss += a4[0] * a4[0] + a4[1] * a4[1] + a4[2] * a4[2] + a4[3] * a4[3];
#pragma unroll
            for (int n = 0; n < 3; ++n) {
                const f32x4 b4 = *(const f32x4*)(bp + (size_t)n * 16 * 2048 + kg * 16);
#pragma unroll
                for (int s2 = 0; s2 < 4; ++s2) acc[n] = __builtin_amdgcn_mfma_f32_16x16x4f32(a4[s2], b4[s2], acc[n], 0, 0, 0);
            }
        }
        ss += __shfl_xor(ss, 16); ss += __shfl_xor(ss, 32);
        const float rs = rsqrtf(ss * (1.0f / D) + NORM_EPS);
#pragma unroll
        for (int j = 0; j < 4; ++j) {
            const float rj = __shfl(rs, 4 * q + j);
#pragma unroll
            for (int n = 0; n < 3; ++n) Lg[(4 * q + j) * 48 + n * 16 + r] = acc[n][j] * rj;
        }
        if (lane < 16) {
            const float* lg = Lg + lane * 48; const int t = (int)t0 + lane;
            float gl[4];
#pragma unroll
            for (int i = 0; i < 4; ++i) gl[i] = lg[i] + bg[i];
            int gi = 0; float gm = gl[0];
#pragma unroll
            for (int i = 1; i < 4; ++i) if (gl[i] > gm) { gm = gl[i]; gi = i; }
            float gsum = 0.f;
#pragma unroll
            for (int i = 0; i < 4; ++i) gsum += fexp(gl[i] - gm);
            const float gtop = 1.0f / gsum;
            float el[8];
#pragma unroll
            for (int i = 0; i < 8; ++i) el[i] = lg[4 + gi * 8 + i] + be[gi * 8 + i];
            int j1 = 0; float m1 = el[0];
#pragma unroll
            for (int i = 1; i < 8; ++i) if (el[i] > m1) { m1 = el[i]; j1 = i; }
            int j2 = -1; float m2 = -INFINITY;
#pragma unroll
            for (int i = 0; i < 8; ++i) if (i != j1 && el[i] > m2) { m2 = el[i]; j2 = i; }
            if (j2 < 0) { j2 = (j1 == 0) ? 1 : 0; m2 = m1; }
            const float e2 = fexp(m2 - m1);
            const float g1 = gtop / (1.0f + e2), g2 = gtop * e2 / (1.0f + e2);
            const int x1 = gi * 8 + j1, x2 = gi * 8 + j2;
            const unsigned p1 = atomicAdd(&cnt[x1], 1u), p2 = atomicAdd(&cnt[x2], 1u);
            u32x4 a; a.x = (unsigned)x1; a.y = (unsigned)x2; a.z = p1; a.w = p2;
            *(u32x4*)(route + (size_t)t * 8) = a;
            route[(size_t)t * 8 + 4] = __float_as_uint(g1); route[(size_t)t * 8 + 5] = __float_as_uint(g2);
        }
#pragma unroll 1
        for (int r4b = 0; r4b < 16; r4b += 4) {
            f32x4 v[4][8];
#pragma unroll
            for (int ri = 0; ri < 4; ++ri)
#pragma unroll
                for (int jj = 0; jj < 8; ++jj) v[ri][jj] = *(const f32x4*)(F.h + (t0 + r4b + ri) * D + 4 * (lane + 64 * jj));
#pragma unroll
            for (int ri = 0; ri < 4; ++ri) {
                const float rj = __shfl(rs, r4b + ri);
                bf16_t* urow = F.U + (t0 + r4b + ri) * D;
#pragma unroll
                for (int jj = 0; jj < 8; ++jj) {
                    const int c = 4 * (lane + 64 * jj);
                    const f32x4 wv = *(const f32x4*)(nw + c);
                    u32x2 pk; pk.x = cvt_pk_bf16(v[ri][jj][0] * rj * wv[0], v[ri][jj][1] * rj * wv[1]); pk.y = cvt_pk_bf16(v[ri][jj][2] * rj * wv[2], v[ri][jj][3] * rj * wv[3]);
                    *(u32x2*)(urow + c) = pk;
                }
            }
        }
    }
}


__device__ __forceinline__ void phase_router3(const Frame& F, int l) {
    const int tid = opaque_tid(); const int lane = tid & 63, w = __builtin_amdgcn_readfirstlane(tid >> 6);
    const int r = lane & 15, q = lane >> 4;
    const float* WRT = (const float*)(F.ws + WS_WRT) + (size_t)l * 48 * 2048;
    const float* nw = F.in[I_NFFN] + (size_t)l * D;
    const float* bg = F.in[I_RGB] + l * 4; const float* be = F.in[I_REB] + l * 32;
    unsigned* cnt = F.ctl + CW_CNT + l * 32;
    unsigned* route = (unsigned*)(F.tab + TAB_ROUTE);
    float* As = (float*)F.lds; float* Bs = As + 64 * 260; float* Cs = Bs + 48 * 260;
    float* Lg = As;
    const int tile = w & 3, kh = w >> 2;
    const int lr = tid >> 6, lc = (tid & 63) * 4;
    for (int g = F.bid; g < NTOK / 64; g += F.G) {
        const size_t t0 = (size_t)g * 64;
        f32x4 va[8], vb[6], vn;
        vn = *(const f32x4*)(nw + lc);
#pragma unroll
        for (int it = 0; it < 8; ++it) va[it] = *(const f32x4*)(F.h + (t0 + lr + 8 * it) * D + lc);
#pragma unroll
        for (int it = 0; it < 6; ++it) vb[it] = *(const f32x4*)(WRT + (size_t)(lr + 8 * it) * 2048 + lc);
        f32x4 acc[3]; acc[0] = (f32x4){0.f, 0.f, 0.f, 0.f}; acc[1] = acc[0]; acc[2] = acc[0];
        float ss = 0.f;
#pragma unroll 1
        for (int s = 0; s < 8; ++s) {
            LDS_BARRIER();
#pragma unroll
            for (int it = 0; it < 8; ++it) *(f32x4*)(As + (lr + 8 * it) * 260 + lc) = va[it];
#pragma unroll
            for (int it = 0; it < 6; ++it) *(f32x4*)(Bs + (lr + 8 * it) * 260 + lc) = vb[it];
            LDS_BARRIER();
#pragma unroll
            for (int it = 0; it < 8; ++it) {
                u32x2 pk; pk.x = cvt_pk_bf16(va[it][0] * vn[0], va[it][1] * vn[1]); pk.y = cvt_pk_bf16(va[it][2] * vn[2], va[it][3] * vn[3]);
                *(u32x2*)(F.U + (t0 + lr + 8 * it) * D + 256 * s + lc) = pk;
            }
            if (s < 7) {
                const int c0 = 256 * (s + 1) + lc;
                vn = *(const f32x4*)(nw + c0);
#pragma unroll
                for (int it = 0; it < 8; ++it) va[it] = *(const f32x4*)(F.h + (t0 + lr + 8 * it) * D + c0);
#pragma unroll
                for (int it = 0; it < 6; ++it) vb[it] = *(const f32x4*)(WRT + (size_t)(lr + 8 * it) * 2048 + c0);
            }
            const float* ap = As + (16 * tile + r) * 260 + 4 * q + kh * 128; const float* bp = Bs + r * 260 + 4 * q + kh * 128;
#pragma unroll
            for (int kg = 0; kg < 8; ++kg) {
                const f32x4 a4 = *(const f32x4*)(ap + 16 * kg);
                ss += a4[0] * a4[0] + a4[1] * a4[1] + a4[2] * a4[2] + a4[3] * a4[3];
#pragma unroll
                for (int n = 0; n < 3; ++n) {
                    const f32x4 b4 = *(const f32x4*)(bp + n * 16 * 260 + 16 * kg);
#pragma unroll
                    for (int s2 = 0; s2 < 4; ++s2) acc[n] = __builtin_amdgcn_mfma_f32_16x16x4f32(a4[s2], b4[s2], acc[n], 0, 0, 0);
                }
            }
        }
        if (kh == 1) {
            float* c = Cs + (tile * 64 + lane) * 13;
#pragma unroll
            for (int n = 0; n < 3; ++n)
#pragma unroll
                for (int j = 0; j < 4; ++j) c[n * 4 + j] = acc[n][j];
            c[12] = ss;
        }
        LDS_BARRIER();
        if (kh == 0) {
            const float* c = Cs + (tile * 64 + lane) * 13;
#pragma unroll
            for (int n = 0; n < 3; ++n)
#pragma unroll
                for (int j = 0; j < 4; ++j) acc[n][j] += c[n * 4 + j];
            ss += c[12];
            ss += __shfl_xor(ss, 16); ss += __shfl_xor(ss, 32);
            const float rs = rsqrtf(ss * (1.0f / D) + NORM_EPS);
#pragma unroll
            for (int j = 0; j < 4; ++j) {
                const float rj = __shfl(rs, 4 * q + j);
#pragma unroll
                for (int n = 0; n < 3; ++n) Lg[(16 * tile + 4 * q + j) * 48 + n * 16 + r] = acc[n][j] * rj;
            }
            if (lane < 16) {
                const float* lg = Lg + (16 * tile + lane) * 48; const int t = (int)t0 + 16 * tile + lane;
                float gl[4];
#pragma unroll
                for (int i = 0; i < 4; ++i) gl[i] = lg[i] + bg[i];
                int gi = 0; float gm = gl[0];
#pragma unroll
                for (int i = 1; i < 4; ++i) if (gl[i] > gm) { gm = gl[i]; gi = i; }
                float gsum = 0.f;
#pragma unroll
                for (int i = 0; i < 4; ++i) gsum += fexp(gl[i] - gm);
                const float gtop = 1.0f / gsum;
                float el[8];
#pragma unroll
                for (int i = 0; i < 8; ++i) el[i] = lg[4 + gi * 8 + i] + be[gi * 8 + i];
                int j1 = 0; float m1 = el[0];
#pragma unroll
                for (int i = 1; i < 8; ++i) if (el[i] > m1) { m1 = el[i]; j1 = i; }
                int j2 = -1; float m2 = -INFINITY;
#pragma unroll
                for (int i = 0; i < 8; ++i) if (i != j1 && el[i] > m2) { m2 = el[i]; j2 = i; }
                if (j2 < 0) { j2 = (j1 == 0) ? 1 : 0; m2 = m1; }
                const float e2 = fexp(m2 - m1);
                const float g1 = gtop / (1.0f + e2), g2 = gtop * e2 / (1.0f + e2);
                const int x1 = gi * 8 + j1, x2 = gi * 8 + j2;
                const unsigned p1 = atomicAdd(&cnt[x1], 1u), p2 = atomicAdd(&cnt[x2], 1u);
                u32x4 a; a.x = (unsigned)x1; a.y = (unsigned)x2; a.z = p1; a.w = p2;
                *(u32x4*)(route + (size_t)t * 8) = a;
                route[(size_t)t * 8 + 4] = __float_as_uint(g1); route[(size_t)t * 8 + 5] = __float_as_uint(g2); route[(size_t)t * 8 + 6] = __float_as_uint(rs);
            }
        }
    }
}

__device__ __forceinline__ void phase_tables(const Frame& F, int l) {
    const int tid = opaque_tid(); const int lane = tid & 63;
    int* pst = (int*)F.lds;
    const unsigned* cnt = F.ctl + CW_CNT + l * 32;
    int* slot_tok = (int*)(F.tab + TAB_SLOTTOK);
    if (tid < 32) pst[32 + tid] = (int)__hip_atomic_load(&cnt[tid], __ATOMIC_RELAXED, __HIP_MEMORY_SCOPE_AGENT);
    __syncthreads();
    if (tid == 0) {
        int* tile_exp = (int*)(F.tab + TAB_TILEEXP); int* ntiles = (int*)(F.tab + TAB_NTILES);
        int off = 0, nt = 0;
        for (int e = 0; e < NEXP; ++e) {
            pst[e] = off; const int tiles = (pst[32 + e] + 255) >> 8;
            if (F.bid == 0) for (int i = 0; i < tiles && nt < MAXTILE; ++i) tile_exp[nt + i] = e;
            nt += tiles; off += tiles * 256;
        }
        if (F.bid == 0) *ntiles = nt < MAXTILE ? nt : MAXTILE;
    }
    __syncthreads();
    if (F.bid == 0) {
        for (int e = 0; e < NEXP; ++e) { const int c = pst[32 + e], beg = pst[e] + c, end = pst[e] + (((c + 255) >> 8) << 8); for (int sidx = beg + tid; sidx < end; sidx += 512) if (sidx < MAXSLOT) { slot_tok[sidx] = 0; ((float*)(F.ws + WS_SLOTRS))[sidx] = 0.f; } }
    }
    const unsigned* route = (const unsigned*)(F.tab + TAB_ROUTE);
    int* tokslot = (int*)(F.tab + TAB_TOKSLOT); float* slotgate = (float*)(F.tab + TAB_SLOTGATE); float* slotrs = (float*)(F.ws + WS_SLOTRS);
    for (int t = F.bid * 512 + tid; t < NTOK; t += F.G * 512) {
        const u32x4 a = *(const u32x4*)(route + (size_t)t * 8);
        int s0 = pst[a.x & 31u] + (int)a.z, s1 = pst[a.y & 31u] + (int)a.w;
        s0 = min(max(s0, 0), MAXSLOT - 1); s1 = min(max(s1, 0), MAXSLOT - 1);
        tokslot[2 * t] = s0; tokslot[2 * t + 1] = s1; slot_tok[s0] = t; slot_tok[s1] = t;
        slotgate[s0] = __uint_as_float(route[(size_t)t * 8 + 4]); slotgate[s1] = __uint_as_float(route[(size_t)t * 8 + 5]);
        const float rsv = __uint_as_float(route[(size_t)t * 8 + 6]); slotrs[s0] = rsv; slotrs[s1] = rsv;
    }
    (void)lane;
}

__device__ __forceinline__ void phase_offsets(const Frame& F, int l) {
    const int tid_ = opaque_tid(); const int lane_ = tid_ & 63; const int wave_ = __builtin_amdgcn_readfirstlane(tid_ >> 6); (void)lane_; (void)wave_;
    if (F.bid == 0 && tid_ == 0) {
        const unsigned* cnt = F.ctl + CW_CNT + l * 32;
        int* padstart = (int*)(F.tab + TAB_PADSTART); int* tile_exp = (int*)(F.tab + TAB_TILEEXP); int* ntiles = (int*)(F.tab + TAB_NTILES);
        int off = 0, nt = 0;
        for (int e = 0; e < NEXP; ++e) {
            const int c = (int)__hip_atomic_load(&cnt[e], __ATOMIC_RELAXED, __HIP_MEMORY_SCOPE_AGENT);
            padstart[e] = off;
            const int tiles = (c + 255) >> 8;
            for (int i = 0; i < tiles && nt < MAXTILE; ++i) tile_exp[nt++] = e;
            off += tiles * 256;
        }
        *ntiles = nt;
    }
}

__device__ __forceinline__ void phase_scatter(const Frame& F) {
    const int tid_ = opaque_tid(); const int lane_ = tid_ & 63; const int wave_ = __builtin_amdgcn_readfirstlane(tid_ >> 6); (void)lane_; (void)wave_;
    const int gw = F.bid * 8 + wave_, nw = F.G * 8, lane = lane_;
    const unsigned* route = (const unsigned*)(F.tab + TAB_ROUTE); const int* padstart = (const int*)(F.tab + TAB_PADSTART);
    int* tokslot = (int*)(F.tab + TAB_TOKSLOT); float* slotgate = (float*)(F.tab + TAB_SLOTGATE);
    for (int t = gw; t < NTOK; t += nw) {
        const u32x4 a = *(const u32x4*)(route + (size_t)t * 8);
        int s0 = padstart[a.x & 31u] + (int)a.z, s1 = padstart[a.y & 31u] + (int)a.w;
        s0 = min(max(s0, 0), MAXSLOT - 1); s1 = min(max(s1, 0), MAXSLOT - 1);
        if (lane == 0) { tokslot[2 * t] = s0; tokslot[2 * t + 1] = s1; slotgate[s0] = __uint_as_float(route[(size_t)t * 8 + 4]); slotgate[s1] = __uint_as_float(route[(size_t)t * 8 + 5]); }
        const u32x4* src = (const u32x4*)(F.U + (size_t)t * D);
        u32x4* d0 = (u32x4*)(F.XPERM + (size_t)s0 * D); u32x4* d1 = (u32x4*)(F.XPERM + (size_t)s1 * D);
#pragma unroll
        for (int i = 0; i < 4; ++i) { const u32x4 x = src[lane + 64 * i]; d0[lane + 64 * i] = x; d1[lane + 64 * i] = x; }
    }
}

constexpr int PH_PER_LAYER = 10, N_PHASES = 1 + DEPTH * PH_PER_LAYER;

__global__ void __launch_bounds__(512, 2) mega(Args args) {
    extern __shared__ __attribute__((aligned(16))) unsigned char lds[];
    Frame F;
    F.in = args.in; F.h = args.out; F.ws = args.ws; F.lds = lds;
    F.G = gridDim.x; F.bid = blockIdx.x;
    F.ctl = (unsigned*)(args.ws + WS_CTL); F.tab = args.ws + WS_TAB;
    F.P = BfPtr{(const bf16_t*)(args.ws + WS_R1)}; F.Pw = (bf16_t*)(args.ws + WS_R1); F.Y = (bf16_t*)(args.ws + WS_R1); F.HID = (bf16_t*)(args.ws + WS_R1 + R1_HID);
    F.Q = (float*)(args.ws + WS_R2); F.XPERM = (bf16_t*)(args.ws + WS_R2); F.O = (float*)(args.ws + WS_R3);
    F.U = (bf16_t*)(args.ws + WS_U); F.MIX = (bf16_t*)(args.ws + WS_MIX);
    LAS unsigned char* ldsl = (LAS unsigned char*)lds;
    volatile LAS unsigned* misc = (volatile LAS unsigned*)(ldsl + LDS_MISC);
    if (threadIdx.x < 16) misc[threadIdx.x] = 0u;
    __syncthreads();
    const int lo = args.ph_lo, hi = args.ph_hi;
    XcdBarrier bar; bar.bar = F.ctl + CW_BAR; bar.x = 0; bar.st = misc;
    if (hi - lo > 1) bar = xcd_barrier_post(F.ctl + CW_BAR, misc);
#define IN(k) (lo <= (k) && (k) < hi)

    int ph = 0;
#ifndef PROBE_GROUP
#define PROBE_GROUP 0
#endif
#define PHASE_BEGIN if (IN(ph)) {
#define PHASE_BEGIN_R(g) if (IN(ph)) { for (int rep_ = 0; rep_ < 1 + (PROBE_GROUP == (g)); ++rep_) {
#define PHASE_END_R } PHASE_END
#define PHASE_END } if (IN(ph) && IN(ph + 1)) xcd_barrier(bar); ++ph;
    PHASE_BEGIN_R(1) phase_prologue(F); __syncthreads(); phase_norm1(F, 0, F.in[I_NMIX]); PHASE_END_R
    for (int l = 0; l < DEPTH; ++l) {
        if (l > 0) { PHASE_BEGIN phase_norm1(F, 1, F.in[I_NMIX] + (size_t)l * D); PHASE_END }
        PHASE_BEGIN_R(2)
            pg8::Gemm g{F.U, (const bf16_t*)(F.ws + WS_WIN) + (size_t)l * PS * D, D, 0, nullptr};
            pg8::StaticOrder S; S.init(NTOK, PS, F.G, F.bid);
            pg8::EpiBf E{F.Pw, PS};
            pg8::gemm_phase(ldsl, g, S, E);
            { const int rem = S.nwg % F.G;
              if (rem > 0 && F.bid >= rem) { __syncthreads(); const int tid_ = opaque_tid();
                  for (int i = F.bid - rem; i < DEFER_GEMM / 2; i += F.G - rem) conv_down_tile(F, 64 * 16 * 8 - DEFER_TILES - DEFER_GEMM + l * (DEFER_GEMM / 2) + i, tid_); }
              else if (rem == 0) { __syncthreads(); const int tid_ = opaque_tid();
                  for (int i = F.bid; i < DEFER_GEMM / 2; i += F.G) conv_down_tile(F, 64 * 16 * 8 - DEFER_TILES - DEFER_GEMM + l * (DEFER_GEMM / 2) + i, tid_); } }
        PHASE_END_R
        PHASE_BEGIN_R(4) phase_front(F, l); PHASE_END_R
        PHASE_BEGIN phase_m2(F, l); PHASE_END
        PHASE_BEGIN_R(6) phase_back(F, l); PHASE_END_R
        PHASE_BEGIN
            pg8::Gemm g{F.MIX, (const bf16_t*)(F.ws + WS_WOUT) + (size_t)l * D * D, D, 0, nullptr};
            pg8::StaticOrder S; S.init(NTOK, D, F.G, F.bid);
            pg8::EpiRes E{l == 0 ? F.in[I_X] : F.h, F.h, D};
            pg8::gemm_phase(ldsl, g, S, E);
        PHASE_END
        PHASE_BEGIN phase_router3(F, l); PHASE_END
        PHASE_BEGIN phase_tables(F, l); PHASE_END
        PHASE_BEGIN_R(2)
            pg8::Gemm g{F.U, (const bf16_t*)(F.ws + WS_WGU) + (size_t)l * NEXP * 2048 * 2048, D, (size_t)2048 * 2048 * 2, (const int*)(F.tab + TAB_SLOTTOK)};
            pg8::MoeOrder S{*(const int*)(F.tab + TAB_NTILES), (const int*)(F.tab + TAB_TILEEXP), 8, F.G, F.bid};
            pg8::EpiGU E{F.HID, (const float*)(F.ws + WS_SLOTRS)};
            pg8::gemm_phase<pg8::EpiGU, pg8::MoeOrder, true>(ldsl, g, S, E);
        PHASE_END_R
        PHASE_BEGIN_R(2)
            pg8::Gemm g{F.HID, (const bf16_t*)(F.ws + WS_WD) + (size_t)l * NEXP * 2048 * 1024, DEXP, (size_t)2048 * 1024 * 2, nullptr};
            pg8::MoeOrder S{*(const int*)(F.tab + TAB_NTILES), (const int*)(F.tab + TAB_TILEEXP), 8, F.G, F.bid};
            pg8::EpiDown E{F.Y, (const float*)(F.tab + TAB_SLOTGATE)};
            pg8::gemm_phase(ldsl, g, S, E);
        PHASE_END_R
    }
    PHASE_BEGIN phase_norm1(F, 2, F.in[I_NFIN]); PHASE_END
#undef PHASE_BEGIN
#undef PHASE_END
#undef IN
}

extern "C" void kernel_launch(void* const* d_in, const int* in_sizes, int n_in, void* d_out, int out_size, void* d_ws, size_t ws_size, hipStream_t stream) {
    static int grid = 0;
    if (grid == 0) {
        if (n_in != NIN || out_size != NTOK * D || ws_size < WS_END) { fprintf(stderr, "kernel_launch: unexpected shapes (n_in %d, out %d, ws %zu < %zu)\n", n_in, out_size, ws_size, (size_t)WS_END); grid = -1; return; }
        int dev = 0, cus = 0;
        if (hipGetDevice(&dev) != hipSuccess || hipDeviceGetAttribute(&cus, hipDeviceAttributeMultiprocessorCount, dev) != hipSuccess) { grid = -1; return; }
        if (hipFuncSetAttribute((const void*)mega, hipFuncAttributeMaxDynamicSharedMemorySize, LDS_BYTES) != hipSuccess) { fprintf(stderr, "kernel_launch: hipFuncSetAttribute failed\n"); grid = -1; return; }
        int per_cu = 0;
        if (hipOccupancyMaxActiveBlocksPerMultiprocessor(&per_cu, (const void*)mega, 512, LDS_BYTES) != hipSuccess || per_cu < 1) fprintf(stderr, "kernel_launch: occupancy query says %d\n", per_cu);
        (void)hipGetLastError();
        grid = cus;
    }
    if (grid < 0) return;
    (void)hipMemsetAsync((char*)d_ws + WS_CTL, 0, CTL_BYTES, stream);
    Args a{};
    for (int i = 0; i < NIN; ++i) a.in[i] = (const float*)d_in[i];
    a.out = (float*)d_out; a.ws = (unsigned char*)d_ws;
#if MK_MULTI
    for (int p = 0; p < N_PHASES; ++p) { a.ph_lo = p; a.ph_hi = p + 1; hipLaunchKernelGGL(mega, dim3(grid), dim3(512), LDS_BYTES, stream, a); }
#else
    a.ph_lo = 0; a.ph_hi = N_PHASES;
    hipLaunchKernelGGL(mega, dim3(grid), dim3(512), LDS_BYTES, stream, a);
#endif
}
```
